# Optimizing an MI355X kernel written in HIP

```python
import math
import jax, jax.numpy as jnp
from jax import lax
import numpy as np

D_MODEL = 1024
BATCH = 4
SEQ = 8192
DEPTH = 2

GRID_W = 64
CTX_LEN = 256
N_MIXERS = 2
ATT_HEADS = 8
ATT_HEAD_DIM = D_MODEL // ATT_HEADS // 2
ATT_V_DIM = 2 * ATT_HEAD_DIM
ROPE_THETA = 10000.0
Q_BLOCK = 128
SGU_CHUNK = 128
SGU_DFF = 2 * D_MODEL
SGU_GROUPS = 8
N_EXPERTS = 256
TOP_K = 8
N_GROUPS = 8
TOPK_GROUPS = 4
EXPERT_DFF = D_MODEL // 4
SHARED_DFF = EXPERT_DFF
ROUTED_SCALE = 2.5
MOE_BLOCK = 128
DEEPNORM_ALPHA = (2 * DEPTH) ** 0.25
DEEPNORM_BETA = (8 * DEPTH) ** -0.25
LN_EPS = 1e-5
N_ATTN_LAYERS = (DEPTH + 1) // 2
N_SGU_LAYERS = DEPTH // 2

kernel_name = "hybrid_diffattn_sgu_moe_deepnorm_prefix"


def _layer_norm(x, g, b):
    xf = x.astype(jnp.float32)
    mu = jnp.mean(xf, axis=-1, keepdims=True)
    var = jnp.mean(jnp.square(xf - mu), axis=-1, keepdims=True)
    return ((xf - mu) * lax.rsqrt(var + LN_EPS) * g.astype(jnp.float32) + b.astype(jnp.float32)).astype(x.dtype)


def _rms_norm(x, g):
    xf = x.astype(jnp.float32)
    return (xf * lax.rsqrt(jnp.mean(jnp.square(xf), axis=-1, keepdims=True) + LN_EPS) * g.astype(jnp.float32)).astype(x.dtype)


def _rope_axis(xh, pos):
    half = xh.shape[-1]
    inv = ROPE_THETA ** (-jnp.arange(0, half, 2, dtype=jnp.float32) / half)
    ang = pos.astype(jnp.float32)[:, None] * inv[None, :]
    ang = jnp.concatenate([ang, ang], axis=-1)[None, :, None, None, :]
    x1, x2 = jnp.split(xh.astype(jnp.float32), 2, axis=-1)
    rot = jnp.concatenate([-x2, x1], axis=-1)
    return (xh.astype(jnp.float32) * jnp.cos(ang) + rot * jnp.sin(ang)).astype(xh.dtype)


def _rope_2d(x, row_pos, col_pos):
    xr, xc = jnp.split(x, 2, axis=-1)
    return jnp.concatenate([_rope_axis(xr, row_pos), _rope_axis(xc, col_pos)], axis=-1)


def _diff_attn_core(q, k, v, lam):
    s = jnp.einsum('bqhmd,bkhmd->bhmqk', q, k, preferred_element_type=jnp.float32) * (ATT_HEAD_DIM ** -0.5)
    p = jax.nn.softmax(s, axis=-1)
    pd = p[:, :, 0] - lam * p[:, :, 1]
    o = jnp.einsum('bhqk,bkhe->bqhe', pd, v.astype(jnp.float32))
    return o.astype(v.dtype)


def _diff_attn_out(o, subln_g, lam_init, w_out):
    o = _rms_norm(o, subln_g) * (1.0 - lam_init)
    return o.reshape(o.shape[0], o.shape[1], D_MODEL) @ w_out


def _diff_attention(h, hc, w_in, w_out, lam_p, subln_g, lam_init, row_pos, col_pos, ctx_out):
    B, N, _ = h.shape
    C = hc.shape[1]
    lam_p = lam_p.astype(jnp.float32)
    lam = jnp.exp(jnp.sum(lam_p[0] * lam_p[1])) - jnp.exp(jnp.sum(lam_p[2] * lam_p[3])) + lam_init
    qkv = h @ w_in
    q = _rope_2d(qkv[..., :D_MODEL].reshape(B, N, ATT_HEADS, 2, ATT_HEAD_DIM), row_pos, col_pos)
    k = _rope_2d(qkv[..., D_MODEL:2 * D_MODEL].reshape(B, N, ATT_HEADS, 2, ATT_HEAD_DIM), row_pos, col_pos)
    v = qkv[..., 2 * D_MODEL:].reshape(B, N, ATT_HEADS, ATT_V_DIM)
    kvc = hc @ w_in[:, D_MODEL:]
    kc = kvc[..., :D_MODEL].reshape(B, C, ATT_HEADS, 2, ATT_HEAD_DIM)
    vc = kvc[..., D_MODEL:].reshape(B, C, ATT_HEADS, ATT_V_DIM)
    k_all = jnp.concatenate([k, kc], axis=1)
    v_all = jnp.concatenate([v, vc], axis=1)
    qb = q.reshape(B, N // Q_BLOCK, Q_BLOCK, ATT_HEADS, 2, ATT_HEAD_DIM).transpose(1, 0, 2, 3, 4, 5)
    ob = lax.map(lambda qi: _diff_attn_core(qi, k_all, v_all, lam), qb)
    o = ob.transpose(1, 0, 2, 3, 4).reshape(B, N, ATT_HEADS, ATT_V_DIM)
    y = _diff_attn_out(o, subln_g, lam_init, w_out)
    yc = None
    if ctx_out:
        qc = (hc @ w_in[:, :D_MODEL]).reshape(B, C, ATT_HEADS, 2, ATT_HEAD_DIM)
        yc = _diff_attn_out(_diff_attn_core(qc, kc, vc, lam), subln_g, lam_init, w_out)
    return y, yc


def _sgu_mixer(h, w_in, b_in, norm_g, norm_b, w_s, b_s, w_out):
    B, N, _ = h.shape
    z = jax.nn.gelu(h @ w_in + b_in, approximate=False)
    u, v = jnp.split(z, 2, axis=-1)
    v = _layer_norm(v, norm_g, norm_b)
    vc = v.reshape(B, N // SGU_CHUNK, SGU_CHUNK, SGU_GROUPS, SGU_DFF // SGU_GROUPS)
    vm = jnp.einsum('gpq,bnqgc->bnpgc', w_s, vc) + b_s.T[:, :, None]
    return (u * vm.reshape(B, N, SGU_DFF)) @ w_out


def _route(xt, w_r, r_bias):
    T = xt.shape[0]
    scores = jax.nn.sigmoid(xt.astype(jnp.float32) @ w_r.astype(jnp.float32))
    choice = scores + r_bias.astype(jnp.float32)
    grp = choice.reshape(T, N_GROUPS, N_EXPERTS // N_GROUPS)
    gscore = jnp.sum(lax.top_k(grp, 2)[0], axis=-1)
    _, gidx = lax.top_k(gscore, TOPK_GROUPS)
    gmask = jnp.any(jax.nn.one_hot(gidx, N_GROUPS, dtype=jnp.bool_), axis=1)
    emask = jnp.repeat(gmask, N_EXPERTS // N_GROUPS, axis=1)
    _, idx = lax.top_k(jnp.where(emask, choice, -jnp.inf), TOP_K)
    w = jnp.take_along_axis(scores, idx, axis=1)
    w = w / jnp.sum(w, axis=-1, keepdims=True) * ROUTED_SCALE
    return idx.astype(jnp.int32), w


def _moe(xt, w_r, r_bias, wg, wu, wd, sg, su, sd):
    T = xt.shape[0]
    idx, w = _route(xt, w_r, r_bias)
    TK = T * TOP_K
    e = idx.reshape(-1)
    tok = jnp.arange(TK, dtype=jnp.int32) // TOP_K
    wf = w.reshape(-1)
    order = jnp.argsort(e)
    se = e[order]
    counts = jnp.bincount(e, length=N_EXPERTS).astype(jnp.int32)
    starts = jnp.cumsum(counts) - counts
    padded = (counts + MOE_BLOCK - 1) // MOE_BLOCK * MOE_BLOCK
    pends = jnp.cumsum(padded)
    pstarts = pends - padded
    dest = pstarts[se] + jnp.arange(TK, dtype=jnp.int32) - starts[se]
    n_blocks = -(-TK // MOE_BLOCK) + N_EXPERTS
    P = n_blocks * MOE_BLOCK
    slot_tok = jnp.zeros((P,), jnp.int32).at[dest].set(tok[order])
    slot_w = jnp.zeros((P,), jnp.float32).at[dest].set(wf[order])
    block_e = jnp.clip(jnp.searchsorted(pends, jnp.arange(n_blocks, dtype=jnp.int32) * MOE_BLOCK, side='right'), 0, N_EXPERTS - 1)

    def step(acc, blk):
        bt, bw, be = blk
        xb = xt[bt]
        hb = jax.nn.silu(xb @ wg[be]) * (xb @ wu[be])
        yb = (hb @ wd[be]) * bw[:, None]
        return acc.at[bt].add(yb.astype(acc.dtype)), None

    routed, _ = lax.scan(step, jnp.zeros_like(xt),
                         (slot_tok.reshape(n_blocks, MOE_BLOCK), slot_w.reshape(n_blocks, MOE_BLOCK), block_e))
    shared = (jax.nn.silu(xt @ sg) * (xt @ su)) @ sd
    return routed + shared


def setup_inputs(seed: int = 0) -> dict:
    key = jax.random.key(seed)
    ks = jax.random.split(key, 32)
    f32 = jnp.float32
    D, dh, dv = D_MODEL, ATT_HEAD_DIM, ATT_V_DIM
    nrm = lambda k, shape, s: jax.random.normal(k, shape, f32) * s
    beta = DEEPNORM_BETA
    return {
        'x': nrm(ks[0], (BATCH, SEQ, D), 1.0),
        'c': nrm(ks[1], (BATCH, D), 1.0),
        'ctx': nrm(ks[2], (BATCH, CTX_LEN, D), 1.0),
        'c_ctx': nrm(ks[3], (D,), 0.5),
        'w_mod': nrm(ks[4], (DEPTH, D, 6 * D), 0.5 * D ** -0.5),
        'b_mod': nrm(ks[5], (DEPTH, 6 * D), 0.02),
        'ln_g': 1.0 + nrm(ks[6], (DEPTH, 2, D), 0.02),
        'ln_b': nrm(ks[7], (DEPTH, 2, D), 0.02),
        'attn_w_in': nrm(ks[8], (N_ATTN_LAYERS, D, 3 * D), D ** -0.5),
        'attn_w_out': nrm(ks[9], (N_ATTN_LAYERS, D, D), beta * D ** -0.5),
        'attn_lambda': nrm(ks[10], (N_ATTN_LAYERS, 4, dh), 0.1),
        'attn_subln_g': 1.0 + nrm(ks[11], (N_ATTN_LAYERS, dv), 0.02),
        'sgu_w_in': nrm(ks[12], (N_SGU_LAYERS, D, 2 * SGU_DFF), D ** -0.5),
        'sgu_b_in': nrm(ks[13], (N_SGU_LAYERS, 2 * SGU_DFF), 0.02),
        'sgu_norm_g': 1.0 + nrm(ks[14], (N_SGU_LAYERS, SGU_DFF), 0.02),
        'sgu_norm_b': nrm(ks[15], (N_SGU_LAYERS, SGU_DFF), 0.02),
        'sgu_w_s': nrm(ks[16], (N_SGU_LAYERS, SGU_GROUPS, SGU_CHUNK, SGU_CHUNK), SGU_CHUNK ** -0.5),
        'sgu_b_s': 1.0 + nrm(ks[17], (N_SGU_LAYERS, SGU_GROUPS, SGU_CHUNK), 0.02),
        'sgu_w_out': nrm(ks[18], (N_SGU_LAYERS, SGU_DFF, D), beta * SGU_DFF ** -0.5),
        'router_w': nrm(ks[19], (DEPTH, D, N_EXPERTS), D ** -0.5),
        'router_bias': nrm(ks[20], (DEPTH, N_EXPERTS), 0.01),
        'exp_w_gate': nrm(ks[21], (DEPTH, N_EXPERTS, D, EXPERT_DFF), D ** -0.5),
        'exp_w_up': nrm(ks[22], (DEPTH, N_EXPERTS, D, EXPERT_DFF), D ** -0.5),
        'exp_w_down': nrm(ks[23], (DEPTH, N_EXPERTS, EXPERT_DFF, D), beta * EXPERT_DFF ** -0.5),
        'sh_w_gate': nrm(ks[24], (DEPTH, D, SHARED_DFF), D ** -0.5),
        'sh_w_up': nrm(ks[25], (DEPTH, D, SHARED_DFF), D ** -0.5),
        'sh_w_down': nrm(ks[26], (DEPTH, SHARED_DFF, D), beta * SHARED_DFF ** -0.5),
    }


def reference(x, c, ctx, c_ctx, w_mod, b_mod, ln_g, ln_b, attn_w_in, attn_w_out, attn_lambda, attn_subln_g,
              sgu_w_in, sgu_b_in, sgu_norm_g, sgu_norm_b, sgu_w_s, sgu_b_s, sgu_w_out,
              router_w, router_bias, exp_w_gate, exp_w_up, exp_w_down, sh_w_gate, sh_w_up, sh_w_down):
    B, N, D = x.shape
    C = ctx.shape[1]
    ROWS = N // GRID_W
    row_pos = jnp.repeat(jnp.arange(ROWS, dtype=jnp.int32), GRID_W, total_repeat_length=ROWS * GRID_W)
    col_pos = jnp.tile(jnp.arange(GRID_W, dtype=jnp.int32), ROWS)
    last_ctx_read = max(i for i in range(DEPTH) if i % N_MIXERS == 0)
    s_c = jax.nn.silu(c)
    s_cc = jax.nn.silu(c_ctx)
    xc = ctx
    for i in range(DEPTH):
        mod = (s_c @ w_mod[i] + b_mod[i])[:, None, :]
        sh_m, sc_m, g_m, sh_f, sc_f, g_f = jnp.split(mod, 6, axis=-1)
        modc = s_cc @ w_mod[i] + b_mod[i]
        shc_m, scc_m, gc_m, shc_f, scc_f, gc_f = jnp.split(modc, 6, axis=-1)
        is_attn = (i % N_MIXERS == 0)
        ctx_update = i < last_ctx_read
        h = x * (1.0 + sc_m) + sh_m
        if is_attn:
            a = i // N_MIXERS
            lam_init = 0.8 - 0.6 * math.exp(-0.3 * i)
            hc = xc * (1.0 + scc_m) + shc_m
            y, yc = _diff_attention(h, hc, attn_w_in[a], attn_w_out[a], attn_lambda[a], attn_subln_g[a],
                                    lam_init, row_pos, col_pos, ctx_update)
        else:
            s = i // N_MIXERS
            sgu_p = (sgu_w_in[s], sgu_b_in[s], sgu_norm_g[s], sgu_norm_b[s], sgu_w_s[s], sgu_b_s[s], sgu_w_out[s])
            y = _sgu_mixer(h, *sgu_p)
            if ctx_update:
                yc = _sgu_mixer(xc * (1.0 + scc_m) + shc_m, *sgu_p)
        x = _layer_norm(DEEPNORM_ALPHA * x + g_m * y, ln_g[i, 0], ln_b[i, 0])
        moe_p = (router_w[i], router_bias[i], exp_w_gate[i], exp_w_up[i], exp_w_down[i],
                 sh_w_gate[i], sh_w_up[i], sh_w_down[i])
        h = (x * (1.0 + sc_f) + sh_f).reshape(B * N, D)
        if ctx_update:
            xc = _layer_norm(DEEPNORM_ALPHA * xc + gc_m * yc, ln_g[i, 0], ln_b[i, 0])
            hc = (xc * (1.0 + scc_f) + shc_f).reshape(B * C, D)
            yf_all = _moe(jnp.concatenate([h, hc], axis=0), *moe_p)
            yf = yf_all[:B * N].reshape(B, N, D)
            yfc = yf_all[B * N:].reshape(B, C, D)
            xc = _layer_norm(DEEPNORM_ALPHA * xc + gc_f * yfc, ln_g[i, 1], ln_b[i, 1])
        else:
            yf = _moe(h, *moe_p).reshape(B, N, D)
        x = _layer_norm(DEEPNORM_ALPHA * x + g_f * yf, ln_g[i, 1], ln_b[i, 1])
    return x
```

```cpp
#include <hip/hip_runtime.h>
#include <cstdio>
#include <cstdint>

#ifndef MK_PER_PHASE_LAUNCH
#define MK_PER_PHASE_LAUNCH 0
#endif

#define GAS __attribute__((address_space(1)))
#define LAS __attribute__((address_space(3)))
typedef unsigned short bf16_t;
typedef float f32x4 __attribute__((ext_vector_type(4)));
typedef unsigned u32x4 __attribute__((ext_vector_type(4)));
typedef unsigned u32x2 __attribute__((ext_vector_type(2)));

constexpr int D = 1024, BATCH = 4, SEQ = 8192, CTX = 256, T = BATCH * SEQ, SEQA = SEQ + CTX, TA = BATCH * SEQA;
constexpr int NH = 8, HD = 64, DV = 128;
constexpr int SGU_DFF = 2048, SGU_CH = 128, SGU_G = 8, SGU_GC = 256;
constexpr int NE = 256, TOPK = 8, NGRP = 8, EDFF = 256;
constexpr int TK = T * TOPK;
constexpr int PADM = 128;
constexpr int PMAX = TK + NE * PADM;
constexpr float LN_EPS = 1e-5f, ALPHA = 1.4142135623730951f, ROUTED_SCALE = 2.5f;
constexpr float LAM_INIT = 0.2f;
constexpr int NWAVES = 8, NTHR = 512;

constexpr size_t MiB = 1u << 20;
constexpr size_t WS_CTL = 0, CTL_ZERO_BYTES = 1 * MiB;
constexpr int CW_BAR = 4096;
constexpr int CW_CNT = 32768;
constexpr size_t WS_MODV = 1 * MiB;
constexpr size_t WS_IDX = 2 * MiB, WS_WGT = 3 * MiB, WS_POS = 4 * MiB;
constexpr size_t WS_STOK = 5 * MiB, WS_SW = 7 * MiB;
constexpr size_t WS_VSTAT = 9 * MiB;
constexpr size_t WS_R = 16 * MiB;
constexpr size_t WS_HALL = WS_R, WS_Q = WS_R + 66 * MiB, WS_K = WS_R + 132 * MiB, WS_V = WS_R + 198 * MiB, WS_OATT = WS_R + 264 * MiB, WS_ATT = WS_R + 520 * MiB;
constexpr size_t WS_U = WS_R, WS_VV = WS_R + 128 * MiB, WS_VN = WS_R + 384 * MiB, WS_GSP = WS_R + 640 * MiB;
constexpr size_t WS_Y = WS_R + 768 * MiB;
constexpr size_t WS_X1 = WS_Y + 128 * MiB;
constexpr size_t WS_X2 = WS_X1 + 128 * MiB;
constexpr size_t WS_HM = WS_X2 + 128 * MiB;
constexpr size_t WS_H1 = WS_HM + 64 * MiB;
constexpr size_t WS_LOG = WS_H1 + 64 * MiB;
constexpr size_t WS_YF = WS_LOG + 32 * MiB;
constexpr size_t WS_HS = WS_YF + 128 * MiB;
constexpr size_t WS_GS = WS_HS + 176 * MiB;
constexpr size_t WS_END = WS_GS + 352 * MiB;
static_assert(WS_END <= (size_t)2048 * MiB, "workspace map exceeds 2 GiB");
static_assert((size_t)(PMAX + T) * EDFF * 4 <= 352 * MiB && (size_t)TA * D * 2 <= 66 * MiB, "ws sizes");

constexpr int LDS_BYTES = 147456;
constexpr int LDS_MISC = 131072;

#define XB_TMO      128
#define XB_XCNT(j)  (256  + 64 * (j))
#define XB_XSUB(j)  (1280 + 64 * (j))
#define XB_XGEN(j)  (2304 + 64 * (j))
#define XB_TOP      3328
#define XB_TOPGEN   3392
#define XCD_BAR_WORDS 3456
#define XB_SPIN_CAP (1u << 23)

__device__ __forceinline__ unsigned xb_ld(unsigned* p)              { return __hip_atomic_load(p, __ATOMIC_RELAXED, __HIP_MEMORY_SCOPE_AGENT); }
__device__ __forceinline__ unsigned xb_add(unsigned* p, unsigned v) { return __hip_atomic_fetch_add(p, v, __ATOMIC_RELAXED, __HIP_MEMORY_SCOPE_AGENT); }
__device__ __forceinline__ unsigned xb_xcc_id() { return (unsigned)__builtin_amdgcn_s_getreg((3 << 11) | 20) & 0xFu; }
#define XB_SPIN(cond, bar) do { unsigned _sp = 0; while (cond) { __builtin_amdgcn_s_sleep(1); \
    if ((++_sp & 255u) == 0u) { if (xb_ld(&(bar)[XB_TMO])) break; if (_sp > XB_SPIN_CAP) { atomicAdd(&(bar)[XB_TMO], 1u); break; } } } } while (0)

struct XcdBarrier { unsigned* bar; unsigned x; volatile LAS unsigned* st; };

__device__ __forceinline__ XcdBarrier xcd_barrier_post(unsigned* bar, volatile LAS unsigned* st) {
    XcdBarrier b; b.bar = bar; b.x = xb_xcc_id(); b.st = st;
    if (threadIdx.x == 0) (void)xb_add(&bar[XB_XCNT(b.x)], 1u);
    return b;
}
__device__ __forceinline__ void xcd_barrier_complete(unsigned* bar, unsigned x, unsigned& nloc, unsigned& nx) {
    const unsigned G = gridDim.x * gridDim.y * gridDim.z;
    unsigned sum, cnt, mine, sp = 0u;
    for (;;) {
        sum = 0u; cnt = 0u; mine = 0u;
#pragma unroll
        for (unsigned j = 0; j < 16; ++j) { const unsigned c = xb_ld(&bar[XB_XCNT(j)]); sum += c; cnt += (c > 0u) ? 1u : 0u; mine = (j == x) ? c : mine; }
        if (sum == G) break;
        __builtin_amdgcn_s_sleep(1);
        if ((++sp & 255u) == 0u) { if (xb_ld(&bar[XB_TMO])) break; if (sp > XB_SPIN_CAP) { atomicAdd(&bar[XB_TMO], 1u); break; } }
    }
    nloc = mine > 0u ? mine : 1u; nx = cnt > 0u ? cnt : 1u;
}
__device__ __forceinline__ void xcd_barrier(const XcdBarrier& b) {
    asm volatile("s_waitcnt vmcnt(0)" ::: "memory");
    __syncthreads();
    if (threadIdx.x == 0) {
        unsigned* bar = b.bar;
        __builtin_amdgcn_s_waitcnt(0);
        unsigned nloc = b.st[0], nx = b.st[1];
        if (nloc == 0u) { xcd_barrier_complete(bar, b.x, nloc, nx); b.st[0] = nloc; b.st[1] = nx; }
        const unsigned old = xb_add(&bar[XB_XSUB(b.x)], 1u);
        const unsigned gen = old / nloc;
        if (old + 1u == (gen + 1u) * nloc) {
            __builtin_amdgcn_fence(__ATOMIC_RELEASE, "agent");
            asm volatile("s_waitcnt vmcnt(0)" ::: "memory");
            const unsigned og = xb_add(&bar[XB_TOP], 1u);
            const unsigned tg = og / nx;
            if (og + 1u == (tg + 1u) * nx) xb_add(&bar[XB_TOPGEN], 1u);
            else XB_SPIN(xb_ld(&bar[XB_TOPGEN]) == tg, bar);
            __builtin_amdgcn_fence(__ATOMIC_ACQUIRE, "agent");
            xb_add(&bar[XB_XGEN(b.x)], 1u);
            asm volatile("s_waitcnt vmcnt(0)" ::: "memory");
        } else {
            XB_SPIN(xb_ld(&bar[XB_XGEN(b.x)]) == gen, bar);
            __builtin_amdgcn_fence(__ATOMIC_ACQUIRE, "agent");
            asm volatile("s_waitcnt vmcnt(0)" ::: "memory");
        }
    }
    __syncthreads();
}

__device__ __forceinline__ unsigned f2bf(float f) { unsigned u = __builtin_bit_cast(unsigned, f); return (u + 0x7fffu + ((u >> 16) & 1u)) >> 16; }
__device__ __forceinline__ float bf2f(unsigned b) { return __builtin_bit_cast(float, b << 16); }
__device__ __forceinline__ unsigned pk2(float lo, float hi) { return f2bf(lo) | (f2bf(hi) << 16); }
__device__ __forceinline__ float wave_sum(float v) {
#pragma unroll
    for (int o = 1; o < 64; o <<= 1) v += __shfl_xor(v, o);
    return v;
}
__device__ __forceinline__ float siluf(float x) { return x / (1.f + __expf(-x)); }
__device__ __forceinline__ float sigmoidf_(float x) { return 1.f / (1.f + __expf(-x)); }
__device__ __forceinline__ float gelu_erf(float x) { return 0.5f * x * (1.f + erff(x * 0.70710678118654752f)); }

template <class LoadA, class Epi>
__device__ __forceinline__ void gemm_tile(const LoadA& la, const float* __restrict__ W, int ldw, int K, int m0, int n0, float* sm, const Epi& E) {
    const int tid = threadIdx.x, ty = tid >> 4, tx = tid & 15;
    float* As = sm; float* Bs = sm + 16 * 132;
    f32x4 acc[4][2];
#pragma unroll
    for (int i = 0; i < 4; ++i) { acc[i][0] = (f32x4){0.f, 0.f, 0.f, 0.f}; acc[i][1] = (f32x4){0.f, 0.f, 0.f, 0.f}; }
    const int ar = tid >> 2, k4 = (tid & 3) * 4;
    const int bk = tid >> 5, bn = (tid & 31) * 4;
    const float* bp = W + (size_t)bk * ldw + n0 + bn;
    for (int k0 = 0; k0 < K; k0 += 16) {
        const f32x4 a = la(m0 + ar, k0 + k4);
        const f32x4 b = *(const f32x4*)(bp + (size_t)k0 * ldw);
        __syncthreads();
        As[(k4 + 0) * 132 + ar] = a.x; As[(k4 + 1) * 132 + ar] = a.y; As[(k4 + 2) * 132 + ar] = a.z; As[(k4 + 3) * 132 + ar] = a.w;
        *(f32x4*)&Bs[bk * 128 + bn] = b;
        __syncthreads();
#pragma unroll
        for (int kk = 0; kk < 16; ++kk) {
            const f32x4 av = *(const f32x4*)&As[kk * 132 + ty * 4];
            const f32x4 b0 = *(const f32x4*)&Bs[kk * 128 + tx * 8], b1 = *(const f32x4*)&Bs[kk * 128 + tx * 8 + 4];
#pragma unroll
            for (int i = 0; i < 4; ++i) { acc[i][0] += b0 * av[i]; acc[i][1] += b1 * av[i]; }
        }
    }
#pragma unroll
    for (int i = 0; i < 4; ++i) E(m0 + ty * 4 + i, n0 + tx * 8, acc[i][0], acc[i][1]);
}
struct LoadBf16 {
    const bf16_t* A; int lda; const int* rowidx;
    __device__ __forceinline__ f32x4 operator()(int r, int k) const {
        const int rr = rowidx ? rowidx[r] : r;
        const u32x2 w = *(const u32x2*)(A + (size_t)rr * lda + k);
        return (f32x4){bf2f(w.x & 0xffffu), bf2f(w.x >> 16), bf2f(w.y & 0xffffu), bf2f(w.y >> 16)};
    }
};
struct LoadF32 {
    const float* A; int lda;
    __device__ __forceinline__ f32x4 operator()(int r, int k) const { return *(const f32x4*)(A + (size_t)r * lda + k); }
};

struct Args { const float* in[27]; float* out; unsigned char* ws; int ph_lo, ph_hi; };
enum { I_X = 0, I_C, I_CTX, I_CCTX, I_WMOD, I_BMOD, I_LNG, I_LNB, I_AWIN, I_AWOUT, I_ALAM, I_ASUBG, I_SWIN, I_SBIN, I_SNG, I_SNB, I_SWS, I_SBS, I_SWOUT,
       I_RW, I_RB, I_EWG, I_EWU, I_EWD, I_SHG, I_SHU, I_SHD };
constexpr int N_PHASES = 25;

__device__ __forceinline__ void ln_rows(const float* xin, const float* y, float* xout, bf16_t* hb, const float* lng, const float* lnb,
                                        const float* modl  , int g_off, const float* modh  , int sc_off, int gw, int NGW, int lane) {
    for (int row = gw; row < T; row += NGW) {
        const int b = row / SEQ; const float* mb = modl + b * 6144;
        f32x4 v[4]; float s = 0.f;
#pragma unroll
        for (int j = 0; j < 4; ++j) {
            const int c = j * 256 + lane * 4;
            const f32x4 xv = *(const f32x4*)(xin + (size_t)row * D + c), yv = *(const f32x4*)(y + (size_t)row * D + c), gv = *(const f32x4*)(mb + g_off + c);
            v[j] = xv * ALPHA + gv * yv; s += (v[j].x + v[j].y) + (v[j].z + v[j].w);
        }
        const float mean = wave_sum(s) * (1.f / D); float s2 = 0.f;
#pragma unroll
        for (int j = 0; j < 4; ++j) { v[j] = v[j] - mean; s2 += (v[j].x * v[j].x + v[j].y * v[j].y) + (v[j].z * v[j].z + v[j].w * v[j].w); }
        const float rstd = 1.f / sqrtf(wave_sum(s2) * (1.f / D) + LN_EPS);
#pragma unroll
        for (int j = 0; j < 4; ++j) {
            const int c = j * 256 + lane * 4;
            const f32x4 o = v[j] * rstd * *(const f32x4*)(lng + c) + *(const f32x4*)(lnb + c);
            *(f32x4*)(xout + (size_t)row * D + c) = o;
            if (modh) {
                const float* mh = modh + b * 6144;
                const f32x4 h = o * (*(const f32x4*)(mh + sc_off + c) + 1.f) + *(const f32x4*)(mh + sc_off - 1024 + c);
                *(u32x2*)(hb + (size_t)row * D + c) = (u32x2){pk2(h.x, h.y), pk2(h.z, h.w)};
            }
        }
    }
}

__device__ __forceinline__ void expert_prefix(const unsigned* cnt, int* ps, int tid) {
    if (tid < 64) {
        int v[4], s = 0;
#pragma unroll
        for (int i = 0; i < 4; ++i) { const int c = (int)cnt[tid * 4 + i]; v[i] = (c + PADM - 1) / PADM * PADM; s += v[i]; }
        int inc = s;
#pragma unroll
        for (int o = 1; o < 64; o <<= 1) { const int t = __shfl_up(inc, o); if (tid >= o) inc += t; }
        int ex = inc - s;
#pragma unroll
        for (int i = 0; i < 4; ++i) { ps[tid * 4 + i] = ex; ex += v[i]; }
        if (tid == 63) ps[256] = ex;
    }
    __syncthreads();
}

struct Ctx { const Args* a; unsigned char* lds; XcdBarrier bar; int tid, lane, wave, G, bid, gw, NGW; long gt, NGT; };
#ifndef PHMASK
#define PHMASK 0xFFFFFFFFu
#endif
#define IN(k) (((PHMASK >> (k)) & 1u) && lo <= (k) && (k) < hi)
#define SEAM(k) do { if (!MK_PER_PHASE_LAUNCH && IN((k) + 1)) xcd_barrier(bar); else __syncthreads(); } while (0)
#define CTX_LOCALS \
    const Args& args = *C.a; unsigned char* lds = C.lds; const XcdBarrier bar = C.bar; const int tid = C.tid, lane = C.lane, wave = C.wave, G = C.G, bid = C.bid, gw = C.gw, NGW = C.NGW; \
    const long gt = C.gt, NGT = C.NGT; unsigned char* ws = args.ws; unsigned* ctl = (unsigned*)(ws + WS_CTL); float* smf = (float*)lds; const int lo = args.ph_lo, hi = args.ph_hi; \
    (void)lane; (void)wave; (void)gw; (void)NGW; (void)gt; (void)NGT; (void)ctl; (void)smf; (void)bid; (void)G;
#define WS_PTRS \
    float* modv = (float*)(ws + WS_MODV); \
    bf16_t* HALL = (bf16_t*)(ws + WS_HALL); bf16_t* Qb = (bf16_t*)(ws + WS_Q); bf16_t* Kb = (bf16_t*)(ws + WS_K); bf16_t* Vb = (bf16_t*)(ws + WS_V); \
    float* OATT = (float*)(ws + WS_OATT); bf16_t* ATT = (bf16_t*)(ws + WS_ATT); \
    float* Y = (float*)(ws + WS_Y); float* X1 = (float*)(ws + WS_X1); float* X2 = (float*)(ws + WS_X2); \
    bf16_t* HM = (bf16_t*)(ws + WS_HM); bf16_t* H1 = (bf16_t*)(ws + WS_H1); \
    float* LOG = (float*)(ws + WS_LOG); float* YF = (float*)(ws + WS_YF); \
    bf16_t* HS = (bf16_t*)(ws + WS_HS); float* GS = (float*)(ws + WS_GS); \
    int* IDX = (int*)(ws + WS_IDX); float* WGT = (float*)(ws + WS_WGT); int* POS = (int*)(ws + WS_POS); \
    int* STOK = (int*)(ws + WS_STOK); float* SW = (float*)(ws + WS_SW); \
    bf16_t* Ub = (bf16_t*)(ws + WS_U); float* VV = (float*)(ws + WS_VV); float* VN = (float*)(ws + WS_VN); bf16_t* GSP = (bf16_t*)(ws + WS_GSP); \

template <int L> __device__ __forceinline__ void layer_tail(const Ctx& C) {
    CTX_LOCALS
    WS_PTRS

                const float* xin = (L == 0) ? args.in[I_X] : X2;
        const float* modl = modv + (size_t)L * 5 * 6144;
        unsigned* cnt = ctl + CW_CNT + L * 256;
        if (L == 1) {
            if (IN(14)) {
                const LoadBf16 la{H1, D, nullptr};
                for (int it = bid; it < (T / 128) * 32; it += G) {
                    const int mt = it / 32, nt = it % 32;
                    auto epi = [=](int r, int c, f32x4 va, f32x4 vb) { const float v[8] = {va.x, va.y, va.z, va.w, vb.x, vb.y, vb.z, vb.w};
                        float z[8];
#pragma unroll
                        for (int j = 0; j < 8; ++j) z[j] = gelu_erf(v[j] + args.in[I_SBIN][c + j]);
                        if (c < SGU_DFF) *(u32x4*)(Ub + (size_t)r * SGU_DFF + c) = (u32x4){pk2(z[0], z[1]), pk2(z[2], z[3]), pk2(z[4], z[5]), pk2(z[6], z[7])};
                        else { float* dst = VV + (size_t)r * SGU_DFF + (c - SGU_DFF); *(f32x4*)dst = (f32x4){z[0], z[1], z[2], z[3]}; *(f32x4*)(dst + 4) = (f32x4){z[4], z[5], z[6], z[7]}; } };
                    gemm_tile(la, args.in[I_SWIN], 2 * SGU_DFF, D, mt * 128, nt * 128, smf, epi);
                }
                SEAM(14);
            }
            if (IN(15)) {
                for (int row = gw; row < T; row += NGW) {
                    f32x4 v[8]; float s = 0.f;
#pragma unroll
                    for (int j = 0; j < 8; ++j) { v[j] = *(const f32x4*)(VV + (size_t)row * SGU_DFF + j * 256 + lane * 4); s += (v[j].x + v[j].y) + (v[j].z + v[j].w); }
                    const float mean = wave_sum(s) * (1.f / SGU_DFF); float s2 = 0.f;
#pragma unroll
                    for (int j = 0; j < 8; ++j) { v[j] = v[j] - mean; s2 += (v[j].x * v[j].x + v[j].y * v[j].y) + (v[j].z * v[j].z + v[j].w * v[j].w); }
                    const float rstd = 1.f / sqrtf(wave_sum(s2) * (1.f / SGU_DFF) + LN_EPS);
#pragma unroll
                    for (int j = 0; j < 8; ++j) { const int c = j * 256 + lane * 4;
                        *(f32x4*)(VN + (size_t)row * SGU_DFF + c) = v[j] * rstd * *(const f32x4*)(args.in[I_SNG] + c) + *(const f32x4*)(args.in[I_SNB] + c); }
                }
                SEAM(15);
            }
            if (IN(16)) {
                for (int it = bid; it < (T / SGU_CH) * SGU_G * 2; it += G) {
                    const int nt = it & 1, g = (it >> 1) & 7, chunk = it >> 4;
                    const LoadF32 la{args.in[I_SWS] + (size_t)g * SGU_CH * SGU_CH, SGU_CH};
                    const float* Wv = VN + (size_t)chunk * SGU_CH * SGU_DFF + g * SGU_GC;
                    auto epi = [=](int p, int c, f32x4 va, f32x4 vb) { const float v[8] = {va.x, va.y, va.z, va.w, vb.x, vb.y, vb.z, vb.w};
                        const size_t off = (size_t)(chunk * SGU_CH + p) * SGU_DFF + g * SGU_GC + c; const float bs = args.in[I_SBS][g * SGU_CH + p];
                        const u32x4 uw = *(const u32x4*)(Ub + off);
                        const float u0 = bf2f(uw.x & 0xffffu), u1 = bf2f(uw.x >> 16), u2 = bf2f(uw.y & 0xffffu), u3 = bf2f(uw.y >> 16), u4 = bf2f(uw.z & 0xffffu), u5 = bf2f(uw.z >> 16), u6 = bf2f(uw.w & 0xffffu), u7 = bf2f(uw.w >> 16);
                        *(u32x4*)(GSP + off) = (u32x4){pk2(u0 * (v[0] + bs), u1 * (v[1] + bs)), pk2(u2 * (v[2] + bs), u3 * (v[3] + bs)), pk2(u4 * (v[4] + bs), u5 * (v[5] + bs)), pk2(u6 * (v[6] + bs), u7 * (v[7] + bs))}; };
                    gemm_tile(la, Wv, SGU_DFF, SGU_CH, 0, nt * 128, smf, epi);
                }
                SEAM(16);
            }
            if (IN(17)) {
                const LoadBf16 la{GSP, SGU_DFF, nullptr};
                for (int it = bid; it < (T / 128) * 8; it += G) {
                    const int mt = it / 8, nt = it % 8;
                    auto epi = [=](int r, int c, f32x4 va, f32x4 vb) { const float v[8] = {va.x, va.y, va.z, va.w, vb.x, vb.y, vb.z, vb.w}; float* dst = Y + (size_t)r * D + c; *(f32x4*)dst = (f32x4){v[0], v[1], v[2], v[3]}; *(f32x4*)(dst + 4) = (f32x4){v[4], v[5], v[6], v[7]}; };
                    gemm_tile(la, args.in[I_SWOUT], D, SGU_DFF, mt * 128, nt * 128, smf, epi);
                }
                SEAM(17);
            }
        }
        const int P_LN = (L == 0) ? 7 : 18;
        if (IN(P_LN)) {
            ln_rows(xin, Y, X1, HM, args.in[I_LNG] + (L * 2 + 0) * D, args.in[I_LNB] + (L * 2 + 0) * D, modl, 2048, modl, 4096, gw, NGW, lane);
            for (long i = gt; i < (long)T * D / 4; i += NGT) *(f32x4*)(YF + i * 4) = (f32x4){0.f, 0.f, 0.f, 0.f};
            SEAM(P_LN);
        }
        if (IN(P_LN + 1)) {
            auto la = [=](int r, int k) -> f32x4 { const float* mb = modl + (r / SEQ) * 6144;
                return *(const f32x4*)(X1 + (size_t)r * D + k) * (*(const f32x4*)(mb + 4096 + k) + 1.f) + *(const f32x4*)(mb + 3072 + k); };
            for (int it = bid; it < (T / 128) * 2; it += G) {
                const int mt = it / 2, nt = it % 2;
                auto epi = [=](int r, int c, f32x4 va, f32x4 vb) { const float v[8] = {va.x, va.y, va.z, va.w, vb.x, vb.y, vb.z, vb.w}; float* dst = LOG + (size_t)r * NE + c; *(f32x4*)dst = (f32x4){v[0], v[1], v[2], v[3]}; *(f32x4*)(dst + 4) = (f32x4){v[4], v[5], v[6], v[7]}; };
                gemm_tile(la, args.in[I_RW] + (size_t)L * D * NE, NE, D, mt * 128, nt * 128, smf, epi);
            }
            SEAM(P_LN + 1);
        }
        if (IN(P_LN + 2)) {
            const float* rb = args.in[I_RB] + L * NE;
            const f32x4 bias = *(const f32x4*)(rb + lane * 4);
            for (int t = gw; t < T; t += NGW) {
                const f32x4 lg = *(const f32x4*)(LOG + (size_t)t * NE + lane * 4);
                float sc[4], ch[4];
#pragma unroll
                for (int i = 0; i < 4; ++i) { sc[i] = sigmoidf_(lg[i]); ch[i] = sc[i] + bias[i]; }
                float m1 = fmaxf(ch[0], ch[1]), m2 = fminf(ch[0], ch[1]);
#pragma unroll
                for (int i = 2; i < 4; ++i) { const float v = ch[i]; m2 = fmaxf(m2, fminf(m1, v)); m1 = fmaxf(m1, v); }
#pragma unroll
                for (int o = 1; o < 8; o <<= 1) { const float b1 = __shfl_xor(m1, o), b2 = __shfl_xor(m2, o); const float n1 = fmaxf(m1, b1), n2 = fmaxf(fminf(m1, b1), fmaxf(m2, b2)); m1 = n1; m2 = n2; }
                const float gs = m1 + m2; const int g = lane >> 3; int rank = 0;
#pragma unroll
                for (int gg = 0; gg < 8; ++gg) { const float o = __shfl(gs, gg * 8); rank += (o > gs || (o == gs && gg < g)) ? 1 : 0; }
                const bool sel = rank < 4;
                float cm[4];
#pragma unroll
                for (int i = 0; i < 4; ++i) cm[i] = sel ? ch[i] : -INFINITY;
                float wsum = 0.f, myw = 0.f; int myidx = 0;
#pragma unroll
                for (int k = 0; k < TOPK; ++k) {
                    float bv = cm[0]; int bi = lane * 4;
#pragma unroll
                    for (int i = 1; i < 4; ++i) if (cm[i] > bv) { bv = cm[i]; bi = lane * 4 + i; }
#pragma unroll
                    for (int o = 1; o < 64; o <<= 1) { const float ov = __shfl_xor(bv, o); const int oi = __shfl_xor(bi, o); if (ov > bv || (ov == bv && oi < bi)) { bv = ov; bi = oi; } }
                    const int sub = bi & 3; const float mysc = sub == 0 ? sc[0] : sub == 1 ? sc[1] : sub == 2 ? sc[2] : sc[3];
                    const float wv = __shfl(mysc, bi >> 2);
                    if ((bi >> 2) == lane) { if (sub == 0) cm[0] = -INFINITY; else if (sub == 1) cm[1] = -INFINITY; else if (sub == 2) cm[2] = -INFINITY; else cm[3] = -INFINITY; }
                    wsum += wv; if (lane == k) { myw = wv; myidx = bi; }
                }
                if (lane < TOPK) {
                    IDX[t * TOPK + lane] = myidx; WGT[t * TOPK + lane] = myw / wsum * ROUTED_SCALE;
                    POS[t * TOPK + lane] = (int)atomicAdd(cnt + myidx, 1u);
                }
            }
            SEAM(P_LN + 2);
        }
        if (IN(P_LN + 3)) {
            int* ps = (int*)lds;
            expert_prefix(cnt, ps, tid);
            for (long p = gt; p < TK; p += NGT) { const int e = IDX[p]; const int slot = ps[e] + POS[p]; STOK[slot] = (int)(p >> 3); SW[slot] = WGT[p]; }
            for (int e = bid; e < NE; e += G) { const int c = (int)cnt[e], pe = ps[e + 1] - ps[e]; for (int s = c + tid; s < pe; s += NTHR) { STOK[ps[e] + s] = 0; SW[ps[e] + s] = 0.f; } }
            SEAM(P_LN + 3);
        }
        if (IN(P_LN + 4)) {
            int* ps = (int*)(lds + 65536);
            expert_prefix(cnt, ps, tid);
            const int nrt = ps[256] / PADM, nst = T / PADM;
            for (int it = bid; it < (nrt + nst) * 2; it += G) {
                const int nt = it & 1, rt = it >> 1; const bool shared = rt >= nrt;
                int e = 0; size_t hsrow0;
                const float *wg, *wu; LoadBf16 la{HM, D, nullptr}; int m0;
                if (!shared) { const int r0 = rt * PADM; int a = 0, bnd = 256; while (bnd - a > 1) { const int mid = (a + bnd) >> 1; if (ps[mid] <= r0) a = mid; else bnd = mid; } e = a;
                    wg = args.in[I_EWG] + ((size_t)L * NE + e) * D * EDFF; wu = args.in[I_EWU] + ((size_t)L * NE + e) * D * EDFF; la.rowidx = STOK; m0 = r0; hsrow0 = 0; }
                else { wg = args.in[I_SHG] + (size_t)L * D * EDFF; wu = args.in[I_SHU] + (size_t)L * D * EDFF; m0 = (rt - nrt) * PADM; hsrow0 = PMAX; }
                auto epi1 = [=](int r, int c, f32x4 va, f32x4 vb) { const float v[8] = {va.x, va.y, va.z, va.w, vb.x, vb.y, vb.z, vb.w}; float* dst = GS + (hsrow0 + r) * EDFF + c; *(f32x4*)dst = (f32x4){v[0], v[1], v[2], v[3]}; *(f32x4*)(dst + 4) = (f32x4){v[4], v[5], v[6], v[7]}; };
                gemm_tile(la, wg, EDFF, D, m0, nt * 128, smf, epi1);
                auto epi2 = [=](int r, int c, f32x4 va, f32x4 vb) { const float v[8] = {va.x, va.y, va.z, va.w, vb.x, vb.y, vb.z, vb.w}; const float* gp = GS + (hsrow0 + r) * EDFF + c; const f32x4 g0 = *(const f32x4*)gp, g1 = *(const f32x4*)(gp + 4);
                    *(u32x4*)(HS + (hsrow0 + r) * EDFF + c) = (u32x4){pk2(siluf(g0.x) * v[0], siluf(g0.y) * v[1]), pk2(siluf(g0.z) * v[2], siluf(g0.w) * v[3]), pk2(siluf(g1.x) * v[4], siluf(g1.y) * v[5]), pk2(siluf(g1.z) * v[6], siluf(g1.w) * v[7])}; };
                gemm_tile(la, wu, EDFF, D, m0, nt * 128, smf, epi2);
            }
            SEAM(P_LN + 4);
        }
        if (IN(P_LN + 5)) {
            int* ps = (int*)(lds + 65536);
            expert_prefix(cnt, ps, tid);
            const int nrt = ps[256] / PADM, nst = T / PADM;
            for (int it = bid; it < (nrt + nst) * 8; it += G) {
                const int nt = it & 7, rt = it >> 3; const bool shared = rt >= nrt;
                const float* wd; int m0; size_t hsrow0;
                if (!shared) { const int r0 = rt * PADM; int a = 0, bnd = 256; while (bnd - a > 1) { const int mid = (a + bnd) >> 1; if (ps[mid] <= r0) a = mid; else bnd = mid; }
                    wd = args.in[I_EWD] + ((size_t)L * NE + a) * EDFF * D; m0 = r0; hsrow0 = 0; }
                else { wd = args.in[I_SHD] + (size_t)L * EDFF * D; m0 = (rt - nrt) * PADM; hsrow0 = PMAX; }
                const LoadBf16 la{HS + hsrow0 * EDFF, EDFF, nullptr};
                auto epi = [=](int r, int c, f32x4 va, f32x4 vb) { const float v[8] = {va.x, va.y, va.z, va.w, vb.x, vb.y, vb.z, vb.w}; const int tok = shared ? r : STOK[r]; const float w = shared ? 1.f : SW[r];
                    if (w != 0.f) { float* dst = YF + (size_t)tok * D + c;
#pragma unroll
                        for (int j = 0; j < 8; ++j) atomicAdd(dst + j, w * v[j]); } };
                gemm_tile(la, wd, D, EDFF, m0, nt * 128, smf, epi);
            }
            SEAM(P_LN + 5);
        }
        if (IN(P_LN + 6)) {
            if (L == 0) ln_rows(X1, YF, X2, H1, args.in[I_LNG] + (L * 2 + 1) * D, args.in[I_LNB] + (L * 2 + 1) * D, modl, 5120, modv + (size_t)5 * 6144, 1024, gw, NGW, lane);
            else ln_rows(X1, YF, args.out, nullptr, args.in[I_LNG] + (L * 2 + 1) * D, args.in[I_LNB] + (L * 2 + 1) * D, modl, 5120, nullptr, 0, gw, NGW, lane);
            SEAM(P_LN + 6);
        }
    }

__global__ void __launch_bounds__(NTHR, 2) mega(Args args) {
    extern __shared__ __attribute__((aligned(16))) unsigned char lds[];
    const int tid = threadIdx.x, lane = tid & 63, wave = __builtin_amdgcn_readfirstlane(tid >> 6);
    const int G = gridDim.x, bid = blockIdx.x;
    const int gw = bid * NWAVES + wave, NGW = G * NWAVES;
    const long gt = (long)bid * NTHR + tid, NGT = (long)G * NTHR;
    unsigned char* ws = args.ws;
    unsigned* ctl = (unsigned*)(ws + WS_CTL);
    float* smf = (float*)lds;

    for (int u = tid; u < (LDS_BYTES - LDS_MISC) / 4; u += NTHR) ((unsigned*)(lds + LDS_MISC))[u] = 0u;
    __syncthreads();
    XcdBarrier bar; bar.bar = ctl + CW_BAR; bar.x = 0; bar.st = nullptr;
    if (!MK_PER_PHASE_LAUNCH) bar = xcd_barrier_post(ctl + CW_BAR, (volatile LAS unsigned*)(lds + LDS_MISC) + 8);

    const int lo = args.ph_lo, hi = args.ph_hi;

    float* modv = (float*)(ws + WS_MODV);
    bf16_t* HALL = (bf16_t*)(ws + WS_HALL); bf16_t* Qb = (bf16_t*)(ws + WS_Q); bf16_t* Kb = (bf16_t*)(ws + WS_K); bf16_t* Vb = (bf16_t*)(ws + WS_V);
    float* OATT = (float*)(ws + WS_OATT); bf16_t* ATT = (bf16_t*)(ws + WS_ATT);
    float* Y = (float*)(ws + WS_Y); float* X1 = (float*)(ws + WS_X1); float* X2 = (float*)(ws + WS_X2);
    bf16_t* HM = (bf16_t*)(ws + WS_HM); bf16_t* H1 = (bf16_t*)(ws + WS_H1);
    float* LOG = (float*)(ws + WS_LOG); float* YF = (float*)(ws + WS_YF);
    bf16_t* HS = (bf16_t*)(ws + WS_HS); float* GS = (float*)(ws + WS_GS);
    int* IDX = (int*)(ws + WS_IDX); float* WGT = (float*)(ws + WS_WGT); int* POS = (int*)(ws + WS_POS);
    int* STOK = (int*)(ws + WS_STOK); float* SW = (float*)(ws + WS_SW);
    bf16_t* Ub = (bf16_t*)(ws + WS_U); float* VV = (float*)(ws + WS_VV); float* VN = (float*)(ws + WS_VN); bf16_t* GSP = (bf16_t*)(ws + WS_GSP);

    if (IN(0)) {
        float* sc = smf;
        float* red = smf + 5 * 1024;
        for (int i = tid; i < 5 * 1024; i += NTHR) { const int r = i >> 10, k = i & 1023; const float c = r < 4 ? args.in[I_C][r * D + k] : args.in[I_CCTX][k]; sc[i] = siluf(c); }
        __syncthreads();
        for (int it = bid; it < 2 * 96; it += G) {
            const int l = it / 96, j = (it % 96) * 64 + lane;
            const float* w = args.in[I_WMOD] + (size_t)l * D * 6144 + j;
            float a0 = 0, a1 = 0, a2 = 0, a3 = 0, a4 = 0;
            for (int k = wave * 128; k < wave * 128 + 128; ++k) { const float wv = w[(size_t)k * 6144]; a0 += sc[k] * wv; a1 += sc[1024 + k] * wv; a2 += sc[2048 + k] * wv; a3 += sc[3072 + k] * wv; a4 += sc[4096 + k] * wv; }
            red[(wave * 5 + 0) * 64 + lane] = a0; red[(wave * 5 + 1) * 64 + lane] = a1; red[(wave * 5 + 2) * 64 + lane] = a2; red[(wave * 5 + 3) * 64 + lane] = a3; red[(wave * 5 + 4) * 64 + lane] = a4;
            __syncthreads();
            if (tid < 320) { const int r = tid >> 6, jj = tid & 63; float s = 0.f;
#pragma unroll
                for (int w8 = 0; w8 < 8; ++w8) s += red[(w8 * 5 + r) * 64 + jj];
                const int col = (it % 96) * 64 + jj;
                modv[((size_t)l * 5 + r) * 6144 + col] = s + args.in[I_BMOD][l * 6144 + col]; }
            __syncthreads();
        }
        SEAM(0);
    }
    if (IN(1)) {
        for (long i = gt; i < (long)TA * (D / 4); i += NGT) {
            const int row = (int)(i >> 8), c = (int)(i & 255) * 4, b = row / SEQA, n = row % SEQA;
            const float* src = n < SEQ ? args.in[I_X] + ((size_t)b * SEQ + n) * D + c : args.in[I_CTX] + ((size_t)b * CTX + (n - SEQ)) * D + c;
            const float* mb = modv + (n < SEQ ? b : 4) * 6144;
            const f32x4 h = *(const f32x4*)src * (*(const f32x4*)(mb + 1024 + c) + 1.f) + *(const f32x4*)(mb + c);
            *(u32x2*)(HALL + (size_t)row * D + c) = (u32x2){pk2(h.x, h.y), pk2(h.z, h.w)};
        }
        SEAM(1);
    }
    if (IN(2)) {
        const LoadBf16 la{HALL, D, nullptr};
        for (int it = bid; it < (TA / 128) * 24; it += G) {
            const int mt = it / 24, nt = it % 24;
            auto epi = [=](int r, int c, f32x4 va, f32x4 vb) { const float v[8] = {va.x, va.y, va.z, va.w, vb.x, vb.y, vb.z, vb.w}; bf16_t* dst = Qb + (size_t)(c >> 10) * ((WS_K - WS_Q) / 2) + (size_t)r * D + (c & 1023);
                *(u32x4*)dst = (u32x4){pk2(v[0], v[1]), pk2(v[2], v[3]), pk2(v[4], v[5]), pk2(v[6], v[7])}; };
            gemm_tile(la, args.in[I_AWIN], 3 * D, D, mt * 128, nt * 128, smf, epi);
        }
        SEAM(2);
    }
    if (IN(3)) {
        for (long i = gt; i < (long)T * 2 * 16 * 2 * 16; i += NGT) {
            const int j = (int)(i & 15), ch = (int)(i >> 4) & 1, hm = (int)(i >> 5) & 15, wh = (int)(i >> 9) & 1; const long tok = i >> 10;
            const int b = (int)(tok / SEQ), n = (int)(tok % SEQ);
            const int pos = ch == 0 ? n / 64 : n % 64;
            const float inv = __powf(10000.f, -(float)j / 16.f), ang = (float)pos * inv;
            const float sn = __sinf(ang), cs = __cosf(ang);
            bf16_t* p = (wh ? Kb : Qb) + ((size_t)b * SEQA + n) * D + hm * 64 + ch * 32 + j;
            const float x1 = bf2f(p[0]), x2 = bf2f(p[16]);
            p[0] = (bf16_t)f2bf(x1 * cs - x2 * sn); p[16] = (bf16_t)f2bf(x2 * cs + x1 * sn);
        }
        SEAM(3);
    }
    if (IN(4)) {
        float* Ks = smf; float* Vs = smf + 64 * 64;
        for (int it = bid; it < BATCH * NH * 2 * (SEQ / 512) * 2; it += G) {
            const int vh = it & 1, qb = (it >> 1) & 15, m = (it >> 5) & 1, h = (it >> 6) & 7, b = it >> 9;
            const int q = qb * 512 + tid;
            float qr[64], o[64];
            { const bf16_t* qp = Qb + ((size_t)b * SEQA + q) * D + h * 128 + m * 64;
#pragma unroll
              for (int d = 0; d < 64; d += 2) { const unsigned w = *(const unsigned*)(qp + d); qr[d] = bf2f(w & 0xffffu) * 0.125f; qr[d + 1] = bf2f(w >> 16) * 0.125f; } }
#pragma unroll
            for (int e = 0; e < 64; ++e) o[e] = 0.f;
            float mx = -1e30f, l = 0.f;
            for (int k0 = 0; k0 < SEQA; k0 += 64) {
                __syncthreads();
                {
                    const int kr = tid >> 3, kc = (tid & 7) * 8;
                    const u32x4 kw = *(const u32x4*)(Kb + ((size_t)b * SEQA + k0 + kr) * D + h * 128 + m * 64 + kc);
                    float* kd = Ks + kr * 64 + kc;
                    kd[0] = bf2f(kw.x & 0xffffu); kd[1] = bf2f(kw.x >> 16); kd[2] = bf2f(kw.y & 0xffffu); kd[3] = bf2f(kw.y >> 16);
                    kd[4] = bf2f(kw.z & 0xffffu); kd[5] = bf2f(kw.z >> 16); kd[6] = bf2f(kw.w & 0xffffu); kd[7] = bf2f(kw.w >> 16);
                    const u32x4 vw = *(const u32x4*)(Vb + ((size_t)b * SEQA + k0 + kr) * D + h * 128 + vh * 64 + kc);
                    float* vd = Vs + kr * 64 + kc;
                    vd[0] = bf2f(vw.x & 0xffffu); vd[1] = bf2f(vw.x >> 16); vd[2] = bf2f(vw.y & 0xffffu); vd[3] = bf2f(vw.y >> 16);
                    vd[4] = bf2f(vw.z & 0xffffu); vd[5] = bf2f(vw.z >> 16); vd[6] = bf2f(vw.w & 0xffffu); vd[7] = bf2f(vw.w >> 16);
                }
                __syncthreads();
                for (int j = 0; j < 64; ++j) {
                    float s = 0.f;
#pragma unroll
                    for (int d = 0; d < 64; d += 4) { const f32x4 kv = *(const f32x4*)&Ks[j * 64 + d]; s += qr[d] * kv.x + qr[d + 1] * kv.y + qr[d + 2] * kv.z + qr[d + 3] * kv.w; }
                    if (s > mx) { const float a = __expf(mx - s); l *= a;
#pragma unroll
                        for (int e = 0; e < 64; ++e) o[e] *= a;
                        mx = s; }
                    const float p = __expf(s - mx); l += p;
#pragma unroll
                    for (int e = 0; e < 64; e += 4) { const f32x4 vv = *(const f32x4*)&Vs[j * 64 + e]; o[e] += p * vv.x; o[e + 1] += p * vv.y; o[e + 2] += p * vv.z; o[e + 3] += p * vv.w; }
                }
            }
            const float rl = 1.f / l;
            float* op = OATT + (((size_t)b * SEQ + q) * NH + h) * 256 + m * 128 + vh * 64;
#pragma unroll
            for (int e = 0; e < 64; e += 4) *(f32x4*)(op + e) = (f32x4){o[e] * rl, o[e + 1] * rl, o[e + 2] * rl, o[e + 3] * rl};
        }
        SEAM(4);
    }
    if (IN(5)) {
        const float* lp = args.in[I_ALAM];
        const float l1 = wave_sum(lp[lane] * lp[64 + lane]), l2 = wave_sum(lp[128 + lane] * lp[192 + lane]);
        const float lam = __expf(l1) - __expf(l2) + LAM_INIT;
        for (int row = gw; row < T; row += NGW) {
            const int h = lane >> 3, e0 = (lane & 7) * 16;
            const float* o0 = OATT + ((size_t)row * NH + h) * 256 + e0; const float* o1 = o0 + 128;
            float v[16]; float ss = 0.f;
#pragma unroll
            for (int e = 0; e < 16; ++e) { v[e] = o0[e] - lam * o1[e]; ss += v[e] * v[e]; }
            ss += __shfl_xor(ss, 1); ss += __shfl_xor(ss, 2); ss += __shfl_xor(ss, 4);
            const float r = (1.f - LAM_INIT) / sqrtf(ss * (1.f / DV) + LN_EPS);
            unsigned w[8];
#pragma unroll
            for (int e = 0; e < 16; e += 2) w[e >> 1] = pk2(v[e] * r * args.in[I_ASUBG][e0 + e], v[e + 1] * r * args.in[I_ASUBG][e0 + e + 1]);
            bf16_t* dst = ATT + (size_t)row * D + h * 128 + e0;
            *(u32x4*)dst = (u32x4){w[0], w[1], w[2], w[3]}; *(u32x4*)(dst + 8) = (u32x4){w[4], w[5], w[6], w[7]};
        }
        SEAM(5);
    }
    if (IN(6)) {
        const LoadBf16 la{ATT, D, nullptr};
        for (int it = bid; it < (T / 128) * 8; it += G) {
            const int mt = it / 8, nt = it % 8;
            auto epi = [=](int r, int c, f32x4 va, f32x4 vb) { const float v[8] = {va.x, va.y, va.z, va.w, vb.x, vb.y, vb.z, vb.w}; float* dst = Y + (size_t)r * D + c; *(f32x4*)dst = (f32x4){v[0], v[1], v[2], v[3]}; *(f32x4*)(dst + 4) = (f32x4){v[4], v[5], v[6], v[7]}; };
            gemm_tile(la, args.in[I_AWOUT], D, D, mt * 128, nt * 128, smf, epi);
        }
        SEAM(6);
    }

    { Ctx C; C.a = &args; C.lds = lds; C.bar = bar; C.tid = tid; C.lane = lane; C.wave = wave; C.G = G; C.bid = bid; C.gw = gw; C.NGW = NGW; C.gt = gt; C.NGT = NGT;
      layer_tail<0>(C); layer_tail<1>(C); }
#undef IN
#undef SEAM
}

extern "C" void kernel_launch(void* const* d_in, const int* in_sizes, int n_in, void* d_out, int out_size, void* d_ws, size_t ws_size, hipStream_t stream) {
    static int grid = 0;
    if (grid == 0) {
        if (n_in != 27 || out_size != T * D || ws_size < WS_END) { fprintf(stderr, "kernel_launch: unexpected shapes n_in %d out %d ws %zu (need %zu)\n", n_in, out_size, ws_size, (size_t)WS_END); grid = -1; return; }
        int dev = 0, cus = 0, per_cu = 0;
        if (hipGetDevice(&dev) != hipSuccess || hipDeviceGetAttribute(&cus, hipDeviceAttributeMultiprocessorCount, dev) != hipSuccess) { grid = -1; return; }
        if (hipFuncSetAttribute((const void*)mega, hipFuncAttributeMaxDynamicSharedMemorySize, LDS_BYTES) != hipSuccess) { fprintf(stderr, "kernel_launch: hipFuncSetAttribute failed\n"); grid = -1; return; }
        if (hipOccupancyMaxActiveBlocksPerMultiprocessor(&per_cu, (const void*)mega, NTHR, LDS_BYTES) != hipSuccess || per_cu < 1) fprintf(stderr, "kernel_launch: occupancy query reports %d\n", per_cu);
        (void)hipGetLastError();
        grid = cus;
    }
    if (grid < 0) return;
    if (hipMemsetAsync((char*)d_ws + WS_CTL, 0, CTL_ZERO_BYTES, stream) != hipSuccess) return;
    Args a{};
    for (int i = 0; i < 27; ++i) a.in[i] = (const float*)d_in[i];
    a.out = (float*)d_out; a.ws = (unsigned char*)d_ws;
#if MK_PER_PHASE_LAUNCH
    for (int p = 0; p < N_PHASES; ++p) { a.ph_lo = p; a.ph_hi = p + 1; hipLaunchKernelGGL(mega, dim3(grid), dim3(NTHR), LDS_BYTES, stream, a); }
#else
    a.ph_lo = 0; a.ph_hi = N_PHASES;
    hipLaunchKernelGGL(mega, dim3(grid), dim3(NTHR), LDS_BYTES, stream, a);
#endif
    const hipError_t le = hipPeekAtLastError();
    if (le != hipSuccess) fprintf(stderr, "kernel_launch: launch failed: %s\n", hipGetErrorName(le));
}
```

```cpp
#include <hip/hip_runtime.h>
#include <cstdio>
#include <cstdint>

#ifndef MK_PER_PHASE_LAUNCH
#define MK_PER_PHASE_LAUNCH 0
#endif
#ifndef FAST_DENSE
#define FAST_DENSE 1
#endif
#ifndef FAST_MOE
#define FAST_MOE 1
#endif

#define GAS __attribute__((address_space(1)))
#define LAS __attribute__((address_space(3)))
typedef unsigned short bf16_t;
typedef float f32x4 __attribute__((ext_vector_type(4)));
typedef float f32x2 __attribute__((ext_vector_type(2)));
typedef unsigned u32x4 __attribute__((ext_vector_type(4)));
typedef unsigned u32x2 __attribute__((ext_vector_type(2)));

constexpr int D = 1024, BATCH = 4, SEQ = 8192, CTX = 256, T = BATCH * SEQ, SEQA = SEQ + CTX, TA = BATCH * SEQA;
constexpr int NH = 8, HD = 64, DV = 128;
constexpr int SGU_DFF = 2048, SGU_CH = 128, SGU_G = 8, SGU_GC = 256;
constexpr int NE = 256, TOPK = 8, NGRP = 8, EDFF = 256;
constexpr int TK = T * TOPK;
constexpr int PADM = 256;
constexpr int PMAX = TK + NE * PADM;
constexpr float LN_EPS = 1e-5f, ALPHA = 1.4142135623730951f, ROUTED_SCALE = 2.5f;
constexpr float LAM_INIT = 0.2f;
constexpr int NWAVES = 8, NTHR = 512;

constexpr size_t MiB = 1u << 20;
constexpr size_t WS_CTL = 0, CTL_ZERO_BYTES = 1 * MiB;
constexpr int CW_BAR = 4096;
constexpr int CW_CNT = 32768;
constexpr size_t WS_MODV = 1 * MiB;
constexpr size_t WS_ROPE = WS_MODV + 512 * 1024;
constexpr size_t WS_IDX = 2 * MiB, WS_WGT = 3 * MiB, WS_POS = 4 * MiB;
constexpr size_t WS_SPAIR = 5 * MiB, WS_SW = 7 * MiB;
constexpr size_t WS_WIN_T = 16 * MiB;
constexpr size_t WS_WOUT_T = 22 * MiB;
constexpr size_t WS_SWIN_T = 24 * MiB;
constexpr size_t WS_SWOUT_T = 32 * MiB;
constexpr size_t WS_SHUP_T = 36 * MiB;
constexpr size_t WS_SHDN_T = 38 * MiB;
constexpr size_t WS_EUP_T = 48 * MiB;
constexpr size_t WS_EDN_T = 560 * MiB;
constexpr size_t WS_R = 816 * MiB;
constexpr size_t WS_HALL = WS_R, WS_Q = WS_R + 66 * MiB, WS_K = WS_R + 132 * MiB, WS_V = WS_R + 198 * MiB, WS_OATT = WS_R + 264 * MiB, WS_ATT = WS_R + 520 * MiB;
constexpr size_t WS_U = WS_R, WS_VB = WS_R + 128 * MiB, WS_GSP = WS_R + 256 * MiB, WS_VN = WS_R + 384 * MiB;
constexpr size_t WS_HO = WS_R;
constexpr size_t WS_Y = WS_R + 640 * MiB;
constexpr size_t WS_X1 = WS_Y + 64 * MiB;
constexpr size_t WS_HM = WS_X1 + 128 * MiB;
constexpr size_t WS_H1 = WS_HM + 64 * MiB;
constexpr size_t WS_LOG = WS_H1 + 64 * MiB;
constexpr size_t WS_HS = WS_LOG + 32 * MiB;
constexpr size_t WS_END = WS_HS + 176 * MiB;
static_assert(WS_END <= (size_t)2048 * MiB, "workspace map exceeds 2 GiB");
static_assert((size_t)(PMAX + T) * EDFF * 2 <= 176 * MiB && (size_t)TA * D * 2 <= 66 * MiB && (size_t)(TK + T + 1) * D * 2 <= 640 * MiB, "ws sizes");
static_assert((size_t)(PMAX + T) * 4 <= 2 * MiB, "slot tables");

constexpr int LDS_BYTES = 163840;
constexpr int LDS_MISC = 131072;
constexpr int LDS_PS = LDS_MISC + 256;
constexpr int LDS_TAB = LDS_MISC + 2048;
constexpr int MAXU_UP = 14, MAXU_DN = 28;
static_assert(LDS_TAB + 28 * 1024 <= LDS_BYTES, "LDS map");

#define XB_TMO      128
#define XB_XCNT(j)  (256  + 64 * (j))
#define XB_XSUB(j)  (1280 + 64 * (j))
#define XB_XGEN(j)  (2304 + 64 * (j))
#define XB_TOP      3328
#define XB_TOPGEN   3392
#define XCD_BAR_WORDS 3456
#define XB_SPIN_CAP (1u << 22)

__device__ __forceinline__ unsigned xb_ld(unsigned* p)              { return __hip_atomic_load(p, __ATOMIC_RELAXED, __HIP_MEMORY_SCOPE_AGENT); }
__device__ __forceinline__ unsigned xb_add(unsigned* p, unsigned v) { return __hip_atomic_fetch_add(p, v, __ATOMIC_RELAXED, __HIP_MEMORY_SCOPE_AGENT); }
__device__ __forceinline__ unsigned xb_xcc_id() { return (unsigned)__builtin_amdgcn_s_getreg((3 << 11) | 20) & 0xFu; }
#define XB_SPIN(cond, bar) do { unsigned _sp = 0; while (cond) { __builtin_amdgcn_s_sleep(1); \
    if ((++_sp & 255u) == 0u) { if (xb_ld(&(bar)[XB_TMO])) break; if (_sp > XB_SPIN_CAP) { atomicAdd(&(bar)[XB_TMO], 1u); break; } } } } while (0)

struct XcdBarrier { unsigned* bar; unsigned x; volatile LAS unsigned* st; };

__device__ __forceinline__ XcdBarrier xcd_barrier_post(unsigned* bar, volatile LAS unsigned* st) {
    XcdBarrier b; b.bar = bar; b.x = xb_xcc_id(); b.st = st;
    if (threadIdx.x == 0) (void)xb_add(&bar[XB_XCNT(b.x)], 1u);
    return b;
}
__device__ __forceinline__ void xcd_barrier_complete(unsigned* bar, unsigned x, unsigned& nloc, unsigned& nx) {
    const unsigned G = gridDim.x * gridDim.y * gridDim.z;
    unsigned sum, cnt, mine, sp = 0u;
    for (;;) {
        sum = 0u; cnt = 0u; mine = 0u;
#pragma unroll
        for (unsigned j = 0; j < 16; ++j) { const unsigned c = xb_ld(&bar[XB_XCNT(j)]); sum += c; cnt += (c > 0u) ? 1u : 0u; mine = (j == x) ? c : mine; }
        if (sum == G) break;
        __builtin_amdgcn_s_sleep(1);
        if ((++sp & 255u) == 0u) { if (xb_ld(&bar[XB_TMO])) break; if (sp > XB_SPIN_CAP) { atomicAdd(&bar[XB_TMO], 1u); break; } }
    }
    nloc = mine > 0u ? mine : 1u; nx = cnt > 0u ? cnt : 1u;
}
__device__ __forceinline__ void xcd_barrier(const XcdBarrier& b) {
    asm volatile("s_waitcnt vmcnt(0)" ::: "memory");
    __syncthreads();
    if (threadIdx.x == 0) {
        unsigned* bar = b.bar;
        __builtin_amdgcn_s_waitcnt(0);
        unsigned nloc = b.st[0], nx = b.st[1];
        if (nloc == 0u) { xcd_barrier_complete(bar, b.x, nloc, nx); b.st[0] = nloc; b.st[1] = nx; }
        const unsigned old = xb_add(&bar[XB_XSUB(b.x)], 1u);
        const unsigned gen = old / nloc;
        if (old + 1u == (gen + 1u) * nloc) {
            __builtin_amdgcn_fence(__ATOMIC_RELEASE, "agent");
            asm volatile("s_waitcnt vmcnt(0)" ::: "memory");
            const unsigned og = xb_add(&bar[XB_TOP], 1u);
            const unsigned tg = og / nx;
            if (og + 1u == (tg + 1u) * nx) xb_add(&bar[XB_TOPGEN], 1u);
            else XB_SPIN(xb_ld(&bar[XB_TOPGEN]) == tg, bar);
            __builtin_amdgcn_fence(__ATOMIC_ACQUIRE, "agent");
            xb_add(&bar[XB_XGEN(b.x)], 1u);
            asm volatile("s_waitcnt vmcnt(0)" ::: "memory");
        } else {
            XB_SPIN(xb_ld(&bar[XB_XGEN(b.x)]) == gen, bar);
            __builtin_amdgcn_fence(__ATOMIC_ACQUIRE, "agent");
            asm volatile("s_waitcnt vmcnt(0)" ::: "memory");
        }
    }
    __syncthreads();
}

__device__ __forceinline__ unsigned f2bf(float f) { unsigned u = __builtin_bit_cast(unsigned, f); return (u + 0x7fffu + ((u >> 16) & 1u)) >> 16; }
__device__ __forceinline__ float bf2f(unsigned b) { return __builtin_bit_cast(float, b << 16); }
__device__ __forceinline__ unsigned pk2(float lo, float hi) { return f2bf(lo) | (f2bf(hi) << 16); }
__device__ __forceinline__ float wave_sum(float v) {
#pragma unroll
    for (int o = 1; o < 64; o <<= 1) v += __shfl_xor(v, o);
    return v;
}
__device__ __forceinline__ float siluf(float x) { return x / (1.f + __expf(-x)); }
__device__ __forceinline__ float sigmoidf_(float x) { return 1.f / (1.f + __expf(-x)); }
__device__ __forceinline__ float gelu_erf(float x) { return 0.5f * x * (1.f + erff(x * 0.70710678118654752f)); }

template <class LoadA, class Epi>
__device__ __forceinline__ void gemm_tile(const LoadA& la, const float* __restrict__ W, int ldw, int K, int m0, int n0, float* sm, const Epi& E) {
    const int tid = threadIdx.x, ty = tid >> 4, tx = tid & 15;
    float* As = sm; float* Bs = sm + 16 * 132;
    f32x4 acc[4][2];
#pragma unroll
    for (int i = 0; i < 4; ++i) { acc[i][0] = (f32x4){0.f, 0.f, 0.f, 0.f}; acc[i][1] = (f32x4){0.f, 0.f, 0.f, 0.f}; }
    const int ar = tid >> 2, k4 = (tid & 3) * 4;
    const int bk = tid >> 5, bn = (tid & 31) * 4;
    const float* bp = W + (size_t)bk * ldw + n0 + bn;
    for (int k0 = 0; k0 < K; k0 += 16) {
        const f32x4 a = la(m0 + ar, k0 + k4);
        const f32x4 b = *(const f32x4*)(bp + (size_t)k0 * ldw);
        __syncthreads();
        As[(k4 + 0) * 132 + ar] = a.x; As[(k4 + 1) * 132 + ar] = a.y; As[(k4 + 2) * 132 + ar] = a.z; As[(k4 + 3) * 132 + ar] = a.w;
        *(f32x4*)&Bs[bk * 128 + bn] = b;
        __syncthreads();
#pragma unroll 4
        for (int kk = 0; kk < 16; ++kk) {
            const f32x4 av = *(const f32x4*)&As[kk * 132 + ty * 4];
            const f32x4 b0 = *(const f32x4*)&Bs[kk * 128 + tx * 8], b1 = *(const f32x4*)&Bs[kk * 128 + tx * 8 + 4];
#pragma unroll
            for (int i = 0; i < 4; ++i) { acc[i][0] += b0 * av[i]; acc[i][1] += b1 * av[i]; }
        }
    }
#pragma unroll
    for (int i = 0; i < 4; ++i) E(m0 + ty * 4 + i, n0 + tx * 8, acc[i][0], acc[i][1]);
}
struct LoadBf16 {
    const bf16_t* A; int lda; const int* rowidx;
    __device__ __forceinline__ f32x4 operator()(int r, int k) const {
        const int rr = rowidx ? rowidx[r] : r;
        const u32x2 w = *(const u32x2*)(A + (size_t)rr * lda + k);
        return (f32x4){bf2f(w.x & 0xffffu), bf2f(w.x >> 16), bf2f(w.y & 0xffffu), bf2f(w.y >> 16)};
    }
};
struct LoadF32 {
    const float* A; int lda;
    __device__ __forceinline__ f32x4 operator()(int r, int k) const { return *(const f32x4*)(A + (size_t)r * lda + k); }
};

namespace pg8 {
typedef short bf16x8 __attribute__((ext_vector_type(8)));
constexpr int BM = 256, BK = 64, HALF = 128, HTB = HALF * BK * 2, STAGE_BYTES = 8 * HTB, NXCD = 8, WGM = 8;
__host__ __device__ __forceinline__ int lds_byte(int r, int c) { const int st = (r >> 4) * 2 + (c >> 5), rr = r & 15, cc = c & 31, ob = rr * 64 + cc * 2; return st * 1024 + (ob ^ (((ob >> 9) & 1) << 5)); }
__host__ __device__ __forceinline__ void stage_rc(int b, int& R, int& C) { const int st = b / 1024, sb = b % 1024, swz = sb ^ (((sb >> 9) & 1) << 5); R = (st >> 1) * 16 + swz / 64; C = (st & 1) * 32 + (swz % 64) / 2; }
__host__ __device__ __forceinline__ int perm32(int rho) { const int n = rho >> 4, i = rho & 15; return 8 * (i >> 2) + 4 * n + (i & 3); }

struct Unit { int pm, pn, row0, e, ord; };

__device__ __forceinline__ unsigned cvt_pk_bf16(float lo, float hi) { unsigned r; asm volatile("v_cvt_pk_bf16_f32 %0, %1, %2" : "=v"(r) : "v"(lo), "v"(hi)); return r; }
__device__ __forceinline__ f32x2 gelu_pk(f32x2 v) {
    const f32x2 av = __builtin_elementwise_abs(v), d = av * 0.2316418882f + 1.0f;
    f32x2 t; t.x = __builtin_amdgcn_rcpf(d.x); t.y = __builtin_amdgcn_rcpf(d.y);
    f32x2 q = t * 0.5307027145f + (-0.7265760135f); q = q * t + 0.7107068705f; q = q * t + (-0.142248368f); q = q * t + 0.127414796f; q = q * t;
    const f32x2 s = (v * v) * (-0.72134752044f);
    f32x2 e; e.x = __builtin_amdgcn_exp2f(s.x); e.y = __builtin_amdgcn_exp2f(s.y);
    const f32x2 m = v * (q * e), r = v - m;
    f32x2 o; o.x = v.x < 0.f ? m.x : r.x; o.y = v.y < 0.f ? m.y : r.y; return o;
}
template <int ACT> struct EpiBf16 {
    static constexpr bool PERM = true;
    bf16_t* O; int ldc; const float* bias; int split_cols; size_t split_stride;
    __device__ __forceinline__ void operator()(const f32x4 (&acc)[2][2][4][2], const Unit& u, int wr, int wc, int fr, int fq) const {
        const int row0 = u.pm * BM + wr * 64 + fr; int colt = u.pn * BM; bf16_t* base = O;
        if (split_cols) { const int t = colt / split_cols; base += (size_t)t * split_stride; colt -= t * split_cols; }
        const int col0 = colt + wc * 32 + 8 * fq, bcol0 = u.pn * BM + wc * 32 + 8 * fq;
        f32x4 bv[2][2];
#pragma unroll
        for (int bj = 0; bj < 2; ++bj)
#pragma unroll
            for (int n = 0; n < 2; ++n) bv[bj][n] = bias ? *(const f32x4*)(bias + bcol0 + bj * HALF + 4 * n) : (f32x4){0.f, 0.f, 0.f, 0.f};
#pragma unroll
        for (int ai = 0; ai < 2; ++ai)
#pragma unroll
            for (int m = 0; m < 4; ++m) { bf16_t* rowp = base + (size_t)(row0 + ai * HALF + m * 16) * ldc + col0;
#pragma unroll
                for (int bj = 0; bj < 2; ++bj) { f32x4 v0 = acc[ai][bj][m][0] + bv[bj][0], v1 = acc[ai][bj][m][1] + bv[bj][1];
                    if (ACT == 1) { f32x2 a = gelu_pk((f32x2){v0[0], v0[1]}), b = gelu_pk((f32x2){v0[2], v0[3]}), c = gelu_pk((f32x2){v1[0], v1[1]}), d = gelu_pk((f32x2){v1[2], v1[3]});
                        v0 = (f32x4){a.x, a.y, b.x, b.y}; v1 = (f32x4){c.x, c.y, d.x, d.y}; }
                    u32x4 w; w.x = cvt_pk_bf16(v0[0], v0[1]); w.y = cvt_pk_bf16(v0[2], v0[3]); w.z = cvt_pk_bf16(v1[0], v1[1]); w.w = cvt_pk_bf16(v1[2], v1[3]);
                    *(u32x4*)(rowp + bj * HALF) = w; } }
    }
};
struct EpiQKV {
    static constexpr bool PERM = true;
    bf16_t* Q; size_t stride; const float* rope; float qscale;
    __device__ __forceinline__ void operator()(const f32x4 (&acc)[2][2][4][2], const Unit& u, int wr, int wc, int fr, int fq) const {
        const int row0 = u.pm * BM + wr * 64 + fr, colt = u.pn * BM, t = colt >> 10, cbase = colt & 1023;
        bf16_t* base = Q + (size_t)t * stride;
        const bool do_rope = (t < 2) && ((u.pm % 33) != 32);
        const float sc = (t == 0) ? qscale : 1.f;
        const float sgn = (fq < 2) ? -1.f : 1.f;
        const bool lowhalf = (fq < 2);
#pragma unroll
        for (int ai = 0; ai < 2; ++ai)
#pragma unroll
            for (int m = 0; m < 4; ++m) {
                const int r = row0 + ai * HALF + m * 16, nseq = r % SEQA;
                const int pos = (wc & 1) ? (nseq & 63) : (nseq >> 6);
                f32x4 cs[4];
                if (do_rope) { const f32x4* rp = (const f32x4*)(rope + (pos * 16 + 8 * (fq & 1)) * 2);
#pragma unroll
                    for (int q4 = 0; q4 < 4; ++q4) cs[q4] = rp[q4]; }
                bf16_t* rowp = base + (size_t)r * D + cbase + wc * 32 + 8 * fq;
#pragma unroll
                for (int bj = 0; bj < 2; ++bj) {
                    float v[8];
#pragma unroll
                    for (int n = 0; n < 2; ++n)
#pragma unroll
                        for (int j = 0; j < 4; ++j) v[n * 4 + j] = acc[ai][bj][m][n][j];
                    if (do_rope) {
#pragma unroll
                        for (int i = 0; i < 8; ++i) {
                            const unsigned xb = __builtin_bit_cast(unsigned, v[i]);
                            auto rr = __builtin_amdgcn_permlane32_swap(xb, xb, false, false);
                            const float partner = __builtin_bit_cast(float, lowhalf ? rr[1] : rr[0]);
                            const float c = cs[i >> 1][(i & 1) * 2], s = cs[i >> 1][(i & 1) * 2 + 1];
                            v[i] = v[i] * c + sgn * partner * s;
                        }
                    }
                    u32x4 w; w.x = cvt_pk_bf16(v[0] * sc, v[1] * sc); w.y = cvt_pk_bf16(v[2] * sc, v[3] * sc); w.z = cvt_pk_bf16(v[4] * sc, v[5] * sc); w.w = cvt_pk_bf16(v[6] * sc, v[7] * sc);
                    *(u32x4*)(rowp + bj * HALF) = w;
                }
            }
    }
};
template <int MAXU> struct EpiMoeUp {
    static constexpr bool PERM = true;
    bf16_t* HS; const LAS float* wtab;
    __device__ __forceinline__ void operator()(const f32x4 (&acc)[2][2][4][2], const Unit& u, int wr, int wc, int fr, int fq) const {
#pragma unroll
        for (int ai = 0; ai < 2; ++ai)
#pragma unroll
            for (int m = 0; m < 4; ++m) {
                const int rr = ai * HALF + wr * 64 + m * 16 + fr;
                const float w = wtab[u.ord * 256 + rr];
                float h[8];
#pragma unroll
                for (int n = 0; n < 2; ++n)
#pragma unroll
                    for (int j = 0; j < 4; ++j) { const float g = acc[ai][0][m][n][j], up = acc[ai][1][m][n][j]; h[n * 4 + j] = w * up * g * __builtin_amdgcn_rcpf(1.f + __expf(-g)); }
                u32x4 o; o.x = cvt_pk_bf16(h[0], h[1]); o.y = cvt_pk_bf16(h[2], h[3]); o.z = cvt_pk_bf16(h[4], h[5]); o.w = cvt_pk_bf16(h[6], h[7]);
                *(u32x4*)(HS + (size_t)(u.row0 + rr) * EDFF + u.pn * 128 + wc * 32 + 8 * fq) = o;
            }
    }
};
template <int MAXU> struct EpiMoeDown {
    static constexpr bool PERM = true;
    bf16_t* HO; const LAS int* ptab;
    __device__ __forceinline__ void operator()(const f32x4 (&acc)[2][2][4][2], const Unit& u, int wr, int wc, int fr, int fq) const {
#pragma unroll
        for (int ai = 0; ai < 2; ++ai)
#pragma unroll
            for (int m = 0; m < 4; ++m) {
                const int rr = ai * HALF + wr * 64 + m * 16 + fr;
                int p = ptab[u.ord * 256 + rr]; p = p < 0 ? (TK + T) : p;
                bf16_t* rowp = HO + (size_t)p * D + u.pn * BM + wc * 32 + 8 * fq;
#pragma unroll
                for (int bj = 0; bj < 2; ++bj) { const f32x4 v0 = acc[ai][bj][m][0], v1 = acc[ai][bj][m][1];
                    u32x4 o; o.x = cvt_pk_bf16(v0[0], v0[1]); o.y = cvt_pk_bf16(v0[2], v0[3]); o.z = cvt_pk_bf16(v1[0], v1[1]); o.w = cvt_pk_bf16(v1[2], v1[3]);
                    *(u32x4*)(rowp + bj * HALF) = o; }
            }
    }
};

struct DenseSched {
    const char* A; const char* Bt; int K, nM, nN, nwg, G, c;
    __device__ __forceinline__ void init(const void* A_, const void* Bt_, int M, int N, int K_, int G_, int c_) { A = (const char*)A_; Bt = (const char*)Bt_; K = K_; nM = M / BM; nN = N / BM; nwg = nM * nN; G = G_; c = c_; }
    __device__ __forceinline__ bool next(int i, Unit& u) const {
        const long L = (long)i * G + c; if (L >= nwg) return false;
        int wgid = (int)L; { const int q = nwg / NXCD, r = nwg % NXCD, xcd = wgid % NXCD, off = wgid / NXCD; wgid = (xcd < r ? xcd * (q + 1) : r * (q + 1) + (xcd - r) * q) + off; }
        const int nig = WGM * nN, gid = wgid / nig, fm = gid * WGM, gsz = (nM - fm) < WGM ? (nM - fm) : WGM;
        u.pm = fm + ((wgid % nig) % gsz); u.pn = (wgid % nig) / gsz; u.row0 = 0; u.e = 0; u.ord = i; return true;
    }
    __device__ __forceinline__ const char* a_base() const { return A; }
    __device__ __forceinline__ unsigned a_off(const Unit& u, int h, int R, int C) const { return (unsigned)(((u.pm * BM + h * HALF + R) * K + C) * 2); }
    __device__ __forceinline__ const char* b_base(const Unit& u) const { return Bt + (size_t)u.pn * BM * K * 2; }
};
template <bool GATHER, int MAXU> struct MoeSched {
    const char* A; const char* Bexp; const char* Bsh; size_t b_estride; int K, NPN, x, r, W;
    const LAS int* ps; const LAS int* xps; const LAS int* ptab;
    __device__ __forceinline__ bool next_any(int i, Unit& u) const {
        const int uu = i * W + r, nrt = __builtin_amdgcn_readfirstlane(xps[32]), tot = (nrt + 16) * NPN; if (uu >= tot) return false;
        const int rtl = uu / NPN; u.pn = uu % NPN; u.pm = 0; u.ord = i;
        if (rtl < nrt) { int a = 0, b = 32; while (b - a > 1) { const int mid = (a + b) >> 1; if (__builtin_amdgcn_readfirstlane(xps[mid]) <= rtl) a = mid; else b = mid; }
            u.e = x + 8 * a; u.row0 = __builtin_amdgcn_readfirstlane(ps[u.e]) + (rtl - __builtin_amdgcn_readfirstlane(xps[a])) * BM; }
        else { u.e = NE; u.row0 = PMAX + (x * 16 + (rtl - nrt)) * BM; }
        return true;
    }
    __device__ __forceinline__ bool next(int i, Unit& u) const { return i < MAXU && next_any(i, u); }
    __device__ __forceinline__ const char* a_base() const { return A; }
    __device__ __forceinline__ unsigned a_off(const Unit& u, int h, int R, int C) const {
        const int row = h * HALF + R;
        if (GATHER) { const int p = ptab[u.ord * 256 + row]; const int tok = p < 0 ? 0 : (p < TK ? (p >> 3) : (p - TK)); return (unsigned)((tok * K + C) * 2); }
        else return (unsigned)(((u.row0 + row) * K + C) * 2);
    }
    __device__ __forceinline__ const char* b_base(const Unit& u) const { return (u.e < NE ? Bexp + (size_t)u.e * b_estride : Bsh) + (size_t)u.pn * BM * K * 2; }
};

template <class Epi, class Sched, bool ALIGN_EPI>
__device__ __forceinline__ void gemm_phase(LAS unsigned char* lds, const int K, const Sched& S, const Epi& E) {
    const int tid = threadIdx.x, wid = __builtin_amdgcn_readfirstlane(tid >> 6), lane = tid & 63, wr = wid >> 2, wc = wid & 3, fr = lane & 15, fq = lane >> 4;
    const int nt = K / BK;
    int sR[2], sC[2]; unsigned voffB[2];
#pragma unroll
    for (int i = 0; i < 2; ++i) { int R, C; stage_rc(tid * 16 + i * 8192, R, C); sR[i] = R; sC[i] = C; const int Rb = Epi::PERM ? ((R & ~31) + perm32(R & 31)) : R; voffB[i] = (unsigned)(Rb * K + C) * 2u; }
    const size_t kstep = (size_t)(BK * 2);
    const size_t hstep = (size_t)HALF * K * 2;
    const unsigned ldsw = (unsigned)wid * 1024u;
    const int aoff = lds_byte(wr * 64 + fr, fq * 8), boff = lds_byte(wc * 32 + fr, fq * 8);
#define PG8_SA(b, h) (((b) * 2 + (h)) * HTB)
#define PG8_SB(b, h) ((4 + (b) * 2 + (h)) * HTB)
#define PG8_STAGE(bufoff, gbase, voff) do { _Pragma("unroll") for (int _i = 0; _i < 2; ++_i) \
        __builtin_amdgcn_global_load_lds((const unsigned*)((const char*)(gbase) + (voff)[_i]), (LAS unsigned*)(lds + (bufoff) + ldsw + _i * 8192), 16, 0, 0); } while (0)
#define PG8_LDA(dst, b, h) do { _Pragma("unroll") for (int m = 0; m < 4; ++m) _Pragma("unroll") for (int k = 0; k < 2; ++k) dst[m][k] = *(const LAS bf16x8*)(lds + PG8_SA(b, h) + aoff + m * 2048 + k * 1024); } while (0)
#define PG8_LDB(dst, b, h) do { _Pragma("unroll") for (int n = 0; n < 2; ++n) _Pragma("unroll") for (int k = 0; k < 2; ++k) dst[n][k] = *(const LAS bf16x8*)(lds + PG8_SB(b, h) + boff + n * 2048 + k * 1024); } while (0)
#define PG8_MMA(ai, bj, At, Bt) do { __builtin_amdgcn_s_setprio(1); _Pragma("unroll") for (int m = 0; m < 4; ++m) _Pragma("unroll") for (int n = 0; n < 2; ++n) _Pragma("unroll") for (int k = 0; k < 2; ++k) \
        acc[ai][bj][m][n] = __builtin_amdgcn_mfma_f32_16x16x32_bf16(Bt[n][k], At[m][k], acc[ai][bj][m][n], 0, 0, 0); __builtin_amdgcn_s_setprio(0); } while (0)
#define PG8_WAIT_V(n) asm volatile("s_waitcnt vmcnt(" #n ")" ::: "memory")
#define PG8_WAIT_L(n) asm volatile("s_waitcnt lgkmcnt(" #n ")" ::: "memory")
#define PG8_BAR __builtin_amdgcn_s_barrier()
#define PG8_SCHED __builtin_amdgcn_sched_barrier(0)
    Unit cur, nxt; int ui = 0;
    if (!S.next(0, cur)) return;
    f32x4 acc[2][2][4][2];
#pragma unroll
    for (int a = 0; a < 2; ++a)
#pragma unroll
        for (int b = 0; b < 2; ++b)
#pragma unroll
            for (int m = 0; m < 4; ++m)
#pragma unroll
                for (int n = 0; n < 2; ++n) acc[a][b][m][n] = (f32x4){0.f, 0.f, 0.f, 0.f};
    bf16x8 At[4][2], B0[2][2], B1[2][2];
    unsigned cao[2][2], nao[2][2];
#pragma unroll
    for (int h = 0; h < 2; ++h)
#pragma unroll
        for (int i = 0; i < 2; ++i) cao[h][i] = S.a_off(cur, h, sR[i], sC[i]);
    const char* const Ab = S.a_base();
    const char* cB = S.b_base(cur);
    PG8_STAGE(PG8_SB(0, 0), cB, voffB); PG8_STAGE(PG8_SB(0, 1), cB + hstep, voffB); PG8_STAGE(PG8_SA(0, 0), Ab, cao[0]); PG8_STAGE(PG8_SA(0, 1), Ab, cao[1]);
    if (wr == 1) PG8_BAR;
    PG8_WAIT_V(2); PG8_BAR;
    PG8_STAGE(PG8_SB(1, 0), cB + kstep, voffB); PG8_STAGE(PG8_SA(1, 0), Ab + kstep, cao[0]); PG8_STAGE(PG8_SB(1, 1), cB + hstep + kstep, voffB);
    PG8_WAIT_V(6); PG8_BAR;
    for (;;) {
        const bool has_next = S.next(ui + 1, nxt);
        const char* nB = has_next ? S.b_base(nxt) : cB;
#pragma unroll
        for (int h = 0; h < 2; ++h)
#pragma unroll
            for (int i = 0; i < 2; ++i) nao[h][i] = has_next ? S.a_off(nxt, h, sR[i], sC[i]) : cao[h][i];
#pragma nounroll
        for (int t = 0; t < nt; t += 2) {
            const bool last = (t == nt - 2);
            const char* a1 = Ab + (size_t)(t + 1) * kstep;
            const char* a2 = last ? Ab : Ab + (size_t)(t + 2) * kstep; const char* b2 = last ? nB : cB + (size_t)(t + 2) * kstep;
            const char* a3 = a2 + kstep; const char* b3 = b2 + kstep;
            unsigned o2[2][2];
#pragma unroll
            for (int h = 0; h < 2; ++h)
#pragma unroll
                for (int i = 0; i < 2; ++i) o2[h][i] = last ? nao[h][i] : cao[h][i];
            PG8_LDB(B0, 0, 0); PG8_LDB(B1, 0, 1); PG8_SCHED; PG8_LDA(At, 0, 0); PG8_STAGE(PG8_SA(1, 1), a1, cao[1]);
            PG8_WAIT_V(8); PG8_WAIT_L(0); PG8_BAR; PG8_MMA(0, 0, At, B0); PG8_MMA(0, 1, At, B1); PG8_BAR; PG8_SCHED;
            PG8_LDA(At, 0, 1); PG8_STAGE(PG8_SB(0, 0), b2, voffB); PG8_STAGE(PG8_SB(0, 1), b2 + hstep, voffB); PG8_STAGE(PG8_SA(0, 0), a2, o2[0]);
            PG8_WAIT_V(8); PG8_WAIT_L(0); PG8_BAR; PG8_MMA(1, 0, At, B0); PG8_MMA(1, 1, At, B1); PG8_BAR; PG8_SCHED;
            PG8_LDB(B0, 1, 0); PG8_LDB(B1, 1, 1); PG8_SCHED; PG8_LDA(At, 1, 0); PG8_STAGE(PG8_SA(0, 1), a2, o2[1]);
            PG8_WAIT_V(8); PG8_WAIT_L(0); PG8_BAR; PG8_MMA(0, 0, At, B0); PG8_MMA(0, 1, At, B1); PG8_BAR; PG8_SCHED;
            PG8_LDA(At, 1, 1); PG8_STAGE(PG8_SB(1, 0), b3, voffB); PG8_STAGE(PG8_SB(1, 1), b3 + hstep, voffB); PG8_STAGE(PG8_SA(1, 0), a3, o2[0]);
            PG8_WAIT_V(8); PG8_WAIT_L(0); PG8_BAR; PG8_MMA(1, 0, At, B0); PG8_MMA(1, 1, At, B1); PG8_BAR; PG8_SCHED;
        }
        if constexpr (ALIGN_EPI) { if (wr == 0) PG8_BAR; }
        E(acc, cur, wr, wc, fr, fq);
        if (!has_next) break;
#pragma unroll
        for (int a = 0; a < 2; ++a)
#pragma unroll
            for (int b = 0; b < 2; ++b)
#pragma unroll
                for (int m = 0; m < 4; ++m)
#pragma unroll
                    for (int n = 0; n < 2; ++n) acc[a][b][m][n] = (f32x4){0.f, 0.f, 0.f, 0.f};
        cur = nxt; cB = nB; ++ui;
#pragma unroll
        for (int h = 0; h < 2; ++h)
#pragma unroll
            for (int i = 0; i < 2; ++i) cao[h][i] = nao[h][i];
        if constexpr (ALIGN_EPI) { if (wr == 1) PG8_BAR; }
    }
    PG8_WAIT_V(0);
    if constexpr (!ALIGN_EPI) { if (wr == 0) PG8_BAR; }
    PG8_BAR;
#undef PG8_SA
#undef PG8_SB
#undef PG8_STAGE
#undef PG8_LDA
#undef PG8_LDB
#undef PG8_MMA
#undef PG8_WAIT_V
#undef PG8_WAIT_L
#undef PG8_BAR
#undef PG8_SCHED
}
}

struct Args { const float* in[27]; float* out; unsigned char* ws; int ph_lo, ph_hi; };
enum { I_X = 0, I_C, I_CTX, I_CCTX, I_WMOD, I_BMOD, I_LNG, I_LNB, I_AWIN, I_AWOUT, I_ALAM, I_ASUBG, I_SWIN, I_SBIN, I_SNG, I_SNB, I_SWS, I_SBS, I_SWOUT,
       I_RW, I_RB, I_EWG, I_EWU, I_EWD, I_SHG, I_SHU, I_SHD };
constexpr int N_PHASES = 25;

__device__ __forceinline__ f32x4 ld_bf4(const bf16_t* p) { const u32x2 w = *(const u32x2*)p; return (f32x4){bf2f(w.x & 0xffffu), bf2f(w.x >> 16), bf2f(w.y & 0xffffu), bf2f(w.y >> 16)}; }

template <bool MOE>
__device__ __forceinline__ void ln_rows(const float* xin, const bf16_t* Yb, float* xout, bf16_t* hb, const float* lng, const float* lnb,
                                        const float* modl, int g_off, const float* modh, int sc_off, int gw, int NGW, int lane) {
    for (int row = gw; row < T; row += NGW) {
        const int b = row / SEQ; const float* mb = modl + b * 6144;
        f32x4 v[4]; float s = 0.f;
#pragma unroll
        for (int j = 0; j < 4; ++j) {
            const int c = j * 256 + lane * 4;
            f32x4 yv;
            if (!MOE) yv = ld_bf4(Yb + (size_t)row * D + c);
            else { yv = ld_bf4(Yb + ((size_t)TK + row) * D + c);
#pragma unroll
                for (int k = 0; k < TOPK; ++k) yv += ld_bf4(Yb + ((size_t)row * TOPK + k) * D + c); }
            const f32x4 xv = *(const f32x4*)(xin + (size_t)row * D + c), gv = *(const f32x4*)(mb + g_off + c);
            v[j] = xv * ALPHA + gv * yv; s += (v[j].x + v[j].y) + (v[j].z + v[j].w);
        }
        const float mean = wave_sum(s) * (1.f / D); float s2 = 0.f;
#pragma unroll
        for (int j = 0; j < 4; ++j) { v[j] = v[j] - mean; s2 += (v[j].x * v[j].x + v[j].y * v[j].y) + (v[j].z * v[j].z + v[j].w * v[j].w); }
        const float rstd = 1.f / sqrtf(wave_sum(s2) * (1.f / D) + LN_EPS);
#pragma unroll
        for (int j = 0; j < 4; ++j) {
            const int c = j * 256 + lane * 4;
            const f32x4 o = v[j] * rstd * *(const f32x4*)(lng + c) + *(const f32x4*)(lnb + c);
            *(f32x4*)(xout + (size_t)row * D + c) = o;
            if (modh) {
                const float* mh = modh + b * 6144;
                const f32x4 h = o * (*(const f32x4*)(mh + sc_off + c) + 1.f) + *(const f32x4*)(mh + sc_off - 1024 + c);
                *(u32x2*)(hb + (size_t)row * D + c) = (u32x2){pk2(h.x, h.y), pk2(h.z, h.w)};
            }
        }
    }
}

__device__ __forceinline__ void expert_prefix(const unsigned* cnt, LAS int* ps, LAS int* xps, int x, int tid) {
    if (tid < 64) {
        int v[4], s = 0;
#pragma unroll
        for (int i = 0; i < 4; ++i) { const int c = (int)cnt[tid * 4 + i]; v[i] = (c + PADM - 1) / PADM * PADM; s += v[i]; }
        int inc = s;
#pragma unroll
        for (int o = 1; o < 64; o <<= 1) { const int t = __shfl_up(inc, o); if (tid >= o) inc += t; }
        int ex = inc - s;
#pragma unroll
        for (int i = 0; i < 4; ++i) { ps[tid * 4 + i] = ex; ex += v[i]; }
        if (tid == 63) ps[256] = ex;
        int tl = 0; if (tid < 32) tl = ((int)cnt[x + 8 * tid] + PADM - 1) / PADM;
        int inc2 = tl;
#pragma unroll
        for (int o = 1; o < 32; o <<= 1) { const int t = __shfl_up(inc2, o); if (tid >= o) inc2 += t; }
        if (tid < 32) { xps[tid] = inc2 - tl; if (tid == 31) xps[32] = inc2; }
    }
    __syncthreads();
}

__device__ __forceinline__ void cvt_item(const float* __restrict__ W, int ldn, int K, int k0, int n0, bf16_t* __restrict__ Bt, int drow0, LAS unsigned char* wl, int lane) {
    const int n4 = (lane & 31) * 4, kh = lane >> 5;
    const float* src = W + (size_t)(k0 + kh * 32) * ldn + n0 + n4;
#pragma unroll
    for (int b = 0; b < 4; ++b) {
        f32x4 v[8];
#pragma unroll
        for (int i = 0; i < 8; ++i) v[i] = *(const f32x4*)(src + (size_t)(b * 8 + i) * ldn);
        const int kc = kh * 4 + b;
#pragma unroll
        for (int c = 0; c < 4; ++c) {
            const int n = n4 + c;
            const u32x4 w = {pk2(v[0][c], v[1][c]), pk2(v[2][c], v[3][c]), pk2(v[4][c], v[5][c]), pk2(v[6][c], v[7][c])};
            *(LAS u32x4*)(wl + n * 128 + ((kc ^ (n & 7)) << 4)) = w;
        }
    }
    asm volatile("s_waitcnt lgkmcnt(0)" ::: "memory");
    const int cch = lane & 7;
#pragma unroll
    for (int j = 0; j < 16; ++j) {
        const int n = (lane >> 3) + 8 * j;
        const u32x4 w = *(const LAS u32x4*)(wl + n * 128 + ((cch ^ (n & 7)) << 4));
        *(u32x4*)(Bt + (size_t)(drow0 + n) * K + k0 + cch * 8) = w;
    }
    asm volatile("s_waitcnt lgkmcnt(0)" ::: "memory");
}

struct Ctx { const Args* a; unsigned char* lds; XcdBarrier bar; int G, bid, NGW; long NGT; };
#ifndef PHMASK
#define PHMASK 0xFFFFFFFFu
#endif
#define IN(k) (((PHMASK >> (k)) & 1u) && lo <= (k) && (k) < hi)
#define SEAM(k) do { if (!MK_PER_PHASE_LAUNCH && IN((k) + 1)) xcd_barrier(bar); else __syncthreads(); } while (0)
#define CTX_LOCALS \
    const Args& args = *C.a; unsigned char* lds = C.lds; const XcdBarrier bar = C.bar; const int G = C.G, bid = C.bid, NGW = C.NGW; \
    const long NGT = C.NGT; unsigned char* ws = args.ws; unsigned* ctl = (unsigned*)(ws + WS_CTL); float* smf = (float*)lds; const int lo = args.ph_lo, hi = args.ph_hi; \
    LAS unsigned char* ldsl = (LAS unsigned char*)lds; \
    (void)NGW; (void)NGT; (void)ctl; (void)smf; (void)bid; (void)G; (void)ldsl;
#define PH_LOCALS \
    int tid = threadIdx.x; asm volatile("" : "+v"(tid)); const int lane = tid & 63, wave = __builtin_amdgcn_readfirstlane(tid >> 6); const int gw = bid * NWAVES + wave; const long gt = (long)bid * NTHR + tid; \
    (void)lane; (void)wave; (void)gw; (void)gt;
#define WS_PTRS \
    float* modv = (float*)(ws + WS_MODV); float* ROPE = (float*)(ws + WS_ROPE); \
    bf16_t* HALL = (bf16_t*)(ws + WS_HALL); bf16_t* Qb = (bf16_t*)(ws + WS_Q); bf16_t* Kb = (bf16_t*)(ws + WS_K); bf16_t* Vb = (bf16_t*)(ws + WS_V); \
    float* OATT = (float*)(ws + WS_OATT); bf16_t* ATT = (bf16_t*)(ws + WS_ATT); \
    bf16_t* Y = (bf16_t*)(ws + WS_Y); float* X1 = (float*)(ws + WS_X1); float* X2 = args.out; \
    bf16_t* HM = (bf16_t*)(ws + WS_HM); bf16_t* H1 = (bf16_t*)(ws + WS_H1); \
    float* LOG = (float*)(ws + WS_LOG); bf16_t* HO = (bf16_t*)(ws + WS_HO); bf16_t* HS = (bf16_t*)(ws + WS_HS); \
    int* IDX = (int*)(ws + WS_IDX); float* WGT = (float*)(ws + WS_WGT); int* POS = (int*)(ws + WS_POS); \
    int* SPAIR = (int*)(ws + WS_SPAIR); float* SW = (float*)(ws + WS_SW); \
    bf16_t* Ub = (bf16_t*)(ws + WS_U); bf16_t* VB = (bf16_t*)(ws + WS_VB); float* VN = (float*)(ws + WS_VN); bf16_t* GSP = (bf16_t*)(ws + WS_GSP); \
    bf16_t* WIN_T = (bf16_t*)(ws + WS_WIN_T); bf16_t* WOUT_T = (bf16_t*)(ws + WS_WOUT_T); bf16_t* SWIN_T = (bf16_t*)(ws + WS_SWIN_T); bf16_t* SWOUT_T = (bf16_t*)(ws + WS_SWOUT_T); \
    bf16_t* SHUP_T = (bf16_t*)(ws + WS_SHUP_T); bf16_t* SHDN_T = (bf16_t*)(ws + WS_SHDN_T); bf16_t* EUP_T = (bf16_t*)(ws + WS_EUP_T); bf16_t* EDN_T = (bf16_t*)(ws + WS_EDN_T); \
    (void)modv; (void)ROPE; (void)HALL; (void)Qb; (void)Kb; (void)Vb; (void)OATT; (void)ATT; (void)Y; (void)X1; (void)X2; (void)HM; (void)H1; (void)LOG; (void)HO; (void)HS; (void)IDX; (void)WGT; (void)POS; \
    (void)SPAIR; (void)SW; (void)Ub; (void)VB; (void)VN; (void)GSP; (void)WIN_T; (void)WOUT_T; (void)SWIN_T; (void)SWOUT_T; (void)SHUP_T; (void)SHDN_T; (void)EUP_T; (void)EDN_T;

__device__ __forceinline__ void phases_front(const Ctx& C) {
    CTX_LOCALS
    WS_PTRS
    if (IN(0)) { PH_LOCALS
        float* sc = smf;
        float* red = smf + 5 * 1024;
        for (int i = tid; i < 5 * 1024; i += NTHR) { const int r = i >> 10, k = i & 1023; const float c = r < 4 ? args.in[I_C][r * D + k] : args.in[I_CCTX][k]; sc[i] = siluf(c); }
        __syncthreads();
        for (int it = bid; it < 2 * 96; it += G) {
            const int l = it / 96, j = (it % 96) * 64 + lane;
            const float* w = args.in[I_WMOD] + (size_t)l * D * 6144 + j;
            float a0 = 0, a1 = 0, a2 = 0, a3 = 0, a4 = 0;
            for (int k = wave * 128; k < wave * 128 + 128; ++k) { const float wv = w[(size_t)k * 6144]; a0 += sc[k] * wv; a1 += sc[1024 + k] * wv; a2 += sc[2048 + k] * wv; a3 += sc[3072 + k] * wv; a4 += sc[4096 + k] * wv; }
            red[(wave * 5 + 0) * 64 + lane] = a0; red[(wave * 5 + 1) * 64 + lane] = a1; red[(wave * 5 + 2) * 64 + lane] = a2; red[(wave * 5 + 3) * 64 + lane] = a3; red[(wave * 5 + 4) * 64 + lane] = a4;
            __syncthreads();
            if (tid < 320) { const int r = tid >> 6, jj = tid & 63; float s = 0.f;
#pragma unroll
                for (int w8 = 0; w8 < 8; ++w8) s += red[(w8 * 5 + r) * 64 + jj];
                const int col = (it % 96) * 64 + jj;
                modv[((size_t)l * 5 + r) * 6144 + col] = s + args.in[I_BMOD][l * 6144 + col]; }
            __syncthreads();
        }
        if (gt < 128 * 16) { const int pos = (int)gt >> 4, jj = (int)gt & 15; const float ang = (float)pos * __powf(10000.f, -(float)jj / 16.f); ROPE[gt * 2] = __cosf(ang); ROPE[gt * 2 + 1] = __sinf(ang); }
#if FAST_DENSE || FAST_MOE
        {
            LAS unsigned char* wl = ldsl + wave * 16384;
            constexpr int NI_WIN = 16 * 24, NI_WOUT = 16 * 8, NI_SWIN = 16 * 32, NI_SWOUT = 32 * 8, NI_SH = 2 * 96, NI_DENSE = NI_WIN + NI_WOUT + NI_SWIN + NI_SWOUT + NI_SH;
            constexpr int NI_EXP = 2 * NE * 96;
            for (int it = gw; it < NI_DENSE + NI_EXP; it += NGW) {
                int r = it;
                if (r < NI_WIN) { cvt_item(args.in[I_AWIN], 3 * D, D, (r / 24) * 64, (r % 24) * 128, WIN_T, (r % 24) * 128, wl, lane); continue; } r -= NI_WIN;
                if (r < NI_WOUT) { cvt_item(args.in[I_AWOUT], D, D, (r / 8) * 64, (r % 8) * 128, WOUT_T, (r % 8) * 128, wl, lane); continue; } r -= NI_WOUT;
                if (r < NI_SWIN) { cvt_item(args.in[I_SWIN], 2 * SGU_DFF, D, (r / 32) * 64, (r % 32) * 128, SWIN_T, (r % 32) * 128, wl, lane); continue; } r -= NI_SWIN;
                if (r < NI_SWOUT) { cvt_item(args.in[I_SWOUT], D, SGU_DFF, (r / 8) * 64, (r % 8) * 128, SWOUT_T, (r % 8) * 128, wl, lane); continue; } r -= NI_SWOUT;
                const float *wg, *wu, *wd; bf16_t *up_t, *dn_t;
                if (r < NI_SH) { const int l = r / 96; r %= 96; wg = args.in[I_SHG] + (size_t)l * D * EDFF; wu = args.in[I_SHU] + (size_t)l * D * EDFF; wd = args.in[I_SHD] + (size_t)l * EDFF * D;
                    up_t = SHUP_T + (size_t)l * 512 * D; dn_t = SHDN_T + (size_t)l * D * EDFF; }
                else { r -= NI_SH; const int le = r / 96; r %= 96; wg = args.in[I_EWG] + (size_t)le * D * EDFF; wu = args.in[I_EWU] + (size_t)le * D * EDFF; wd = args.in[I_EWD] + (size_t)le * EDFF * D;
                    up_t = EUP_T + (size_t)le * 512 * D; dn_t = EDN_T + (size_t)le * D * EDFF; }
                const int mat = r / 32, sub = r % 32;
                if (mat < 2) cvt_item(mat == 0 ? wg : wu, EDFF, D, (sub / 2) * 64, (sub % 2) * 128, up_t, (sub % 2) * 256 + mat * 128, wl, lane);
                else cvt_item(wd, D, EDFF, (sub / 8) * 64, (sub % 8) * 128, dn_t, (sub % 8) * 128, wl, lane);
            }
        }
#endif
        SEAM(0);
    }
    if (IN(1)) { PH_LOCALS
        for (long i = gt; i < (long)TA * (D / 4); i += NGT) {
            const int row = (int)(i >> 8), c = (int)(i & 255) * 4, b = row / SEQA, n = row % SEQA;
            const float* src = n < SEQ ? args.in[I_X] + ((size_t)b * SEQ + n) * D + c : args.in[I_CTX] + ((size_t)b * CTX + (n - SEQ)) * D + c;
            const float* mb = modv + (n < SEQ ? b : 4) * 6144;
            const f32x4 h = *(const f32x4*)src * (*(const f32x4*)(mb + 1024 + c) + 1.f) + *(const f32x4*)(mb + c);
            *(u32x2*)(HALL + (size_t)row * D + c) = (u32x2){pk2(h.x, h.y), pk2(h.z, h.w)};
        }
        SEAM(1);
    }
#if FAST_DENSE
    if (IN(2)) { PH_LOCALS
        pg8::DenseSched S; S.init(HALL, WIN_T, TA, 3 * D, D, G, bid);
        const pg8::EpiQKV E{Qb, (WS_K - WS_Q) / 2, ROPE, 1.f};
        pg8::gemm_phase<pg8::EpiQKV, pg8::DenseSched, true>(ldsl, D, S, E);
        SEAM(2);
    }
    if (IN(3)) { SEAM(3); }
#else
    if (IN(2)) { PH_LOCALS
        const LoadBf16 la{HALL, D, nullptr};
        for (int it = bid; it < (TA / 128) * 24; it += G) {
            const int mt = it / 24, nt = it % 24;
            auto epi = [=](int r, int c, f32x4 va, f32x4 vb) { bf16_t* dst = Qb + (size_t)(c >> 10) * ((WS_K - WS_Q) / 2) + (size_t)r * D + (c & 1023);
                *(u32x4*)dst = (u32x4){pk2(va.x, va.y), pk2(va.z, va.w), pk2(vb.x, vb.y), pk2(vb.z, vb.w)}; };
            gemm_tile(la, args.in[I_AWIN], 3 * D, D, mt * 128, nt * 128, smf, epi);
        }
        SEAM(2);
    }
    if (IN(3)) { PH_LOCALS
        for (long i = gt; i < (long)T * 1024; i += NGT) {
            const int j = (int)(i & 15), ch = (int)(i >> 4) & 1, hm = (int)(i >> 5) & 15, wh = (int)(i >> 9) & 1; const long tok = i >> 10;
            const int b = (int)(tok / SEQ), n = (int)(tok % SEQ);
            const int pos = ch == 0 ? n / 64 : n % 64;
            const float cs = ROPE[(pos * 16 + j) * 2], sn = ROPE[(pos * 16 + j) * 2 + 1];
            bf16_t* p = (wh ? Kb : Qb) + ((size_t)b * SEQA + n) * D + hm * 64 + ch * 32 + j;
            const float x1 = bf2f(p[0]), x2 = bf2f(p[16]);
            p[0] = (bf16_t)f2bf(x1 * cs - x2 * sn); p[16] = (bf16_t)f2bf(x2 * cs + x1 * sn);
        }
        SEAM(3);
    }
#endif
    if (IN(4)) { PH_LOCALS
        float* Ks = smf; float* Vs = smf + 64 * 64;
        for (int it = bid; it < BATCH * NH * 2 * (SEQ / 512) * 2; it += G) {
            const int vh = it & 1, qb = (it >> 1) & 15, m = (it >> 5) & 1, h = (it >> 6) & 7, b = it >> 9;
            const int q = qb * 512 + tid;
            float qr[64], o[64];
            { const bf16_t* qp = Qb + ((size_t)b * SEQA + q) * D + h * 128 + m * 64;
#pragma unroll
              for (int d = 0; d < 64; d += 2) { const unsigned w = *(const unsigned*)(qp + d); qr[d] = bf2f(w & 0xffffu) * 0.125f; qr[d + 1] = bf2f(w >> 16) * 0.125f; } }
#pragma unroll
            for (int e = 0; e < 64; ++e) o[e] = 0.f;
            float mx = -1e30f, l = 0.f;
            for (int k0 = 0; k0 < SEQA; k0 += 64) {
                __syncthreads();
                {
                    const int kr = tid >> 3, kc = (tid & 7) * 8;
                    const u32x4 kw = *(const u32x4*)(Kb + ((size_t)b * SEQA + k0 + kr) * D + h * 128 + m * 64 + kc);
                    float* kd = Ks + kr * 64 + kc;
                    kd[0] = bf2f(kw.x & 0xffffu); kd[1] = bf2f(kw.x >> 16); kd[2] = bf2f(kw.y & 0xffffu); kd[3] = bf2f(kw.y >> 16);
                    kd[4] = bf2f(kw.z & 0xffffu); kd[5] = bf2f(kw.z >> 16); kd[6] = bf2f(kw.w & 0xffffu); kd[7] = bf2f(kw.w >> 16);
                    const u32x4 vw = *(const u32x4*)(Vb + ((size_t)b * SEQA + k0 + kr) * D + h * 128 + vh * 64 + kc);
                    float* vd = Vs + kr * 64 + kc;
                    vd[0] = bf2f(vw.x & 0xffffu); vd[1] = bf2f(vw.x >> 16); vd[2] = bf2f(vw.y & 0xffffu); vd[3] = bf2f(vw.y >> 16);
                    vd[4] = bf2f(vw.z & 0xffffu); vd[5] = bf2f(vw.z >> 16); vd[6] = bf2f(vw.w & 0xffffu); vd[7] = bf2f(vw.w >> 16);
                }
                __syncthreads();
                for (int j = 0; j < 64; ++j) {
                    float s = 0.f;
#pragma unroll
                    for (int d = 0; d < 64; d += 4) { const f32x4 kv = *(const f32x4*)&Ks[j * 64 + d]; s += qr[d] * kv.x + qr[d + 1] * kv.y + qr[d + 2] * kv.z + qr[d + 3] * kv.w; }
                    if (s > mx) { const float a = __expf(mx - s); l *= a;
#pragma unroll
                        for (int e = 0; e < 64; ++e) o[e] *= a;
                        mx = s; }
                    const float p = __expf(s - mx); l += p;
#pragma unroll
                    for (int e = 0; e < 64; e += 4) { const f32x4 vv = *(const f32x4*)&Vs[j * 64 + e]; o[e] += p * vv.x; o[e + 1] += p * vv.y; o[e + 2] += p * vv.z; o[e + 3] += p * vv.w; }
                }
            }
            const float rl = 1.f / l;
            float* op = OATT + (((size_t)b * SEQ + q) * NH + h) * 256 + m * 128 + vh * 64;
#pragma unroll
            for (int e = 0; e < 64; e += 4) *(f32x4*)(op + e) = (f32x4){o[e] * rl, o[e + 1] * rl, o[e + 2] * rl, o[e + 3] * rl};
        }
        SEAM(4);
    }
    if (IN(5)) { PH_LOCALS
        const float* lp = args.in[I_ALAM];
        const float l1 = wave_sum(lp[lane] * lp[64 + lane]), l2 = wave_sum(lp[128 + lane] * lp[192 + lane]);
        const float lam = __expf(l1) - __expf(l2) + LAM_INIT;
        for (int row = gw; row < T; row += NGW) {
            const int h = lane >> 3, e0 = (lane & 7) * 16;
            const float* o0 = OATT + ((size_t)row * NH + h) * 256 + e0; const float* o1 = o0 + 128;
            float v[16]; float ss = 0.f;
#pragma unroll
            for (int e = 0; e < 16; ++e) { v[e] = o0[e] - lam * o1[e]; ss += v[e] * v[e]; }
            ss += __shfl_xor(ss, 1); ss += __shfl_xor(ss, 2); ss += __shfl_xor(ss, 4);
            const float r = (1.f - LAM_INIT) / sqrtf(ss * (1.f / DV) + LN_EPS);
            unsigned w[8];
#pragma unroll
            for (int e = 0; e < 16; e += 2) w[e >> 1] = pk2(v[e] * r * args.in[I_ASUBG][e0 + e], v[e + 1] * r * args.in[I_ASUBG][e0 + e + 1]);
            bf16_t* dst = ATT + (size_t)row * D + h * 128 + e0;
            *(u32x4*)dst = (u32x4){w[0], w[1], w[2], w[3]}; *(u32x4*)(dst + 8) = (u32x4){w[4], w[5], w[6], w[7]};
        }
        SEAM(5);
    }
    if (IN(6)) { PH_LOCALS
#if FAST_DENSE
        pg8::DenseSched S; S.init(ATT, WOUT_T, T, D, D, G, bid);
        const pg8::EpiBf16<0> E{Y, D, nullptr, 0, 0};
        pg8::gemm_phase<pg8::EpiBf16<0>, pg8::DenseSched, true>(ldsl, D, S, E);
#else
        const LoadBf16 la{ATT, D, nullptr};
        for (int it = bid; it < (T / 128) * 8; it += G) {
            const int mt = it / 8, nt = it % 8;
            auto epi = [=](int r, int c, f32x4 va, f32x4 vb) { *(u32x4*)(Y + (size_t)r * D + c) = (u32x4){pk2(va.x, va.y), pk2(va.z, va.w), pk2(vb.x, vb.y), pk2(vb.z, vb.w)}; };
            gemm_tile(la, args.in[I_AWOUT], D, D, mt * 128, nt * 128, smf, epi);
        }
#endif
        SEAM(6);
    }
}
template <int L> __device__ __forceinline__ void layer_tail(const Ctx& C) {
    CTX_LOCALS
    WS_PTRS
    const float* xin = (L == 0) ? args.in[I_X] : X2;
    const float* modl = modv + (size_t)L * 5 * 6144;
    unsigned* cnt = ctl + CW_CNT + L * 256;
    LAS int* ps = (LAS int*)(ldsl + LDS_PS); LAS int* xps = ps + 264;
    const int xcd = bid & 7, xr = bid >> 3, XW = G >> 3;
    if (L == 1) {
        if (IN(14)) { PH_LOCALS
#if FAST_DENSE
            pg8::DenseSched S; S.init(H1, SWIN_T, T, 2 * SGU_DFF, D, G, bid);
            const pg8::EpiBf16<1> E{Ub, SGU_DFF, args.in[I_SBIN], SGU_DFF, (WS_VB - WS_U) / 2};
            pg8::gemm_phase<pg8::EpiBf16<1>, pg8::DenseSched, true>(ldsl, D, S, E);
#else
            const LoadBf16 la{H1, D, nullptr};
            for (int it = bid; it < (T / 128) * 32; it += G) {
                const int mt = it / 32, nt = it % 32;
                auto epi = [=](int r, int c, f32x4 va, f32x4 vb) { const float v[8] = {va.x, va.y, va.z, va.w, vb.x, vb.y, vb.z, vb.w};
                    float z[8];
#pragma unroll
                    for (int j = 0; j < 8; ++j) z[j] = gelu_erf(v[j] + args.in[I_SBIN][c + j]);
                    bf16_t* dst = (c < SGU_DFF) ? Ub + (size_t)r * SGU_DFF + c : VB + (size_t)r * SGU_DFF + (c - SGU_DFF);
                    *(u32x4*)dst = (u32x4){pk2(z[0], z[1]), pk2(z[2], z[3]), pk2(z[4], z[5]), pk2(z[6], z[7])}; };
                gemm_tile(la, args.in[I_SWIN], 2 * SGU_DFF, D, mt * 128, nt * 128, smf, epi);
            }
#endif
            SEAM(14);
        }
        if (IN(15)) { PH_LOCALS
            for (int row = gw; row < T; row += NGW) {
                f32x4 v[8]; float s = 0.f;
#pragma unroll
                for (int j = 0; j < 8; ++j) { v[j] = ld_bf4(VB + (size_t)row * SGU_DFF + j * 256 + lane * 4); s += (v[j].x + v[j].y) + (v[j].z + v[j].w); }
                const float mean = wave_sum(s) * (1.f / SGU_DFF); float s2 = 0.f;
#pragma unroll
                for (int j = 0; j < 8; ++j) { v[j] = v[j] - mean; s2 += (v[j].x * v[j].x + v[j].y * v[j].y) + (v[j].z * v[j].z + v[j].w * v[j].w); }
                const float rstd = 1.f / sqrtf(wave_sum(s2) * (1.f / SGU_DFF) + LN_EPS);
#pragma unroll
                for (int j = 0; j < 8; ++j) { const int c = j * 256 + lane * 4;
                    *(f32x4*)(VN + (size_t)row * SGU_DFF + c) = v[j] * rstd * *(const f32x4*)(args.in[I_SNG] + c) + *(const f32x4*)(args.in[I_SNB] + c); }
            }
            SEAM(15);
        }
        if (IN(16)) { PH_LOCALS
            for (int it = bid; it < (T / SGU_CH) * SGU_G * 2; it += G) {
                const int nt = it & 1, g = (it >> 1) & 7, chunk = it >> 4;
                const LoadF32 la{args.in[I_SWS] + (size_t)g * SGU_CH * SGU_CH, SGU_CH};
                const float* Wv = VN + (size_t)chunk * SGU_CH * SGU_DFF + g * SGU_GC;
                auto epi = [=](int p, int c, f32x4 va, f32x4 vb) { const float v[8] = {va.x, va.y, va.z, va.w, vb.x, vb.y, vb.z, vb.w};
                    const size_t off = (size_t)(chunk * SGU_CH + p) * SGU_DFF + g * SGU_GC + c; const float bs = args.in[I_SBS][g * SGU_CH + p];
                    const u32x4 uw = *(const u32x4*)(Ub + off);
                    const float u0 = bf2f(uw.x & 0xffffu), u1 = bf2f(uw.x >> 16), u2 = bf2f(uw.y & 0xffffu), u3 = bf2f(uw.y >> 16), u4 = bf2f(uw.z & 0xffffu), u5 = bf2f(uw.z >> 16), u6 = bf2f(uw.w & 0xffffu), u7 = bf2f(uw.w >> 16);
                    *(u32x4*)(GSP + off) = (u32x4){pk2(u0 * (v[0] + bs), u1 * (v[1] + bs)), pk2(u2 * (v[2] + bs), u3 * (v[3] + bs)), pk2(u4 * (v[4] + bs), u5 * (v[5] + bs)), pk2(u6 * (v[6] + bs), u7 * (v[7] + bs))}; };
                gemm_tile(la, Wv, SGU_DFF, SGU_CH, 0, nt * 128, smf, epi);
            }
            SEAM(16);
        }
        if (IN(17)) { PH_LOCALS
#if FAST_DENSE
            pg8::DenseSched S; S.init(GSP, SWOUT_T, T, D, SGU_DFF, G, bid);
            const pg8::EpiBf16<0> E{Y, D, nullptr, 0, 0};
            pg8::gemm_phase<pg8::EpiBf16<0>, pg8::DenseSched, true>(ldsl, SGU_DFF, S, E);
#else
            const LoadBf16 la{GSP, SGU_DFF, nullptr};
            for (int it = bid; it < (T / 128) * 8; it += G) {
                const int mt = it / 8, nt = it % 8;
                auto epi = [=](int r, int c, f32x4 va, f32x4 vb) { *(u32x4*)(Y + (size_t)r * D + c) = (u32x4){pk2(va.x, va.y), pk2(va.z, va.w), pk2(vb.x, vb.y), pk2(vb.z, vb.w)}; };
                gemm_tile(la, args.in[I_SWOUT], D, SGU_DFF, mt * 128, nt * 128, smf, epi);
            }
#endif
            SEAM(17);
        }
    }
    constexpr int P_LN = (L == 0) ? 7 : 18;
    if (IN(P_LN)) { PH_LOCALS
        ln_rows<false>(xin, Y, X1, HM, args.in[I_LNG] + (L * 2 + 0) * D, args.in[I_LNB] + (L * 2 + 0) * D, modl, 2048, modl, 4096, gw, NGW, lane);
        SEAM(P_LN);
    }
    if (IN(P_LN + 1)) { PH_LOCALS
        auto la = [=](int r, int k) -> f32x4 { const float* mb = modl + (r / SEQ) * 6144;
            return *(const f32x4*)(X1 + (size_t)r * D + k) * (*(const f32x4*)(mb + 4096 + k) + 1.f) + *(const f32x4*)(mb + 3072 + k); };
        for (int it = bid; it < (T / 128) * 2; it += G) {
            const int mt = it / 2, nt = it % 2;
            auto epi = [=](int r, int c, f32x4 va, f32x4 vb) { float* dst = LOG + (size_t)r * NE + c; *(f32x4*)dst = va; *(f32x4*)(dst + 4) = vb; };
            gemm_tile(la, args.in[I_RW] + (size_t)L * D * NE, NE, D, mt * 128, nt * 128, smf, epi);
        }
        SEAM(P_LN + 1);
    }
    if (IN(P_LN + 2)) { PH_LOCALS
        const float* rb = args.in[I_RB] + L * NE;
        const f32x4 bias = *(const f32x4*)(rb + lane * 4);
        for (int t = gw; t < T; t += NGW) {
            const f32x4 lg = *(const f32x4*)(LOG + (size_t)t * NE + lane * 4);
            float sc[4], ch[4];
#pragma unroll
            for (int i = 0; i < 4; ++i) { sc[i] = sigmoidf_(lg[i]); ch[i] = sc[i] + bias[i]; }
            float m1 = fmaxf(ch[0], ch[1]), m2 = fminf(ch[0], ch[1]);
#pragma unroll
            for (int i = 2; i < 4; ++i) { const float v = ch[i]; m2 = fmaxf(m2, fminf(m1, v)); m1 = fmaxf(m1, v); }
#pragma unroll
            for (int o = 1; o < 8; o <<= 1) { const float b1 = __shfl_xor(m1, o), b2 = __shfl_xor(m2, o); const float n1 = fmaxf(m1, b1), n2 = fmaxf(fminf(m1, b1), fmaxf(m2, b2)); m1 = n1; m2 = n2; }
            const float gs = m1 + m2; const int g = lane >> 3; int rank = 0;
#pragma unroll
            for (int gg = 0; gg < 8; ++gg) { const float o = __shfl(gs, gg * 8); rank += (o > gs || (o == gs && gg < g)) ? 1 : 0; }
            const bool sel = rank < 4;
            float cm[4];
#pragma unroll
            for (int i = 0; i < 4; ++i) cm[i] = sel ? ch[i] : -INFINITY;
            float wsum = 0.f, myw = 0.f; int myidx = 0;
#pragma unroll
            for (int k = 0; k < TOPK; ++k) {
                float bv = cm[0]; int bi = lane * 4;
#pragma unroll
                for (int i = 1; i < 4; ++i) if (cm[i] > bv) { bv = cm[i]; bi = lane * 4 + i; }
#pragma unroll
                for (int o = 1; o < 64; o <<= 1) { const float ov = __shfl_xor(bv, o); const int oi = __shfl_xor(bi, o); if (ov > bv || (ov == bv && oi < bi)) { bv = ov; bi = oi; } }
                const int sub = bi & 3; const float mysc = sub == 0 ? sc[0] : sub == 1 ? sc[1] : sub == 2 ? sc[2] : sc[3];
                const float wv = __shfl(mysc, bi >> 2);
                if ((bi >> 2) == lane) { if (sub == 0) cm[0] = -INFINITY; else if (sub == 1) cm[1] = -INFINITY; else if (sub == 2) cm[2] = -INFINITY; else cm[3] = -INFINITY; }
                wsum += wv; if (lane == k) { myw = wv; myidx = bi; }
            }
            if (lane < TOPK) {
                IDX[t * TOPK + lane] = myidx; WGT[t * TOPK + lane] = myw / wsum * ROUTED_SCALE;
                POS[t * TOPK + lane] = (int)atomicAdd(cnt + myidx, 1u);
            }
        }
        SEAM(P_LN + 2);
    }
    if (IN(P_LN + 3)) { PH_LOCALS
        expert_prefix(cnt, ps, xps, xcd, tid);
        for (long p = gt; p < TK; p += NGT) { const int e = IDX[p]; const int slot = ps[e] + POS[p]; SPAIR[slot] = (int)p; SW[slot] = WGT[p]; }
        for (int e = bid; e < NE; e += G) { const int c = (int)cnt[e], pe = ps[e + 1] - ps[e]; for (int s = c + tid; s < pe; s += NTHR) { SPAIR[ps[e] + s] = -1; SW[ps[e] + s] = 0.f; } }
        for (long t = gt; t < T; t += NGT) { SPAIR[PMAX + t] = TK + (int)t; SW[PMAX + t] = 1.f; }
        SEAM(P_LN + 3);
    }
    auto naive_up = [=](int row0, int e, int pn) {
        const float* wg = e < NE ? args.in[I_EWG] + ((size_t)L * NE + e) * D * EDFF : args.in[I_SHG] + (size_t)L * D * EDFF;
        const float* wu = e < NE ? args.in[I_EWU] + ((size_t)L * NE + e) * D * EDFF : args.in[I_SHU] + (size_t)L * D * EDFF;
        auto la = [=](int r, int k) -> f32x4 { const int p = SPAIR[r]; const int tok = p < 0 ? 0 : (p < TK ? (p >> 3) : (p - TK)); return ld_bf4(HM + (size_t)tok * D + k); };
        for (int half = 0; half < 2; ++half) {
            f32x4 ga[4], gb[4];
            { int ri = 0; auto epi1 = [&](int r, int c, f32x4 va, f32x4 vb) { ga[ri] = va; gb[ri] = vb; ++ri; }; gemm_tile(la, wg, EDFF, D, row0 + half * 128, pn * 128, smf, epi1); }
            { int ri = 0; auto epi2 = [&](int r, int c, f32x4 va, f32x4 vb) { const float w = SW[r]; const f32x4 g0 = ga[ri], g1 = gb[ri]; ++ri;
                *(u32x4*)(HS + (size_t)r * EDFF + c) = (u32x4){pk2(w * siluf(g0.x) * va.x, w * siluf(g0.y) * va.y), pk2(w * siluf(g0.z) * va.z, w * siluf(g0.w) * va.w), pk2(w * siluf(g1.x) * vb.x, w * siluf(g1.y) * vb.y), pk2(w * siluf(g1.z) * vb.z, w * siluf(g1.w) * vb.w)}; };
              gemm_tile(la, wu, EDFF, D, row0 + half * 128, pn * 128, smf, epi2); }
        }
    };
    auto naive_dn = [=](int row0, int e, int pn) {
        const float* wd = e < NE ? args.in[I_EWD] + ((size_t)L * NE + e) * EDFF * D : args.in[I_SHD] + (size_t)L * EDFF * D;
        const LoadBf16 la{HS, EDFF, nullptr};
        auto epi = [=](int r, int c, f32x4 va, f32x4 vb) { const int p = SPAIR[r];
            if (p >= 0) *(u32x4*)(HO + (size_t)p * D + c) = (u32x4){pk2(va.x, va.y), pk2(va.z, va.w), pk2(vb.x, vb.y), pk2(vb.z, vb.w)}; };
        for (int q = 0; q < 4; ++q) gemm_tile(la, wd, D, EDFF, row0 + (q >> 1) * 128, pn * 256 + (q & 1) * 128, smf, epi);
    };
    if (IN(P_LN + 4)) { PH_LOCALS
        expert_prefix(cnt, ps, xps, xcd, tid);
        LAS int* ptab = (LAS int*)(ldsl + LDS_TAB); LAS float* wtab = (LAS float*)(ldsl + LDS_TAB + MAXU_UP * 1024);
        pg8::MoeSched<true, MAXU_UP> S{(const char*)HM, (const char*)(EUP_T + (size_t)L * NE * 512 * D), (const char*)(SHUP_T + (size_t)L * 512 * D), (size_t)512 * D * 2, D, 2, xcd, xr, XW, ps, xps, ptab};
        pg8::Unit u;
#if FAST_MOE
        for (int j = 0; S.next(j, u); ++j) if (tid < 256) { ptab[j * 256 + tid] = SPAIR[u.row0 + tid]; wtab[j * 256 + tid] = SW[u.row0 + tid]; }
        __syncthreads();
        const pg8::EpiMoeUp<MAXU_UP> E{HS, wtab};
        pg8::gemm_phase<pg8::EpiMoeUp<MAXU_UP>, pg8::MoeSched<true, MAXU_UP>, true>(ldsl, D, S, E);
        for (int j = MAXU_UP; S.next_any(j, u); ++j) naive_up(u.row0, u.e, u.pn);
#else
        for (int j = 0; S.next_any(j, u); ++j) naive_up(u.row0, u.e, u.pn);
#endif
        SEAM(P_LN + 4);
    }
    if (IN(P_LN + 5)) { PH_LOCALS
        expert_prefix(cnt, ps, xps, xcd, tid);
        LAS int* ptab = (LAS int*)(ldsl + LDS_TAB);
        pg8::MoeSched<false, MAXU_DN> S{(const char*)HS, (const char*)(EDN_T + (size_t)L * NE * D * EDFF), (const char*)(SHDN_T + (size_t)L * D * EDFF), (size_t)D * EDFF * 2, EDFF, 4, xcd, xr, XW, ps, xps, ptab};
        pg8::Unit u;
#if FAST_MOE
        for (int j = 0; S.next(j, u); ++j) if (tid < 256) ptab[j * 256 + tid] = SPAIR[u.row0 + tid];
        __syncthreads();
        const pg8::EpiMoeDown<MAXU_DN> E{HO, ptab};
        int kdn = EDFF; asm volatile("" : "+s"(kdn));
        pg8::gemm_phase<pg8::EpiMoeDown<MAXU_DN>, pg8::MoeSched<false, MAXU_DN>, true>(ldsl, kdn, S, E);
        for (int j = MAXU_DN; S.next_any(j, u); ++j) naive_dn(u.row0, u.e, u.pn);
#else
        for (int j = 0; S.next_any(j, u); ++j) naive_dn(u.row0, u.e, u.pn);
#endif
        SEAM(P_LN + 5);
    }
    if (IN(P_LN + 6)) { PH_LOCALS
        if (L == 0) ln_rows<true>(X1, HO, X2, H1, args.in[I_LNG] + (L * 2 + 1) * D, args.in[I_LNB] + (L * 2 + 1) * D, modl, 5120, modv + (size_t)5 * 6144, 1024, gw, NGW, lane);
        else ln_rows<true>(X1, HO, args.out, nullptr, args.in[I_LNG] + (L * 2 + 1) * D, args.in[I_LNB] + (L * 2 + 1) * D, modl, 5120, nullptr, 0, gw, NGW, lane);
        SEAM(P_LN + 6);
    }
}

__global__ void __launch_bounds__(NTHR, 2) mega(Args args) {
    extern __shared__ __attribute__((aligned(16))) unsigned char lds[];
    const int tid = threadIdx.x;
    const int G = gridDim.x, bid = blockIdx.x;
    unsigned* ctl = (unsigned*)(args.ws + WS_CTL);
    for (int u = tid; u < 512; u += NTHR) ((unsigned*)(lds + LDS_MISC))[u] = 0u;
    __syncthreads();
    XcdBarrier bar; bar.bar = ctl + CW_BAR; bar.x = 0; bar.st = nullptr;
    if (!MK_PER_PHASE_LAUNCH) bar = xcd_barrier_post(ctl + CW_BAR, (volatile LAS unsigned*)(lds + LDS_MISC) + 8);
    Ctx C; C.a = &args; C.lds = lds; C.bar = bar; C.G = G; C.bid = bid; C.NGW = G * NWAVES; C.NGT = (long)G * NTHR;
    phases_front(C);
    layer_tail<0>(C);
    layer_tail<1>(C);
}

extern "C" void kernel_launch(void* const* d_in, const int* in_sizes, int n_in, void* d_out, int out_size, void* d_ws, size_t ws_size, hipStream_t stream) {
    static int grid = 0;
    if (grid == 0) {
        if (n_in != 27 || out_size != T * D || ws_size < WS_END) { fprintf(stderr, "kernel_launch: unexpected shapes n_in %d out %d ws %zu (need %zu)\n", n_in, out_size, ws_size, (size_t)WS_END); grid = -1; return; }
        int dev = 0, cus = 0, per_cu = 0;
        if (hipGetDevice(&dev) != hipSuccess || hipDeviceGetAttribute(&cus, hipDeviceAttributeMultiprocessorCount, dev) != hipSuccess) { grid = -1; return; }
        if (hipFuncSetAttribute((const void*)mega, hipFuncAttributeMaxDynamicSharedMemorySize, LDS_BYTES) != hipSuccess) { fprintf(stderr, "kernel_launch: hipFuncSetAttribute failed\n"); grid = -1; return; }
        if (hipOccupancyMaxActiveBlocksPerMultiprocessor(&per_cu, (const void*)mega, NTHR, LDS_BYTES) != hipSuccess || per_cu < 1) fprintf(stderr, "kernel_launch: occupancy query reports %d\n", per_cu);
        (void)hipGetLastError();
        grid = cus;
    }
    if (grid < 0) return;
    if (hipMemsetAsync((char*)d_ws + WS_CTL, 0, CTL_ZERO_BYTES, stream) != hipSuccess) return;
    Args a{};
    for (int i = 0; i < 27; ++i) a.in[i] = (const float*)d_in[i];
    a.out = (float*)d_out; a.ws = (unsigned char*)d_ws;
#if MK_PER_PHASE_LAUNCH
    for (int p = 0; p < N_PHASES; ++p) { a.ph_lo = p; a.ph_hi = p + 1; hipLaunchKernelGGL(mega, dim3(grid), dim3(NTHR), LDS_BYTES, stream, a); }
#else
    a.ph_lo = 0; a.ph_hi = N_PHASES;
    hipLaunchKernelGGL(mega, dim3(grid), dim3(NTHR), LDS_BYTES, stream, a);
#endif
    const hipError_t le = hipPeekAtLastError();
    if (le != hipSuccess) fprintf(stderr, "kernel_launch: launch failed: %s\n", hipGetErrorName(le));
}
```

```cpp
#include <hip/hip_runtime.h>
#include <cstdio>
#include <cstdint>

#ifndef MK_PER_PHASE_LAUNCH
#define MK_PER_PHASE_LAUNCH 0
#endif
#ifndef FAST_DENSE
#define FAST_DENSE 1
#endif
#ifndef FAST_MOE
#define FAST_MOE 1
#endif

#define GAS __attribute__((address_space(1)))
#define LAS __attribute__((address_space(3)))
typedef unsigned short bf16_t;
typedef float f32x4 __attribute__((ext_vector_type(4)));
typedef float f32x2 __attribute__((ext_vector_type(2)));
typedef unsigned u32x4 __attribute__((ext_vector_type(4)));
typedef unsigned u32x2 __attribute__((ext_vector_type(2)));

constexpr int D = 1024, BATCH = 4, SEQ = 8192, CTX = 256, T = BATCH * SEQ, SEQA = SEQ + CTX, TA = BATCH * SEQA;
constexpr int NH = 8, HD = 64, DV = 128;
constexpr int SGU_DFF = 2048, SGU_CH = 128, SGU_G = 8, SGU_GC = 256;
constexpr int NE = 256, TOPK = 8, NGRP = 8, EDFF = 256;
constexpr int TK = T * TOPK;
constexpr int PADM = 256;
constexpr int PMAX = TK + NE * PADM;
constexpr float LN_EPS = 1e-5f, ALPHA = 1.4142135623730951f, ROUTED_SCALE = 2.5f;
constexpr float LAM_INIT = 0.2f;
constexpr int NWAVES = 8, NTHR = 512;

constexpr size_t MiB = 1u << 20;
constexpr size_t WS_CTL = 0, CTL_ZERO_BYTES = 1 * MiB;
constexpr int CW_BAR = 4096;
constexpr int CW_CNT = 32768;
constexpr size_t WS_MODV = 1 * MiB;
constexpr size_t WS_ROPE = WS_MODV + 512 * 1024;
constexpr size_t WS_IDX = 2 * MiB, WS_WGT = 3 * MiB, WS_POS = 4 * MiB;
constexpr size_t WS_SPAIR = 5 * MiB, WS_SW = 7 * MiB;
constexpr size_t WS_WIN_T = 16 * MiB;
constexpr size_t WS_WOUT_T = 22 * MiB;
constexpr size_t WS_SWIN_T = 24 * MiB;
constexpr size_t WS_SWOUT_T = 32 * MiB;
constexpr size_t WS_SHUP_T = 36 * MiB;
constexpr size_t WS_SHDN_T = 38 * MiB;
constexpr size_t WS_EUP_T = 48 * MiB;
constexpr size_t WS_EDN_T = 560 * MiB;
constexpr size_t WS_R = 816 * MiB;
constexpr size_t WS_HALL = WS_R, WS_Q = WS_R + 66 * MiB, WS_K = WS_R + 132 * MiB, WS_V = WS_R + 198 * MiB, WS_OATT = WS_R + 264 * MiB, WS_ATT = WS_R + 520 * MiB;
constexpr size_t WS_U = WS_R, WS_VB = WS_R + 128 * MiB, WS_GSP = WS_R + 256 * MiB, WS_VN = WS_R + 384 * MiB;
constexpr size_t WS_HO = WS_R;
constexpr size_t WS_Y = WS_R + 640 * MiB;
constexpr size_t WS_X1 = WS_Y + 64 * MiB;
constexpr size_t WS_HM = WS_X1 + 128 * MiB;
constexpr size_t WS_H1 = WS_HM + 64 * MiB;
constexpr size_t WS_LOG = WS_H1 + 64 * MiB;
constexpr size_t WS_HS = WS_LOG + 32 * MiB;
constexpr size_t WS_END = WS_HS + 176 * MiB;
static_assert(WS_END <= (size_t)2048 * MiB, "workspace map exceeds 2 GiB");
static_assert((size_t)(PMAX + T) * EDFF * 2 <= 176 * MiB && (size_t)TA * D * 2 <= 66 * MiB && (size_t)(TK + T + 1) * D * 2 <= 640 * MiB, "ws sizes");
static_assert((size_t)(PMAX + T) * 4 <= 2 * MiB, "slot tables");

constexpr int LDS_BYTES = 163840;
constexpr int LDS_MISC = 131072;
constexpr int LDS_PS = LDS_MISC + 256;
constexpr int LDS_TAB = LDS_MISC + 2048;
constexpr int MAXU_UP = 14, MAXU_DN = 28;
static_assert(LDS_TAB + 28 * 1024 <= LDS_BYTES, "LDS map");

#define XB_TMO      128
#define XB_XCNT(j)  (256  + 64 * (j))
#define XB_XSUB(j)  (1280 + 64 * (j))
#define XB_XGEN(j)  (2304 + 64 * (j))
#define XB_TOP      3328
#define XB_TOPGEN   3392
#define XCD_BAR_WORDS 3456
#define XB_SPIN_CAP (1u << 22)

__device__ __forceinline__ unsigned xb_ld(unsigned* p)              { return __hip_atomic_load(p, __ATOMIC_RELAXED, __HIP_MEMORY_SCOPE_AGENT); }
__device__ __forceinline__ unsigned xb_add(unsigned* p, unsigned v) { return __hip_atomic_fetch_add(p, v, __ATOMIC_RELAXED, __HIP_MEMORY_SCOPE_AGENT); }
__device__ __forceinline__ unsigned xb_xcc_id() { return (unsigned)__builtin_amdgcn_s_getreg((3 << 11) | 20) & 0xFu; }
#define XB_SPIN(cond, bar) do { unsigned _sp = 0; while (cond) { __builtin_amdgcn_s_sleep(1); \
    if ((++_sp & 255u) == 0u) { if (xb_ld(&(bar)[XB_TMO])) break; if (_sp > XB_SPIN_CAP) { atomicAdd(&(bar)[XB_TMO], 1u); break; } } } } while (0)

struct XcdBarrier { unsigned* bar; unsigned x; volatile LAS unsigned* st; };

__device__ __forceinline__ XcdBarrier xcd_barrier_post(unsigned* bar, volatile LAS unsigned* st) {
    XcdBarrier b; b.bar = bar; b.x = xb_xcc_id(); b.st = st;
    if (threadIdx.x == 0) (void)xb_add(&bar[XB_XCNT(b.x)], 1u);
    return b;
}
__device__ __forceinline__ void xcd_barrier_complete(unsigned* bar, unsigned x, unsigned& nloc, unsigned& nx) {
    const unsigned G = gridDim.x * gridDim.y * gridDim.z;
    unsigned sum, cnt, mine, sp = 0u;
    for (;;) {
        sum = 0u; cnt = 0u; mine = 0u;
#pragma unroll
        for (unsigned j = 0; j < 16; ++j) { const unsigned c = xb_ld(&bar[XB_XCNT(j)]); sum += c; cnt += (c > 0u) ? 1u : 0u; mine = (j == x) ? c : mine; }
        if (sum == G) break;
        __builtin_amdgcn_s_sleep(1);
        if ((++sp & 255u) == 0u) { if (xb_ld(&bar[XB_TMO])) break; if (sp > XB_SPIN_CAP) { atomicAdd(&bar[XB_TMO], 1u); break; } }
    }
    nloc = mine > 0u ? mine : 1u; nx = cnt > 0u ? cnt : 1u;
}
__device__ __forceinline__ void xcd_barrier(const XcdBarrier& b) {
    asm volatile("s_waitcnt vmcnt(0)" ::: "memory");
    __syncthreads();
    if (threadIdx.x == 0) {
        unsigned* bar = b.bar;
        __builtin_amdgcn_s_waitcnt(0);
        unsigned nloc = b.st[0], nx = b.st[1];
        if (nloc == 0u) { xcd_barrier_complete(bar, b.x, nloc, nx); b.st[0] = nloc; b.st[1] = nx; }
        const unsigned old = xb_add(&bar[XB_XSUB(b.x)], 1u);
        const unsigned gen = old / nloc;
        if (old + 1u == (gen + 1u) * nloc) {
            __builtin_amdgcn_fence(__ATOMIC_RELEASE, "agent");
            asm volatile("s_waitcnt vmcnt(0)" ::: "memory");
            const unsigned og = xb_add(&bar[XB_TOP], 1u);
            const unsigned tg = og / nx;
            if (og + 1u == (tg + 1u) * nx) xb_add(&bar[XB_TOPGEN], 1u);
            else XB_SPIN(xb_ld(&bar[XB_TOPGEN]) == tg, bar);
            __builtin_amdgcn_fence(__ATOMIC_ACQUIRE, "agent");
            xb_add(&bar[XB_XGEN(b.x)], 1u);
            asm volatile("s_waitcnt vmcnt(0)" ::: "memory");
        } else {
            XB_SPIN(xb_ld(&bar[XB_XGEN(b.x)]) == gen, bar);
            __builtin_amdgcn_fence(__ATOMIC_ACQUIRE, "agent");
            asm volatile("s_waitcnt vmcnt(0)" ::: "memory");
        }
    }
    __syncthreads();
}

__device__ __forceinline__ unsigned f2bf(float f) { unsigned u = __builtin_bit_cast(unsigned, f); return (u + 0x7fffu + ((u >> 16) & 1u)) >> 16; }
__device__ __forceinline__ float bf2f(unsigned b) { return __builtin_bit_cast(float, b << 16); }
__device__ __forceinline__ unsigned pk2(float lo, float hi) { return f2bf(lo) | (f2bf(hi) << 16); }
__device__ __forceinline__ float wave_sum(float v) {
#pragma unroll
    for (int o = 1; o < 64; o <<= 1) v += __shfl_xor(v, o);
    return v;
}
__device__ __forceinline__ float siluf(float x) { return x / (1.f + __expf(-x)); }
__device__ __forceinline__ float sigmoidf_(float x) { return 1.f / (1.f + __expf(-x)); }
__device__ __forceinline__ float gelu_erf(float x) { return 0.5f * x * (1.f + erff(x * 0.70710678118654752f)); }

template <class LoadA, class Epi>
__device__ __forceinline__ void gemm_tile(const LoadA& la, const float* __restrict__ W, int ldw, int K, int m0, int n0, float* sm, const Epi& E) {
    const int tid = threadIdx.x, ty = tid >> 4, tx = tid & 15;
    float* As = sm; float* Bs = sm + 16 * 132;
    f32x4 acc[4][2];
#pragma unroll
    for (int i = 0; i < 4; ++i) { acc[i][0] = (f32x4){0.f, 0.f, 0.f, 0.f}; acc[i][1] = (f32x4){0.f, 0.f, 0.f, 0.f}; }
    const int ar = tid >> 2, k4 = (tid & 3) * 4;
    const int bk = tid >> 5, bn = (tid & 31) * 4;
    const float* bp = W + (size_t)bk * ldw + n0 + bn;
    for (int k0 = 0; k0 < K; k0 += 16) {
        const f32x4 a = la(m0 + ar, k0 + k4);
        const f32x4 b = *(const f32x4*)(bp + (size_t)k0 * ldw);
        __syncthreads();
        As[(k4 + 0) * 132 + ar] = a.x; As[(k4 + 1) * 132 + ar] = a.y; As[(k4 + 2) * 132 + ar] = a.z; As[(k4 + 3) * 132 + ar] = a.w;
        *(f32x4*)&Bs[bk * 128 + bn] = b;
        __syncthreads();
#pragma unroll 4
        for (int kk = 0; kk < 16; ++kk) {
            const f32x4 av = *(const f32x4*)&As[kk * 132 + ty * 4];
            const f32x4 b0 = *(const f32x4*)&Bs[kk * 128 + tx * 8], b1 = *(const f32x4*)&Bs[kk * 128 + tx * 8 + 4];
#pragma unroll
            for (int i = 0; i < 4; ++i) { acc[i][0] += b0 * av[i]; acc[i][1] += b1 * av[i]; }
        }
    }
#pragma unroll
    for (int i = 0; i < 4; ++i) E(m0 + ty * 4 + i, n0 + tx * 8, acc[i][0], acc[i][1]);
}
struct LoadBf16 {
    const bf16_t* A; int lda; const int* rowidx;
    __device__ __forceinline__ f32x4 operator()(int r, int k) const {
        const int rr = rowidx ? rowidx[r] : r;
        const u32x2 w = *(const u32x2*)(A + (size_t)rr * lda + k);
        return (f32x4){bf2f(w.x & 0xffffu), bf2f(w.x >> 16), bf2f(w.y & 0xffffu), bf2f(w.y >> 16)};
    }
};
struct LoadF32 {
    const float* A; int lda;
    __device__ __forceinline__ f32x4 operator()(int r, int k) const { return *(const f32x4*)(A + (size_t)r * lda + k); }
};

namespace pg8 {
typedef short bf16x8 __attribute__((ext_vector_type(8)));
constexpr int BM = 256, BK = 64, HALF = 128, HTB = HALF * BK * 2, STAGE_BYTES = 8 * HTB, NXCD = 8, WGM = 8;
__host__ __device__ __forceinline__ int lds_byte(int r, int c) { const int st = (r >> 4) * 2 + (c >> 5), rr = r & 15, cc = c & 31, ob = rr * 64 + cc * 2; return st * 1024 + (ob ^ (((ob >> 9) & 1) << 5)); }
__host__ __device__ __forceinline__ void stage_rc(int b, int& R, int& C) { const int st = b / 1024, sb = b % 1024, swz = sb ^ (((sb >> 9) & 1) << 5); R = (st >> 1) * 16 + swz / 64; C = (st & 1) * 32 + (swz % 64) / 2; }
__host__ __device__ __forceinline__ int perm32(int rho) { const int n = rho >> 4, i = rho & 15; return 8 * (i >> 2) + 4 * n + (i & 3); }

struct Unit { int pm, pn, row0, e, ord; };

__device__ __forceinline__ unsigned cvt_pk_bf16(float lo, float hi) { unsigned r; asm volatile("v_cvt_pk_bf16_f32 %0, %1, %2" : "=v"(r) : "v"(lo), "v"(hi)); return r; }
__device__ __forceinline__ f32x2 gelu_pk(f32x2 v) {
    const f32x2 av = __builtin_elementwise_abs(v), d = av * 0.2316418882f + 1.0f;
    f32x2 t; t.x = __builtin_amdgcn_rcpf(d.x); t.y = __builtin_amdgcn_rcpf(d.y);
    f32x2 q = t * 0.5307027145f + (-0.7265760135f); q = q * t + 0.7107068705f; q = q * t + (-0.142248368f); q = q * t + 0.127414796f; q = q * t;
    const f32x2 s = (v * v) * (-0.72134752044f);
    f32x2 e; e.x = __builtin_amdgcn_exp2f(s.x); e.y = __builtin_amdgcn_exp2f(s.y);
    const f32x2 m = v * (q * e), r = v - m;
    f32x2 o; o.x = v.x < 0.f ? m.x : r.x; o.y = v.y < 0.f ? m.y : r.y; return o;
}
template <int ACT> struct EpiBf16 {
    static constexpr bool PERM = true;
    bf16_t* O; int ldc; const float* bias; int split_cols; size_t split_stride;
    __device__ __forceinline__ void operator()(const f32x4 (&acc)[2][2][4][2], const Unit& u, int wr, int wc, int fr, int fq) const {
        const int row0 = u.pm * BM + wr * 64 + fr; int colt = u.pn * BM; bf16_t* base = O;
        if (split_cols) { const int t = colt / split_cols; base += (size_t)t * split_stride; colt -= t * split_cols; }
        const int col0 = colt + wc * 32 + 8 * fq, bcol0 = u.pn * BM + wc * 32 + 8 * fq;
        f32x4 bv[2][2];
#pragma unroll
        for (int bj = 0; bj < 2; ++bj)
#pragma unroll
            for (int n = 0; n < 2; ++n) bv[bj][n] = bias ? *(const f32x4*)(bias + bcol0 + bj * HALF + 4 * n) : (f32x4){0.f, 0.f, 0.f, 0.f};
#pragma unroll
        for (int ai = 0; ai < 2; ++ai)
#pragma unroll
            for (int m = 0; m < 4; ++m) { bf16_t* rowp = base + (size_t)(row0 + ai * HALF + m * 16) * ldc + col0;
#pragma unroll
                for (int bj = 0; bj < 2; ++bj) { f32x4 v0 = acc[ai][bj][m][0] + bv[bj][0], v1 = acc[ai][bj][m][1] + bv[bj][1];
                    if (ACT == 1) { f32x2 a = gelu_pk((f32x2){v0[0], v0[1]}), b = gelu_pk((f32x2){v0[2], v0[3]}), c = gelu_pk((f32x2){v1[0], v1[1]}), d = gelu_pk((f32x2){v1[2], v1[3]});
                        v0 = (f32x4){a.x, a.y, b.x, b.y}; v1 = (f32x4){c.x, c.y, d.x, d.y}; }
                    u32x4 w; w.x = cvt_pk_bf16(v0[0], v0[1]); w.y = cvt_pk_bf16(v0[2], v0[3]); w.z = cvt_pk_bf16(v1[0], v1[1]); w.w = cvt_pk_bf16(v1[2], v1[3]);
                    *(u32x4*)(rowp + bj * HALF) = w; } }
    }
};
struct EpiQKV {
    static constexpr bool PERM = true;
    bf16_t* Q; size_t stride; const float* rope; float qscale;
    __device__ __forceinline__ void operator()(const f32x4 (&acc)[2][2][4][2], const Unit& u, int wr, int wc, int fr, int fq) const {
        const int row0 = u.pm * BM + wr * 64 + fr, colt = u.pn * BM, t = colt >> 10, cbase = colt & 1023;
        bf16_t* base = Q + (size_t)t * stride;
        const bool do_rope = (t < 2) && ((u.pm % 33) != 32);
        const float sc = (t == 0) ? qscale : 1.f;
        const float sgn = (fq < 2) ? -1.f : 1.f;
        const bool lowhalf = (fq < 2);
#pragma unroll
        for (int ai = 0; ai < 2; ++ai)
#pragma unroll
            for (int m = 0; m < 4; ++m) {
                const int r = row0 + ai * HALF + m * 16, nseq = r % SEQA;
                const int pos = (wc & 1) ? (nseq & 63) : (nseq >> 6);
                f32x4 cs[4];
                if (do_rope) { const f32x4* rp = (const f32x4*)(rope + (pos * 16 + 8 * (fq & 1)) * 2);
#pragma unroll
                    for (int q4 = 0; q4 < 4; ++q4) cs[q4] = rp[q4]; }
                bf16_t* rowp = base + (size_t)r * D + cbase + wc * 32 + 8 * fq;
#pragma unroll
                for (int bj = 0; bj < 2; ++bj) {
                    float v[8];
#pragma unroll
                    for (int n = 0; n < 2; ++n)
#pragma unroll
                        for (int j = 0; j < 4; ++j) v[n * 4 + j] = acc[ai][bj][m][n][j];
                    if (do_rope) {
#pragma unroll
                        for (int i = 0; i < 8; ++i) {
                            const unsigned xb = __builtin_bit_cast(unsigned, v[i]);
                            auto rr = __builtin_amdgcn_permlane32_swap(xb, xb, false, false);
                            const float partner = __builtin_bit_cast(float, lowhalf ? rr[1] : rr[0]);
                            const float c = cs[i >> 1][(i & 1) * 2], s = cs[i >> 1][(i & 1) * 2 + 1];
                            v[i] = v[i] * c + sgn * partner * s;
                        }
                    }
                    u32x4 w; w.x = cvt_pk_bf16(v[0] * sc, v[1] * sc); w.y = cvt_pk_bf16(v[2] * sc, v[3] * sc); w.z = cvt_pk_bf16(v[4] * sc, v[5] * sc); w.w = cvt_pk_bf16(v[6] * sc, v[7] * sc);
                    *(u32x4*)(rowp + bj * HALF) = w;
                }
            }
    }
};
template <int MAXU> struct EpiMoeUp {
    static constexpr bool PERM = true;
    bf16_t* HS; const LAS float* wtab;
    __device__ __forceinline__ void operator()(const f32x4 (&acc)[2][2][4][2], const Unit& u, int wr, int wc, int fr, int fq) const {
#pragma unroll
        for (int ai = 0; ai < 2; ++ai)
#pragma unroll
            for (int m = 0; m < 4; ++m) {
                const int rr = ai * HALF + wr * 64 + m * 16 + fr;
                const float w = wtab[u.ord * 256 + rr];
                float h[8];
#pragma unroll
                for (int n = 0; n < 2; ++n)
#pragma unroll
                    for (int j = 0; j < 4; ++j) { const float g = acc[ai][0][m][n][j], up = acc[ai][1][m][n][j]; h[n * 4 + j] = w * up * g * __builtin_amdgcn_rcpf(1.f + __expf(-g)); }
                u32x4 o; o.x = cvt_pk_bf16(h[0], h[1]); o.y = cvt_pk_bf16(h[2], h[3]); o.z = cvt_pk_bf16(h[4], h[5]); o.w = cvt_pk_bf16(h[6], h[7]);
                *(u32x4*)(HS + (size_t)(u.row0 + rr) * EDFF + u.pn * 128 + wc * 32 + 8 * fq) = o;
            }
    }
};
template <int MAXU> struct EpiMoeDown {
    static constexpr bool PERM = true;
    bf16_t* HO; const LAS int* ptab;
    __device__ __forceinline__ void operator()(const f32x4 (&acc)[2][2][4][2], const Unit& u, int wr, int wc, int fr, int fq) const {
#pragma unroll
        for (int ai = 0; ai < 2; ++ai)
#pragma unroll
            for (int m = 0; m < 4; ++m) {
                const int rr = ai * HALF + wr * 64 + m * 16 + fr;
                int p = ptab[u.ord * 256 + rr]; p = p < 0 ? (TK + T) : p;
                bf16_t* rowp = HO + (size_t)p * D + u.pn * BM + wc * 32 + 8 * fq;
#pragma unroll
                for (int bj = 0; bj < 2; ++bj) { const f32x4 v0 = acc[ai][bj][m][0], v1 = acc[ai][bj][m][1];
                    u32x4 o; o.x = cvt_pk_bf16(v0[0], v0[1]); o.y = cvt_pk_bf16(v0[2], v0[3]); o.z = cvt_pk_bf16(v1[0], v1[1]); o.w = cvt_pk_bf16(v1[2], v1[3]);
                    *(u32x4*)(rowp + bj * HALF) = o; }
            }
    }
};

struct DenseSched {
    const char* A; const char* Bt; int K, nM, nN, nwg, G, c;
    __device__ __forceinline__ void init(const void* A_, const void* Bt_, int M, int N, int K_, int G_, int c_) { A = (const char*)A_; Bt = (const char*)Bt_; K = K_; nM = M / BM; nN = N / BM; nwg = nM * nN; G = G_; c = c_; }
    __device__ __forceinline__ bool next(int i, Unit& u) const {
        const long L = (long)i * G + c; if (L >= nwg) return false;
        int wgid = (int)L; { const int q = nwg / NXCD, r = nwg % NXCD, xcd = wgid % NXCD, off = wgid / NXCD; wgid = (xcd < r ? xcd * (q + 1) : r * (q + 1) + (xcd - r) * q) + off; }
        const int nig = WGM * nN, gid = wgid / nig, fm = gid * WGM, gsz = (nM - fm) < WGM ? (nM - fm) : WGM;
        u.pm = fm + ((wgid % nig) % gsz); u.pn = (wgid % nig) / gsz; u.row0 = 0; u.e = 0; u.ord = i; return true;
    }
    __device__ __forceinline__ const char* a_base() const { return A; }
    __device__ __forceinline__ unsigned a_off(const Unit& u, int h, int R, int C) const { return (unsigned)(((u.pm * BM + h * HALF + R) * K + C) * 2); }
    __device__ __forceinline__ const char* b_base(const Unit& u) const { return Bt + (size_t)u.pn * BM * K * 2; }
};
template <bool GATHER, int MAXU> struct MoeSched {
    const char* A; const char* Bexp; const char* Bsh; size_t b_estride; int K, NPN, x, r, W;
    const LAS int* ps; const LAS int* xps; const LAS int* ptab;
    __device__ __forceinline__ bool next_any(int i, Unit& u) const {
        const int uu = i * W + r, nrt = __builtin_amdgcn_readfirstlane(xps[32]), tot = (nrt + 16) * NPN; if (uu >= tot) return false;
        const int rtl = uu / NPN; u.pn = uu % NPN; u.pm = 0; u.ord = i;
        if (rtl < nrt) { int a = 0, b = 32; while (b - a > 1) { const int mid = (a + b) >> 1; if (__builtin_amdgcn_readfirstlane(xps[mid]) <= rtl) a = mid; else b = mid; }
            u.e = x + 8 * a; u.row0 = __builtin_amdgcn_readfirstlane(ps[u.e]) + (rtl - __builtin_amdgcn_readfirstlane(xps[a])) * BM; }
        else { u.e = NE; u.row0 = PMAX + (x * 16 + (rtl - nrt)) * BM; }
        return true;
    }
    __device__ __forceinline__ bool next(int i, Unit& u) const { return i < MAXU && next_any(i, u); }
    __device__ __forceinline__ const char* a_base() const { return A; }
    __device__ __forceinline__ unsigned a_off(const Unit& u, int h, int R, int C) const {
        const int row = h * HALF + R;
        if (GATHER) { const int p = ptab[u.ord * 256 + row]; const int tok = p < 0 ? 0 : (p < TK ? (p >> 3) : (p - TK)); return (unsigned)((tok * K + C) * 2); }
        else return (unsigned)(((u.row0 + row) * K + C) * 2);
    }
    __device__ __forceinline__ const char* b_base(const Unit& u) const { return (u.e < NE ? Bexp + (size_t)u.e * b_estride : Bsh) + (size_t)u.pn * BM * K * 2; }
};

template <class Epi, class Sched, bool ALIGN_EPI>
__device__ __forceinline__ void gemm_phase(LAS unsigned char* lds, const int K, const Sched& S, const Epi& E) {
    const int tid = threadIdx.x, wid = __builtin_amdgcn_readfirstlane(tid >> 6), lane = tid & 63, wr = wid >> 2, wc = wid & 3, fr = lane & 15, fq = lane >> 4;
    const int nt = K / BK;
    int sR[2], sC[2]; unsigned voffB[2];
#pragma unroll
    for (int i = 0; i < 2; ++i) { int R, C; stage_rc(tid * 16 + i * 8192, R, C); sR[i] = R; sC[i] = C; const int Rb = Epi::PERM ? ((R & ~31) + perm32(R & 31)) : R; voffB[i] = (unsigned)(Rb * K + C) * 2u; }
    const size_t kstep = (size_t)(BK * 2);
    const size_t hstep = (size_t)HALF * K * 2;
    const unsigned ldsw = (unsigned)wid * 1024u;
    const int aoff = lds_byte(wr * 64 + fr, fq * 8), boff = lds_byte(wc * 32 + fr, fq * 8);
#define PG8_SA(b, h) (((b) * 2 + (h)) * HTB)
#define PG8_SB(b, h) ((4 + (b) * 2 + (h)) * HTB)
#define PG8_STAGE(bufoff, gbase, voff) do { _Pragma("unroll") for (int _i = 0; _i < 2; ++_i) \
        __builtin_amdgcn_global_load_lds((const unsigned*)((const char*)(gbase) + (voff)[_i]), (LAS unsigned*)(lds + (bufoff) + ldsw + _i * 8192), 16, 0, 0); } while (0)
#define PG8_LDA(dst, b, h) do { _Pragma("unroll") for (int m = 0; m < 4; ++m) _Pragma("unroll") for (int k = 0; k < 2; ++k) dst[m][k] = *(const LAS bf16x8*)(lds + PG8_SA(b, h) + aoff + m * 2048 + k * 1024); } while (0)
#define PG8_LDB(dst, b, h) do { _Pragma("unroll") for (int n = 0; n < 2; ++n) _Pragma("unroll") for (int k = 0; k < 2; ++k) dst[n][k] = *(const LAS bf16x8*)(lds + PG8_SB(b, h) + boff + n * 2048 + k * 1024); } while (0)
#define PG8_MMA(ai, bj, At, Bt) do { __builtin_amdgcn_s_setprio(1); _Pragma("unroll") for (int m = 0; m < 4; ++m) _Pragma("unroll") for (int n = 0; n < 2; ++n) _Pragma("unroll") for (int k = 0; k < 2; ++k) \
        acc[ai][bj][m][n] = __builtin_amdgcn_mfma_f32_16x16x32_bf16(Bt[n][k], At[m][k], acc[ai][bj][m][n], 0, 0, 0); __builtin_amdgcn_s_setprio(0); } while (0)
#define PG8_WAIT_V(n) asm volatile("s_waitcnt vmcnt(" #n ")" ::: "memory")
#define PG8_WAIT_L(n) asm volatile("s_waitcnt lgkmcnt(" #n ")" ::: "memory")
#define PG8_BAR __builtin_amdgcn_s_barrier()
#define PG8_SCHED __builtin_amdgcn_sched_barrier(0)
    Unit cur, nxt; int ui = 0;
    if (!S.next(0, cur)) return;
    f32x4 acc[2][2][4][2];
#pragma unroll
    for (int a = 0; a < 2; ++a)
#pragma unroll
        for (int b = 0; b < 2; ++b)
#pragma unroll
            for (int m = 0; m < 4; ++m)
#pragma unroll
                for (int n = 0; n < 2; ++n) acc[a][b][m][n] = (f32x4){0.f, 0.f, 0.f, 0.f};
    bf16x8 At[4][2], B0[2][2], B1[2][2];
    unsigned cao[2][2], nao[2][2];
#pragma unroll
    for (int h = 0; h < 2; ++h)
#pragma unroll
        for (int i = 0; i < 2; ++i) cao[h][i] = S.a_off(cur, h, sR[i], sC[i]);
    const char* const Ab = S.a_base();
    const char* cB = S.b_base(cur);
    PG8_STAGE(PG8_SB(0, 0), cB, voffB); PG8_STAGE(PG8_SB(0, 1), cB + hstep, voffB); PG8_STAGE(PG8_SA(0, 0), Ab, cao[0]); PG8_STAGE(PG8_SA(0, 1), Ab, cao[1]);
    if (wr == 1) PG8_BAR;
    PG8_WAIT_V(2); PG8_BAR;
    PG8_STAGE(PG8_SB(1, 0), cB + kstep, voffB); PG8_STAGE(PG8_SA(1, 0), Ab + kstep, cao[0]); PG8_STAGE(PG8_SB(1, 1), cB + hstep + kstep, voffB);
    PG8_WAIT_V(6); PG8_BAR;
    for (;;) {
        const bool has_next = S.next(ui + 1, nxt);
        const char* nB = has_next ? S.b_base(nxt) : cB;
#pragma unroll
        for (int h = 0; h < 2; ++h)
#pragma unroll
            for (int i = 0; i < 2; ++i) nao[h][i] = has_next ? S.a_off(nxt, h, sR[i], sC[i]) : cao[h][i];
#pragma nounroll
        for (int t = 0; t < nt; t += 2) {
            const bool last = (t == nt - 2);
            const char* a1 = Ab + (size_t)(t + 1) * kstep;
            const char* a2 = last ? Ab : Ab + (size_t)(t + 2) * kstep; const char* b2 = last ? nB : cB + (size_t)(t + 2) * kstep;
            const char* a3 = a2 + kstep; const char* b3 = b2 + kstep;
            unsigned o2[2][2];
#pragma unroll
            for (int h = 0; h < 2; ++h)
#pragma unroll
                for (int i = 0; i < 2; ++i) o2[h][i] = last ? nao[h][i] : cao[h][i];
            PG8_LDB(B0, 0, 0); PG8_LDB(B1, 0, 1); PG8_SCHED; PG8_LDA(At, 0, 0); PG8_STAGE(PG8_SA(1, 1), a1, cao[1]);
            PG8_WAIT_V(8); PG8_WAIT_L(0); PG8_BAR; PG8_MMA(0, 0, At, B0); PG8_MMA(0, 1, At, B1); PG8_BAR; PG8_SCHED;
            PG8_LDA(At, 0, 1); PG8_STAGE(PG8_SB(0, 0), b2, voffB); PG8_STAGE(PG8_SB(0, 1), b2 + hstep, voffB); PG8_STAGE(PG8_SA(0, 0), a2, o2[0]);
            PG8_WAIT_V(8); PG8_WAIT_L(0); PG8_BAR; PG8_MMA(1, 0, At, B0); PG8_MMA(1, 1, At, B1); PG8_BAR; PG8_SCHED;
            PG8_LDB(B0, 1, 0); PG8_LDB(B1, 1, 1); PG8_SCHED; PG8_LDA(At, 1, 0); PG8_STAGE(PG8_SA(0, 1), a2, o2[1]);
            PG8_WAIT_V(8); PG8_WAIT_L(0); PG8_BAR; PG8_MMA(0, 0, At, B0); PG8_MMA(0, 1, At, B1); PG8_BAR; PG8_SCHED;
            PG8_LDA(At, 1, 1); PG8_STAGE(PG8_SB(1, 0), b3, voffB); PG8_STAGE(PG8_SB(1, 1), b3 + hstep, voffB); PG8_STAGE(PG8_SA(1, 0), a3, o2[0]);
            PG8_WAIT_V(8); PG8_WAIT_L(0); PG8_BAR; PG8_MMA(1, 0, At, B0); PG8_MMA(1, 1, At, B1); PG8_BAR; PG8_SCHED;
        }
        if constexpr (ALIGN_EPI) { if (wr == 0) PG8_BAR; }
        E(acc, cur, wr, wc, fr, fq);
        if (!has_next) break;
#pragma unroll
        for (int a = 0; a < 2; ++a)
#pragma unroll
            for (int b = 0; b < 2; ++b)
#pragma unroll
                for (int m = 0; m < 4; ++m)
#pragma unroll
                    for (int n = 0; n < 2; ++n) acc[a][b][m][n] = (f32x4){0.f, 0.f, 0.f, 0.f};
        cur = nxt; cB = nB; ++ui;
#pragma unroll
        for (int h = 0; h < 2; ++h)
#pragma unroll
            for (int i = 0; i < 2; ++i) cao[h][i] = nao[h][i];
        if constexpr (ALIGN_EPI) { if (wr == 1) PG8_BAR; }
    }
    PG8_WAIT_V(0);
    if constexpr (!ALIGN_EPI) { if (wr == 0) PG8_BAR; }
    PG8_BAR;
#undef PG8_SA
#undef PG8_SB
#undef PG8_STAGE
#undef PG8_LDA
#undef PG8_LDB
#undef PG8_MMA
#undef PG8_WAIT_V
#undef PG8_WAIT_L
#undef PG8_BAR
#undef PG8_SCHED
}
}

namespace att {
using bf16x8 = __attribute__((ext_vector_type(8))) short;
using s16x4  = __attribute__((ext_vector_type(4))) short;
using f32x16 = __attribute__((ext_vector_type(16))) float;
constexpr int QBLK = 32, KVBLK = 64, UNIT_ROWS = 128, LDR = D;
constexpr float SCALE = 0.125f;
constexpr float THR = 8.f;
constexpr size_t SHM_V = KVBLK * 128 * 2, SHM_K = KVBLK * 128 * 2, SHM_ATTN = 2 * SHM_V + 2 * SHM_K + 8 * 64 * 4;
#define KSWZ(row, colB) ((row) * 256 + ((colB) ^ (((row) & 7) << 4)))
#define SBAR() __builtin_amdgcn_sched_barrier(0)
__device__ __forceinline__ int crow(int r, int hi) { return (r & 3) + 8 * (r >> 2) + 4 * hi; }
__device__ __forceinline__ unsigned cvtpk(float lo, float hi) { unsigned r; asm volatile("v_cvt_pk_bf16_f32 %0, %1, %2" : "=v"(r) : "v"(lo), "v"(hi)); return r; }

__device__ __forceinline__ void partialSM(f32x16& p0, f32x16& p1, float& m_reg, float& mn, float& alpha) {
  constexpr float C = SCALE * 1.4426950408889634f;
  float pmax = p0[0]; for (int r = 1; r < 16; ++r) pmax = fmaxf(pmax, p0[r]); for (int r = 0; r < 16; ++r) pmax = fmaxf(pmax, p1[r]);
  { auto rr = __builtin_amdgcn_permlane32_swap(__float_as_uint(pmax), __float_as_uint(pmax), false, false);
    pmax = fmaxf(__uint_as_float(rr[0]), __uint_as_float(rr[1])); }
  if (__builtin_expect(__all(pmax - m_reg <= THR / SCALE), 1)) { mn = m_reg; alpha = 1.f; }
  else { mn = fmaxf(m_reg, pmax); alpha = __builtin_amdgcn_exp2f((m_reg - mn) * C); m_reg = mn; }
  float mnC = -mn * C;
  for (int r = 0; r < 16; ++r) p0[r] = fmaf(p0[r], C, mnC); for (int r = 0; r < 16; ++r) p1[r] = fmaf(p1[r], C, mnC);
  for (int r = 0; r < 16; ++r) p0[r] = __builtin_amdgcn_exp2f(p0[r]);
}
__device__ __forceinline__ void finishSM(f32x16& p0, f32x16& p1, float alpha, float& l_reg, bf16x8& pa0, bf16x8& pa1, bf16x8& pa2, bf16x8& pa3) {
  for (int r = 0; r < 16; ++r) p1[r] = __builtin_amdgcn_exp2f(p1[r]);
  float ps = 0; for (int r = 0; r < 16; ++r) ps += p0[r]; for (int r = 0; r < 16; ++r) ps += p1[r];
  { auto rr = __builtin_amdgcn_permlane32_swap(__float_as_uint(ps), __float_as_uint(ps), false, false);
    ps = __uint_as_float(rr[0]) + __uint_as_float(rr[1]); }
  l_reg = l_reg * alpha + ps;
#define PK4(P, BASE, OUT) do { unsigned a0 = cvtpk(P[BASE + 0], P[BASE + 1]), a1 = cvtpk(P[BASE + 2], P[BASE + 3]);   \
    unsigned b0 = cvtpk(P[BASE + 4], P[BASE + 5]), b1 = cvtpk(P[BASE + 6], P[BASE + 7]);                              \
    auto r0 = __builtin_amdgcn_permlane32_swap(a0, b0, false, false); auto r1 = __builtin_amdgcn_permlane32_swap(a1, b1, false, false); \
    u32x4 w = {r0[0], r1[0], r0[1], r1[1]}; OUT = *reinterpret_cast<bf16x8*>(&w); } while (0)
  PK4(p0, 0, pa0); PK4(p0, 8, pa1); PK4(p1, 0, pa2); PK4(p1, 8, pa3);
#undef PK4
}
__device__ __forceinline__ void qkt(f32x16& p0, f32x16& p1, const bf16_t* Ks, const bf16x8* qr, int r32, int hi, int mp) {
  p0 = f32x16{}; p1 = f32x16{};
#pragma unroll
  for (int d0 = 0; d0 < 4; ++d0) { int cb = ((mp * 4 + d0) * 16 + hi * 8) * 2;
    bf16x8 b0 = *reinterpret_cast<const bf16x8*>((const char*)Ks + KSWZ(r32, cb));
    bf16x8 b1 = *reinterpret_cast<const bf16x8*>((const char*)Ks + KSWZ(32 + r32, cb));
    p0 = __builtin_amdgcn_mfma_f32_32x32x16_bf16(b0, qr[d0], p0, 0, 0, 0);
    p1 = __builtin_amdgcn_mfma_f32_32x32x16_bf16(b1, qr[d0], p1, 0, 0, 0); }
}
__device__ __forceinline__ int v_st(int k, int c) { const int kk = (k & ~0xC) | ((k & 4) << 1) | ((k & 8) >> 1); return ((kk >> 3) * 4 + (c >> 5)) * 512 + ((kk & 7) * 32 + (c & 31)) * 2; }
__device__ __forceinline__ int v_rd_base(int lane) { return ((lane & 3) << 3) | (((lane >> 2) & 3) << 6) | (((lane >> 4) & 1) << 5) | (((lane >> 5) & 1) << 8); }
constexpr int v_rd_off(int d0, int ks, int half) { return d0 * 512 + ks * 4096 + half * 2048; }
template <int OFF> __device__ __forceinline__ s16x4 tr_read(int vb) {
  s16x4 r; asm volatile("ds_read_b64_tr_b16 %0, %1 offset:%2" : "=&v"(r) : "v"(vb), "i"(OFF) : "memory"); return r;
}
template <int D0> __device__ __forceinline__ void pv_one(f32x16& od, int vb, bf16x8 pa0, bf16x8 pa1, bf16x8 pa2, bf16x8 pa3) {
  const s16x4 l0 = tr_read<v_rd_off(D0, 0, 0)>(vb), h0 = tr_read<v_rd_off(D0, 0, 1)>(vb), l1 = tr_read<v_rd_off(D0, 1, 0)>(vb), h1 = tr_read<v_rd_off(D0, 1, 1)>(vb);
  const s16x4 l2 = tr_read<v_rd_off(D0, 2, 0)>(vb), h2 = tr_read<v_rd_off(D0, 2, 1)>(vb), l3 = tr_read<v_rd_off(D0, 3, 0)>(vb), h3 = tr_read<v_rd_off(D0, 3, 1)>(vb);
  asm volatile("s_waitcnt lgkmcnt(0)" ::: "memory"); SBAR();
#define PK(L, H) (bf16x8){L[0], L[1], L[2], L[3], H[0], H[1], H[2], H[3]}
  od = __builtin_amdgcn_mfma_f32_32x32x16_bf16(pa0, PK(l0, h0), od, 0, 0, 0);
  od = __builtin_amdgcn_mfma_f32_32x32x16_bf16(pa1, PK(l1, h1), od, 0, 0, 0);
  od = __builtin_amdgcn_mfma_f32_32x32x16_bf16(pa2, PK(l2, h2), od, 0, 0, 0);
  od = __builtin_amdgcn_mfma_f32_32x32x16_bf16(pa3, PK(l3, h3), od, 0, 0, 0);
#undef PK
}
__device__ __forceinline__ void pv_d0(f32x16* o, int vb, bf16x8 pa0, bf16x8 pa1, bf16x8 pa2, bf16x8 pa3) {
  pv_one<0>(o[0], vb, pa0, pa1, pa2, pa3); pv_one<1>(o[1], vb, pa0, pa1, pa2, pa3); pv_one<2>(o[2], vb, pa0, pa1, pa2, pa3); pv_one<3>(o[3], vb, pa0, pa1, pa2, pa3);
}

__device__ __forceinline__ void attn_unit(const bf16_t* __restrict__ Qb, const bf16_t* __restrict__ Kh, const bf16_t* __restrict__ Vh, bf16_t* __restrict__ Ob,
                                          float lam, const float* __restrict__ gsub, int seq, char* lds) {
  const int tid = threadIdx.x, wid = tid >> 6, lane = tid & 63, r32 = lane & 31, hi = lane >> 5, mp = wid >> 2, wq = wid & 3;
  bf16_t* V_lds = (bf16_t*)lds; bf16_t* K_lds = (bf16_t*)(lds + 2 * SHM_V);
  float* ws = (float*)(lds + 2 * SHM_V + 2 * SHM_K) + wid * 64; float* li_l = ws; float* al_l = ws + 32;
  float m_reg = -1e30f, l_reg = 0; f32x16 o[4] = {}; bf16x8 qr[4];
  const bf16_t* Qw = Qb + (long)(wq * QBLK + r32) * LDR + mp * 64 + hi * 8;
#pragma unroll
  for (int d0 = 0; d0 < 4; ++d0) qr[d0] = *reinterpret_cast<const bf16x8*>(Qw + d0 * 16);
  const int sr = tid >> 4, sc = (tid & 15) * 8, vst0 = v_st(sr, sc), vst1 = v_st(32 + sr, sc);
  const int vb0 = (int)(uintptr_t)V_lds + v_rd_base(lane);
  struct { bf16x8 vs0, vs1, ks0, ks1; } sr_[2];
#define SLOAD(i, k0) do { sr_[i].vs0 = *reinterpret_cast<const bf16x8*>(&Vh[(long)((k0) + sr) * LDR + sc]); sr_[i].vs1 = *reinterpret_cast<const bf16x8*>(&Vh[(long)((k0) + 32 + sr) * LDR + sc]); \
    sr_[i].ks0 = *reinterpret_cast<const bf16x8*>(&Kh[(long)((k0) + sr) * LDR + sc]); sr_[i].ks1 = *reinterpret_cast<const bf16x8*>(&Kh[(long)((k0) + 32 + sr) * LDR + sc]); } while (0)
#define SWRITE(b, i) do { *(bf16x8*)((char*)V_lds + (b) * SHM_V + vst0) = sr_[i].vs0;          \
    *(bf16x8*)((char*)V_lds + (b) * SHM_V + vst1) = sr_[i].vs1; int kc = sc * 2;               \
    *(bf16x8*)((char*)K_lds + (b) * SHM_K + KSWZ(sr, kc)) = sr_[i].ks0;                       \
    *(bf16x8*)((char*)K_lds + (b) * SHM_K + KSWZ(32 + sr, kc)) = sr_[i].ks1; } while (0)
#define SWAIT() asm volatile("s_waitcnt vmcnt(4)" ::: "memory")
#define RESC(a) do { if (__any((a) < 1.f)) { if (hi == 0) al_l[r32] = (a); asm volatile("s_waitcnt lgkmcnt(0)" ::: "memory"); \
    for (int d = 0; d < 4; ++d) for (int r = 0; r < 16; ++r) o[d][r] *= al_l[crow(r, hi)]; } } while (0)
  f32x16 pA0, pA1, pB0, pB1; float mnA, mnB, alA, alB; bf16x8 pa0, pa1, pa2, pa3; const int NT = seq / KVBLK;
  constexpr int SE = 0, SO = 1;
  SLOAD(SE, 0); asm volatile("s_waitcnt vmcnt(0)" ::: "memory"); SWRITE(0, SE); __syncthreads();
  qkt(pA0, pA1, K_lds, qr, r32, hi, mp); partialSM(pA0, pA1, m_reg, mnA, alA);
  SLOAD(SO, KVBLK); if (2 < NT) SLOAD(SE, 2 * KVBLK);
  SWAIT(); SWRITE(1, SO); __syncthreads();
  for (int j = 1; j + 1 < NT; j += 2) {
    SBAR(); qkt(pB0, pB1, (bf16_t*)((char*)K_lds + SHM_K), qr, r32, hi, mp);
    finishSM(pA0, pA1, alA, l_reg, pa0, pa1, pa2, pa3); SBAR();
    SLOAD(SO, (j + 2) * KVBLK); SBAR();
    pv_d0(o, vb0, pa0, pa1, pa2, pa3); partialSM(pB0, pB1, m_reg, mnB, alB);
    __syncthreads(); SWAIT(); SWRITE(0, SE);
    RESC(alB); __syncthreads();
    SBAR(); qkt(pA0, pA1, K_lds, qr, r32, hi, mp);
    finishSM(pB0, pB1, alB, l_reg, pa0, pa1, pa2, pa3); SBAR();
    if (j + 3 < NT) SLOAD(SE, (j + 3) * KVBLK); SBAR();
    pv_d0(o, vb0 + (int)SHM_V, pa0, pa1, pa2, pa3); partialSM(pA0, pA1, m_reg, mnA, alA);
    __syncthreads(); SWAIT(); SWRITE(1, SO);
    RESC(alA); __syncthreads();
  }
  SBAR(); qkt(pB0, pB1, (bf16_t*)((char*)K_lds + SHM_K), qr, r32, hi, mp);
  finishSM(pA0, pA1, alA, l_reg, pa0, pa1, pa2, pa3); SBAR();
  pv_d0(o, vb0, pa0, pa1, pa2, pa3); partialSM(pB0, pB1, m_reg, mnB, alB);
  __syncthreads(); RESC(alB);
  finishSM(pB0, pB1, alB, l_reg, pa0, pa1, pa2, pa3); SBAR();
  pv_d0(o, vb0 + (int)SHM_V, pa0, pa1, pa2, pa3);
  if (hi == 0) li_l[r32] = l_reg; asm volatile("s_waitcnt lgkmcnt(0)" ::: "memory");
#pragma unroll
  for (int r = 0; r < 16; ++r) { const float rl = __builtin_amdgcn_rcpf(li_l[crow(r, hi)]);
#pragma unroll
    for (int d0 = 0; d0 < 4; ++d0) o[d0][r] *= rl; }
  __syncthreads();
  float* ex = (float*)lds + wq * 4096;
  if (mp == 1) {
#pragma unroll
    for (int d0 = 0; d0 < 4; ++d0)
#pragma unroll
      for (int r = 0; r < 16; ++r) ex[(d0 * 16 + r) * 64 + lane] = o[d0][r];
  }
  __syncthreads();
  if (mp == 0) {
    float gq[4];
#pragma unroll
    for (int d0 = 0; d0 < 4; ++d0) gq[d0] = gsub[d0 * 32 + r32] * (1.f - LAM_INIT);
    bf16_t* Ow = Ob + (long)(wq * QBLK) * LDR;
#pragma unroll
    for (int r = 0; r < 16; ++r) {
      float ss = 0.f;
#pragma unroll
      for (int d0 = 0; d0 < 4; ++d0) { o[d0][r] -= lam * ex[(d0 * 16 + r) * 64 + lane]; ss += o[d0][r] * o[d0][r]; }
      ss += __shfl_xor(ss, 1); ss += __shfl_xor(ss, 2); ss += __shfl_xor(ss, 4); ss += __shfl_xor(ss, 8); ss += __shfl_xor(ss, 16);
      const float rn = 1.f / sqrtf(ss * (1.f / DV) + LN_EPS);
      const int orow = crow(r, hi);
#pragma unroll
      for (int d0 = 0; d0 < 4; ++d0) Ow[(long)orow * LDR + d0 * 32 + r32] = (bf16_t)f2bf(o[d0][r] * rn * gq[d0]);
    }
  }
  __syncthreads();
#undef SLOAD
#undef SWRITE
#undef SWAIT
#undef RESC
}
#undef KSWZ
#undef SBAR
}

struct Args { const float* in[27]; float* out; unsigned char* ws; int ph_lo, ph_hi; };
enum { I_X = 0, I_C, I_CTX, I_CCTX, I_WMOD, I_BMOD, I_LNG, I_LNB, I_AWIN, I_AWOUT, I_ALAM, I_ASUBG, I_SWIN, I_SBIN, I_SNG, I_SNB, I_SWS, I_SBS, I_SWOUT,
       I_RW, I_RB, I_EWG, I_EWU, I_EWD, I_SHG, I_SHU, I_SHD };
constexpr int N_PHASES = 25;

__device__ __forceinline__ f32x4 ld_bf4(const bf16_t* p) { const u32x2 w = *(const u32x2*)p; return (f32x4){bf2f(w.x & 0xffffu), bf2f(w.x >> 16), bf2f(w.y & 0xffffu), bf2f(w.y >> 16)}; }

template <bool MOE>
__device__ __forceinline__ void ln_rows(const float* xin, const bf16_t* Yb, float* xout, bf16_t* hb, const float* lng, const float* lnb,
                                        const float* modl, int g_off, const float* modh, int sc_off, int gw, int NGW, int lane) {
    for (int row = gw; row < T; row += NGW) {
        const int b = row / SEQ; const float* mb = modl + b * 6144;
        f32x4 v[4]; float s = 0.f;
#pragma unroll
        for (int j = 0; j < 4; ++j) {
            const int c = j * 256 + lane * 4;
            f32x4 yv;
            if (!MOE) yv = ld_bf4(Yb + (size_t)row * D + c);
            else { yv = ld_bf4(Yb + ((size_t)TK + row) * D + c);
#pragma unroll
                for (int k = 0; k < TOPK; ++k) yv += ld_bf4(Yb + ((size_t)row * TOPK + k) * D + c); }
            const f32x4 xv = *(const f32x4*)(xin + (size_t)row * D + c), gv = *(const f32x4*)(mb + g_off + c);
            v[j] = xv * ALPHA + gv * yv; s += (v[j].x + v[j].y) + (v[j].z + v[j].w);
        }
        const float mean = wave_sum(s) * (1.f / D); float s2 = 0.f;
#pragma unroll
        for (int j = 0; j < 4; ++j) { v[j] = v[j] - mean; s2 += (v[j].x * v[j].x + v[j].y * v[j].y) + (v[j].z * v[j].z + v[j].w * v[j].w); }
        const float rstd = 1.f / sqrtf(wave_sum(s2) * (1.f / D) + LN_EPS);
#pragma unroll
        for (int j = 0; j < 4; ++j) {
            const int c = j * 256 + lane * 4;
            const f32x4 o = v[j] * rstd * *(const f32x4*)(lng + c) + *(const f32x4*)(lnb + c);
            *(f32x4*)(xout + (size_t)row * D + c) = o;
            if (modh) {
                const float* mh = modh + b * 6144;
                const f32x4 h = o * (*(const f32x4*)(mh + sc_off + c) + 1.f) + *(const f32x4*)(mh + sc_off - 1024 + c);
                *(u32x2*)(hb + (size_t)row * D + c) = (u32x2){pk2(h.x, h.y), pk2(h.z, h.w)};
            }
        }
    }
}

__device__ __forceinline__ void expert_prefix(const unsigned* cnt, LAS int* ps, LAS int* xps, int x, int tid) {
    if (tid < 64) {
        int v[4], s = 0;
#pragma unroll
        for (int i = 0; i < 4; ++i) { const int c = (int)cnt[tid * 4 + i]; v[i] = (c + PADM - 1) / PADM * PADM; s += v[i]; }
        int inc = s;
#pragma unroll
        for (int o = 1; o < 64; o <<= 1) { const int t = __shfl_up(inc, o); if (tid >= o) inc += t; }
        int ex = inc - s;
#pragma unroll
        for (int i = 0; i < 4; ++i) { ps[tid * 4 + i] = ex; ex += v[i]; }
        if (tid == 63) ps[256] = ex;
        int tl = 0; if (tid < 32) tl = ((int)cnt[x + 8 * tid] + PADM - 1) / PADM;
        int inc2 = tl;
#pragma unroll
        for (int o = 1; o < 32; o <<= 1) { const int t = __shfl_up(inc2, o); if (tid >= o) inc2 += t; }
        if (tid < 32) { xps[tid] = inc2 - tl; if (tid == 31) xps[32] = inc2; }
    }
    __syncthreads();
}

__device__ __forceinline__ void cvt_item(const float* __restrict__ W, int ldn, int K, int k0, int n0, bf16_t* __restrict__ Bt, int drow0, LAS unsigned char* wl, int lane) {
    const int n4 = (lane & 31) * 4, kh = lane >> 5;
    const float* src = W + (size_t)(k0 + kh * 32) * ldn + n0 + n4;
#pragma unroll
    for (int b = 0; b < 4; ++b) {
        f32x4 v[8];
#pragma unroll
        for (int i = 0; i < 8; ++i) v[i] = *(const f32x4*)(src + (size_t)(b * 8 + i) * ldn);
        const int kc = kh * 4 + b;
#pragma unroll
        for (int c = 0; c < 4; ++c) {
            const int n = n4 + c;
            const u32x4 w = {pk2(v[0][c], v[1][c]), pk2(v[2][c], v[3][c]), pk2(v[4][c], v[5][c]), pk2(v[6][c], v[7][c])};
            *(LAS u32x4*)(wl + n * 128 + ((kc ^ (n & 7)) << 4)) = w;
        }
    }
    asm volatile("s_waitcnt lgkmcnt(0)" ::: "memory");
    const int cch = lane & 7;
#pragma unroll
    for (int j = 0; j < 16; ++j) {
        const int n = (lane >> 3) + 8 * j;
        const u32x4 w = *(const LAS u32x4*)(wl + n * 128 + ((cch ^ (n & 7)) << 4));
        *(u32x4*)(Bt + (size_t)(drow0 + n) * K + k0 + cch * 8) = w;
    }
    asm volatile("s_waitcnt lgkmcnt(0)" ::: "memory");
}

struct Ctx { const Args* a; unsigned char* lds; XcdBarrier bar; int G, bid, NGW; long NGT; };
#ifndef PHMASK
#define PHMASK 0xFFFFFFFFu
#endif
#define IN(k) (((PHMASK >> (k)) & 1u) && lo <= (k) && (k) < hi)
#define SEAM(k) do { if (!MK_PER_PHASE_LAUNCH && IN((k) + 1)) xcd_barrier(bar); else __syncthreads(); } while (0)
#define CTX_LOCALS \
    const Args& args = *C.a; unsigned char* lds = C.lds; const XcdBarrier bar = C.bar; const int G = C.G, bid = C.bid, NGW = C.NGW; \
    const long NGT = C.NGT; unsigned char* ws = args.ws; unsigned* ctl = (unsigned*)(ws + WS_CTL); float* smf = (float*)lds; const int lo = args.ph_lo, hi = args.ph_hi; \
    LAS unsigned char* ldsl = (LAS unsigned char*)lds; \
    (void)NGW; (void)NGT; (void)ctl; (void)smf; (void)bid; (void)G; (void)ldsl;
#define PH_LOCALS \
    int tid = threadIdx.x; asm volatile("" : "+v"(tid)); const int lane = tid & 63, wave = __builtin_amdgcn_readfirstlane(tid >> 6); const int gw = bid * NWAVES + wave; const long gt = (long)bid * NTHR + tid; \
    (void)lane; (void)wave; (void)gw; (void)gt;
#define WS_PTRS \
    float* modv = (float*)(ws + WS_MODV); float* ROPE = (float*)(ws + WS_ROPE); \
    bf16_t* HALL = (bf16_t*)(ws + WS_HALL); bf16_t* Qb = (bf16_t*)(ws + WS_Q); bf16_t* Kb = (bf16_t*)(ws + WS_K); bf16_t* Vb = (bf16_t*)(ws + WS_V); \
    float* OATT = (float*)(ws + WS_OATT); bf16_t* ATT = (bf16_t*)(ws + WS_ATT); \
    bf16_t* Y = (bf16_t*)(ws + WS_Y); float* X1 = (float*)(ws + WS_X1); float* X2 = args.out; \
    bf16_t* HM = (bf16_t*)(ws + WS_HM); bf16_t* H1 = (bf16_t*)(ws + WS_H1); \
    float* LOG = (float*)(ws + WS_LOG); bf16_t* HO = (bf16_t*)(ws + WS_HO); bf16_t* HS = (bf16_t*)(ws + WS_HS); \
    int* IDX = (int*)(ws + WS_IDX); float* WGT = (float*)(ws + WS_WGT); int* POS = (int*)(ws + WS_POS); \
    int* SPAIR = (int*)(ws + WS_SPAIR); float* SW = (float*)(ws + WS_SW); \
    bf16_t* Ub = (bf16_t*)(ws + WS_U); bf16_t* VB = (bf16_t*)(ws + WS_VB); float* VN = (float*)(ws + WS_VN); bf16_t* GSP = (bf16_t*)(ws + WS_GSP); \
    bf16_t* WIN_T = (bf16_t*)(ws + WS_WIN_T); bf16_t* WOUT_T = (bf16_t*)(ws + WS_WOUT_T); bf16_t* SWIN_T = (bf16_t*)(ws + WS_SWIN_T); bf16_t* SWOUT_T = (bf16_t*)(ws + WS_SWOUT_T); \
    bf16_t* SHUP_T = (bf16_t*)(ws + WS_SHUP_T); bf16_t* SHDN_T = (bf16_t*)(ws + WS_SHDN_T); bf16_t* EUP_T = (bf16_t*)(ws + WS_EUP_T); bf16_t* EDN_T = (bf16_t*)(ws + WS_EDN_T); \
    (void)modv; (void)ROPE; (void)HALL; (void)Qb; (void)Kb; (void)Vb; (void)OATT; (void)ATT; (void)Y; (void)X1; (void)X2; (void)HM; (void)H1; (void)LOG; (void)HO; (void)HS; (void)IDX; (void)WGT; (void)POS; \
    (void)SPAIR; (void)SW; (void)Ub; (void)VB; (void)VN; (void)GSP; (void)WIN_T; (void)WOUT_T; (void)SWIN_T; (void)SWOUT_T; (void)SHUP_T; (void)SHDN_T; (void)EUP_T; (void)EDN_T;

__device__ __forceinline__ void phases_front(const Ctx& C) {
    CTX_LOCALS
    WS_PTRS
    if (IN(0)) { PH_LOCALS
        float* sc = smf;
        float* red = smf + 5 * 1024;
        for (int i = tid; i < 5 * 1024; i += NTHR) { const int r = i >> 10, k = i & 1023; const float c = r < 4 ? args.in[I_C][r * D + k] : args.in[I_CCTX][k]; sc[i] = siluf(c); }
        __syncthreads();
        for (int it = bid; it < 2 * 96; it += G) {
            const int l = it / 96, j = (it % 96) * 64 + lane;
            const float* w = args.in[I_WMOD] + (size_t)l * D * 6144 + j;
            float a0 = 0, a1 = 0, a2 = 0, a3 = 0, a4 = 0;
            for (int k = wave * 128; k < wave * 128 + 128; ++k) { const float wv = w[(size_t)k * 6144]; a0 += sc[k] * wv; a1 += sc[1024 + k] * wv; a2 += sc[2048 + k] * wv; a3 += sc[3072 + k] * wv; a4 += sc[4096 + k] * wv; }
            red[(wave * 5 + 0) * 64 + lane] = a0; red[(wave * 5 + 1) * 64 + lane] = a1; red[(wave * 5 + 2) * 64 + lane] = a2; red[(wave * 5 + 3) * 64 + lane] = a3; red[(wave * 5 + 4) * 64 + lane] = a4;
            __syncthreads();
            if (tid < 320) { const int r = tid >> 6, jj = tid & 63; float s = 0.f;
#pragma unroll
                for (int w8 = 0; w8 < 8; ++w8) s += red[(w8 * 5 + r) * 64 + jj];
                const int col = (it % 96) * 64 + jj;
                modv[((size_t)l * 5 + r) * 6144 + col] = s + args.in[I_BMOD][l * 6144 + col]; }
            __syncthreads();
        }
        if (gt < 128 * 16) { const int pos = (int)gt >> 4, jj = (int)gt & 15; const float ang = (float)pos * __powf(10000.f, -(float)jj / 16.f); ROPE[gt * 2] = __cosf(ang); ROPE[gt * 2 + 1] = __sinf(ang); }
#if FAST_DENSE || FAST_MOE
        {
            LAS unsigned char* wl = ldsl + wave * 16384;
            constexpr int NI_WIN = 16 * 24, NI_WOUT = 16 * 8, NI_SWIN = 16 * 32, NI_SWOUT = 32 * 8, NI_SH = 2 * 96, NI_DENSE = NI_WIN + NI_WOUT + NI_SWIN + NI_SWOUT + NI_SH;
            constexpr int NI_EXP = 2 * NE * 96;
            for (int it = gw; it < NI_DENSE + NI_EXP; it += NGW) {
                int r = it;
                if (r < NI_WIN) { cvt_item(args.in[I_AWIN], 3 * D, D, (r / 24) * 64, (r % 24) * 128, WIN_T, (r % 24) * 128, wl, lane); continue; } r -= NI_WIN;
                if (r < NI_WOUT) { cvt_item(args.in[I_AWOUT], D, D, (r / 8) * 64, (r % 8) * 128, WOUT_T, (r % 8) * 128, wl, lane); continue; } r -= NI_WOUT;
                if (r < NI_SWIN) { cvt_item(args.in[I_SWIN], 2 * SGU_DFF, D, (r / 32) * 64, (r % 32) * 128, SWIN_T, (r % 32) * 128, wl, lane); continue; } r -= NI_SWIN;
                if (r < NI_SWOUT) { cvt_item(args.in[I_SWOUT], D, SGU_DFF, (r / 8) * 64, (r % 8) * 128, SWOUT_T, (r % 8) * 128, wl, lane); continue; } r -= NI_SWOUT;
                const float *wg, *wu, *wd; bf16_t *up_t, *dn_t;
                if (r < NI_SH) { const int l = r / 96; r %= 96; wg = args.in[I_SHG] + (size_t)l * D * EDFF; wu = args.in[I_SHU] + (size_t)l * D * EDFF; wd = args.in[I_SHD] + (size_t)l * EDFF * D;
                    up_t = SHUP_T + (size_t)l * 512 * D; dn_t = SHDN_T + (size_t)l * D * EDFF; }
                else { r -= NI_SH; const int le = r / 96; r %= 96; wg = args.in[I_EWG] + (size_t)le * D * EDFF; wu = args.in[I_EWU] + (size_t)le * D * EDFF; wd = args.in[I_EWD] + (size_t)le * EDFF * D;
                    up_t = EUP_T + (size_t)le * 512 * D; dn_t = EDN_T + (size_t)le * D * EDFF; }
                const int mat = r / 32, sub = r % 32;
                if (mat < 2) cvt_item(mat == 0 ? wg : wu, EDFF, D, (sub / 2) * 64, (sub % 2) * 128, up_t, (sub % 2) * 256 + mat * 128, wl, lane);
                else cvt_item(wd, D, EDFF, (sub / 8) * 64, (sub % 8) * 128, dn_t, (sub % 8) * 128, wl, lane);
            }
        }
#endif
        SEAM(0);
    }
    if (IN(1)) { PH_LOCALS
        for (long i = gt; i < (long)TA * (D / 4); i += NGT) {
            const int row = (int)(i >> 8), c = (int)(i & 255) * 4, b = row / SEQA, n = row % SEQA;
            const float* src = n < SEQ ? args.in[I_X] + ((size_t)b * SEQ + n) * D + c : args.in[I_CTX] + ((size_t)b * CTX + (n - SEQ)) * D + c;
            const float* mb = modv + (n < SEQ ? b : 4) * 6144;
            const f32x4 h = *(const f32x4*)src * (*(const f32x4*)(mb + 1024 + c) + 1.f) + *(const f32x4*)(mb + c);
            *(u32x2*)(HALL + (size_t)row * D + c) = (u32x2){pk2(h.x, h.y), pk2(h.z, h.w)};
        }
        SEAM(1);
    }
#if FAST_DENSE
    if (IN(2)) { PH_LOCALS
        pg8::DenseSched S; S.init(HALL, WIN_T, TA, 3 * D, D, G, bid);
        const pg8::EpiQKV E{Qb, (WS_K - WS_Q) / 2, ROPE, 1.f};
        pg8::gemm_phase<pg8::EpiQKV, pg8::DenseSched, true>(ldsl, D, S, E);
        SEAM(2);
    }
    if (IN(3)) { SEAM(3); }
#else
    if (IN(2)) { PH_LOCALS
        const LoadBf16 la{HALL, D, nullptr};
        for (int it = bid; it < (TA / 128) * 24; it += G) {
            const int mt = it / 24, nt = it % 24;
            auto epi = [=](int r, int c, f32x4 va, f32x4 vb) { bf16_t* dst = Qb + (size_t)(c >> 10) * ((WS_K - WS_Q) / 2) + (size_t)r * D + (c & 1023);
                *(u32x4*)dst = (u32x4){pk2(va.x, va.y), pk2(va.z, va.w), pk2(vb.x, vb.y), pk2(vb.z, vb.w)}; };
            gemm_tile(la, args.in[I_AWIN], 3 * D, D, mt * 128, nt * 128, smf, epi);
        }
        SEAM(2);
    }
    if (IN(3)) { PH_LOCALS
        for (long i = gt; i < (long)T * 1024; i += NGT) {
            const int j = (int)(i & 15), ch = (int)(i >> 4) & 1, hm = (int)(i >> 5) & 15, wh = (int)(i >> 9) & 1; const long tok = i >> 10;
            const int b = (int)(tok / SEQ), n = (int)(tok % SEQ);
            const int pos = ch == 0 ? n / 64 : n % 64;
            const float cs = ROPE[(pos * 16 + j) * 2], sn = ROPE[(pos * 16 + j) * 2 + 1];
            bf16_t* p = (wh ? Kb : Qb) + ((size_t)b * SEQA + n) * D + hm * 64 + ch * 32 + j;
            const float x1 = bf2f(p[0]), x2 = bf2f(p[16]);
            p[0] = (bf16_t)f2bf(x1 * cs - x2 * sn); p[16] = (bf16_t)f2bf(x2 * cs + x1 * sn);
        }
        SEAM(3);
    }
#endif
    if (IN(4)) { PH_LOCALS
        const float* lp = args.in[I_ALAM];
        const float l1 = wave_sum(lp[lane] * lp[64 + lane]), l2 = wave_sum(lp[128 + lane] * lp[192 + lane]);
        const float lam = __expf(l1) - __expf(l2) + LAM_INIT;
        const int x = bid & 7, r = bid >> 3, W = G >> 3;
        for (int i = 0; ; ++i) {
            const int idx = i * W + r; if (idx >= 4 * (SEQ / att::UNIT_ROWS)) break;
            const int pair = x * 4 + idx / (SEQ / att::UNIT_ROWS), qb = idx % (SEQ / att::UNIT_ROWS), b = pair >> 3, h = pair & 7;
            const size_t kv0 = (size_t)b * SEQA * D + h * 128;
            att::attn_unit(Qb + kv0 + (size_t)qb * att::UNIT_ROWS * D, Kb + kv0, Vb + kv0, ATT + ((size_t)b * SEQ + (size_t)qb * att::UNIT_ROWS) * D + h * 128,
                           lam, args.in[I_ASUBG], SEQA, (char*)lds);
        }
        SEAM(4);
    }
    if (IN(5)) { SEAM(5); }
    if (IN(6)) { PH_LOCALS
#if FAST_DENSE
        pg8::DenseSched S; S.init(ATT, WOUT_T, T, D, D, G, bid);
        const pg8::EpiBf16<0> E{Y, D, nullptr, 0, 0};
        pg8::gemm_phase<pg8::EpiBf16<0>, pg8::DenseSched, true>(ldsl, D, S, E);
#else
        const LoadBf16 la{ATT, D, nullptr};
        for (int it = bid; it < (T / 128) * 8; it += G) {
            const int mt = it / 8, nt = it % 8;
            auto epi = [=](int r, int c, f32x4 va, f32x4 vb) { *(u32x4*)(Y + (size_t)r * D + c) = (u32x4){pk2(va.x, va.y), pk2(va.z, va.w), pk2(vb.x, vb.y), pk2(vb.z, vb.w)}; };
            gemm_tile(la, args.in[I_AWOUT], D, D, mt * 128, nt * 128, smf, epi);
        }
#endif
        SEAM(6);
    }
}
template <int L> __device__ __forceinline__ void layer_tail(const Ctx& C) {
    CTX_LOCALS
    WS_PTRS
    const float* xin = (L == 0) ? args.in[I_X] : X2;
    const float* modl = modv + (size_t)L * 5 * 6144;
    unsigned* cnt = ctl + CW_CNT + L * 256;
    LAS int* ps = (LAS int*)(ldsl + LDS_PS); LAS int* xps = ps + 264;
    const int xcd = bid & 7, xr = bid >> 3, XW = G >> 3;
    if (L == 1) {
        if (IN(14)) { PH_LOCALS
#if FAST_DENSE
            pg8::DenseSched S; S.init(H1, SWIN_T, T, 2 * SGU_DFF, D, G, bid);
            const pg8::EpiBf16<1> E{Ub, SGU_DFF, args.in[I_SBIN], SGU_DFF, (WS_VB - WS_U) / 2};
            pg8::gemm_phase<pg8::EpiBf16<1>, pg8::DenseSched, true>(ldsl, D, S, E);
#else
            const LoadBf16 la{H1, D, nullptr};
            for (int it = bid; it < (T / 128) * 32; it += G) {
                const int mt = it / 32, nt = it % 32;
                auto epi = [=](int r, int c, f32x4 va, f32x4 vb) { const float v[8] = {va.x, va.y, va.z, va.w, vb.x, vb.y, vb.z, vb.w};
                    float z[8];
#pragma unroll
                    for (int j = 0; j < 8; ++j) z[j] = gelu_erf(v[j] + args.in[I_SBIN][c + j]);
                    bf16_t* dst = (c < SGU_DFF) ? Ub + (size_t)r * SGU_DFF + c : VB + (size_t)r * SGU_DFF + (c - SGU_DFF);
                    *(u32x4*)dst = (u32x4){pk2(z[0], z[1]), pk2(z[2], z[3]), pk2(z[4], z[5]), pk2(z[6], z[7])}; };
                gemm_tile(la, args.in[I_SWIN], 2 * SGU_DFF, D, mt * 128, nt * 128, smf, epi);
            }
#endif
            SEAM(14);
        }
        if (IN(15)) { PH_LOCALS
            for (int row = gw; row < T; row += NGW) {
                f32x4 v[8]; float s = 0.f;
#pragma unroll
                for (int j = 0; j < 8; ++j) { v[j] = ld_bf4(VB + (size_t)row * SGU_DFF + j * 256 + lane * 4); s += (v[j].x + v[j].y) + (v[j].z + v[j].w); }
                const float mean = wave_sum(s) * (1.f / SGU_DFF); float s2 = 0.f;
#pragma unroll
                for (int j = 0; j < 8; ++j) { v[j] = v[j] - mean; s2 += (v[j].x * v[j].x + v[j].y * v[j].y) + (v[j].z * v[j].z + v[j].w * v[j].w); }
                const float rstd = 1.f / sqrtf(wave_sum(s2) * (1.f / SGU_DFF) + LN_EPS);
#pragma unroll
                for (int j = 0; j < 8; ++j) { const int c = j * 256 + lane * 4;
                    *(f32x4*)(VN + (size_t)row * SGU_DFF + c) = v[j] * rstd * *(const f32x4*)(args.in[I_SNG] + c) + *(const f32x4*)(args.in[I_SNB] + c); }
            }
            SEAM(15);
        }
        if (IN(16)) { PH_LOCALS
            for (int it = bid; it < (T / SGU_CH) * SGU_G * 2; it += G) {
                const int nt = it & 1, g = (it >> 1) & 7, chunk = it >> 4;
                const LoadF32 la{args.in[I_SWS] + (size_t)g * SGU_CH * SGU_CH, SGU_CH};
                const float* Wv = VN + (size_t)chunk * SGU_CH * SGU_DFF + g * SGU_GC;
                auto epi = [=](int p, int c, f32x4 va, f32x4 vb) { const float v[8] = {va.x, va.y, va.z, va.w, vb.x, vb.y, vb.z, vb.w};
                    const size_t off = (size_t)(chunk * SGU_CH + p) * SGU_DFF + g * SGU_GC + c; const float bs = args.in[I_SBS][g * SGU_CH + p];
                    const u32x4 uw = *(const u32x4*)(Ub + off);
                    const float u0 = bf2f(uw.x & 0xffffu), u1 = bf2f(uw.x >> 16), u2 = bf2f(uw.y & 0xffffu), u3 = bf2f(uw.y >> 16), u4 = bf2f(uw.z & 0xffffu), u5 = bf2f(uw.z >> 16), u6 = bf2f(uw.w & 0xffffu), u7 = bf2f(uw.w >> 16);
                    *(u32x4*)(GSP + off) = (u32x4){pk2(u0 * (v[0] + bs), u1 * (v[1] + bs)), pk2(u2 * (v[2] + bs), u3 * (v[3] + bs)), pk2(u4 * (v[4] + bs), u5 * (v[5] + bs)), pk2(u6 * (v[6] + bs), u7 * (v[7] + bs))}; };
                gemm_tile(la, Wv, SGU_DFF, SGU_CH, 0, nt * 128, smf, epi);
            }
            SEAM(16);
        }
        if (IN(17)) { PH_LOCALS
#if FAST_DENSE
            pg8::DenseSched S; S.init(GSP, SWOUT_T, T, D, SGU_DFF, G, bid);
            const pg8::EpiBf16<0> E{Y, D, nullptr, 0, 0};
            pg8::gemm_phase<pg8::EpiBf16<0>, pg8::DenseSched, true>(ldsl, SGU_DFF, S, E);
#else
            const LoadBf16 la{GSP, SGU_DFF, nullptr};
            for (int it = bid; it < (T / 128) * 8; it += G) {
                const int mt = it / 8, nt = it % 8;
                auto epi = [=](int r, int c, f32x4 va, f32x4 vb) { *(u32x4*)(Y + (size_t)r * D + c) = (u32x4){pk2(va.x, va.y), pk2(va.z, va.w), pk2(vb.x, vb.y), pk2(vb.z, vb.w)}; };
                gemm_tile(la, args.in[I_SWOUT], D, SGU_DFF, mt * 128, nt * 128, smf, epi);
            }
#endif
            SEAM(17);
        }
    }
    constexpr int P_LN = (L == 0) ? 7 : 18;
    if (IN(P_LN)) { PH_LOCALS
        ln_rows<false>(xin, Y, X1, HM, args.in[I_LNG] + (L * 2 + 0) * D, args.in[I_LNB] + (L * 2 + 0) * D, modl, 2048, modl, 4096, gw, NGW, lane);
        SEAM(P_LN);
    }
    if (IN(P_LN + 1)) { PH_LOCALS
        auto la = [=](int r, int k) -> f32x4 { const float* mb = modl + (r / SEQ) * 6144;
            return *(const f32x4*)(X1 + (size_t)r * D + k) * (*(const f32x4*)(mb + 4096 + k) + 1.f) + *(const f32x4*)(mb + 3072 + k); };
        for (int it = bid; it < (T / 128) * 2; it += G) {
            const int mt = it / 2, nt = it % 2;
            auto epi = [=](int r, int c, f32x4 va, f32x4 vb) { float* dst = LOG + (size_t)r * NE + c; *(f32x4*)dst = va; *(f32x4*)(dst + 4) = vb; };
            gemm_tile(la, args.in[I_RW] + (size_t)L * D * NE, NE, D, mt * 128, nt * 128, smf, epi);
        }
        SEAM(P_LN + 1);
    }
    if (IN(P_LN + 2)) { PH_LOCALS
        const float* rb = args.in[I_RB] + L * NE;
        const f32x4 bias = *(const f32x4*)(rb + lane * 4);
        for (int t = gw; t < T; t += NGW) {
            const f32x4 lg = *(const f32x4*)(LOG + (size_t)t * NE + lane * 4);
            float sc[4], ch[4];
#pragma unroll
            for (int i = 0; i < 4; ++i) { sc[i] = sigmoidf_(lg[i]); ch[i] = sc[i] + bias[i]; }
            float m1 = fmaxf(ch[0], ch[1]), m2 = fminf(ch[0], ch[1]);
#pragma unroll
            for (int i = 2; i < 4; ++i) { const float v = ch[i]; m2 = fmaxf(m2, fminf(m1, v)); m1 = fmaxf(m1, v); }
#pragma unroll
            for (int o = 1; o < 8; o <<= 1) { const float b1 = __shfl_xor(m1, o), b2 = __shfl_xor(m2, o); const float n1 = fmaxf(m1, b1), n2 = fmaxf(fminf(m1, b1), fmaxf(m2, b2)); m1 = n1; m2 = n2; }
            const float gs = m1 + m2; const int g = lane >> 3; int rank = 0;
#pragma unroll
            for (int gg = 0; gg < 8; ++gg) { const float o = __shfl(gs, gg * 8); rank += (o > gs || (o == gs && gg < g)) ? 1 : 0; }
            const bool sel = rank < 4;
            float cm[4];
#pragma unroll
            for (int i = 0; i < 4; ++i) cm[i] = sel ? ch[i] : -INFINITY;
            float wsum = 0.f, myw = 0.f; int myidx = 0;
#pragma unroll
            for (int k = 0; k < TOPK; ++k) {
                float bv = cm[0]; int bi = lane * 4;
#pragma unroll
                for (int i = 1; i < 4; ++i) if (cm[i] > bv) { bv = cm[i]; bi = lane * 4 + i; }
#pragma unroll
                for (int o = 1; o < 64; o <<= 1) { const float ov = __shfl_xor(bv, o); const int oi = __shfl_xor(bi, o); if (ov > bv || (ov == bv && oi < bi)) { bv = ov; bi = oi; } }
                const int sub = bi & 3; const float mysc = sub == 0 ? sc[0] : sub == 1 ? sc[1] : sub == 2 ? sc[2] : sc[3];
                const float wv = __shfl(mysc, bi >> 2);
                if ((bi >> 2) == lane) { if (sub == 0) cm[0] = -INFINITY; else if (sub == 1) cm[1] = -INFINITY; else if (sub == 2) cm[2] = -INFINITY; else cm[3] = -INFINITY; }
                wsum += wv; if (lane == k) { myw = wv; myidx = bi; }
            }
            if (lane < TOPK) {
                IDX[t * TOPK + lane] = myidx; WGT[t * TOPK + lane] = myw / wsum * ROUTED_SCALE;
                POS[t * TOPK + lane] = (int)atomicAdd(cnt + myidx, 1u);
            }
        }
        SEAM(P_LN + 2);
    }
    if (IN(P_LN + 3)) { PH_LOCALS
        expert_prefix(cnt, ps, xps, xcd, tid);
        for (long p = gt; p < TK; p += NGT) { const int e = IDX[p]; const int slot = ps[e] + POS[p]; SPAIR[slot] = (int)p; SW[slot] = WGT[p]; }
        for (int e = bid; e < NE; e += G) { const int c = (int)cnt[e], pe = ps[e + 1] - ps[e]; for (int s = c + tid; s < pe; s += NTHR) { SPAIR[ps[e] + s] = -1; SW[ps[e] + s] = 0.f; } }
        for (long t = gt; t < T; t += NGT) { SPAIR[PMAX + t] = TK + (int)t; SW[PMAX + t] = 1.f; }
        SEAM(P_LN + 3);
    }
    auto naive_up = [=](int row0, int e, int pn) {
        const float* wg = e < NE ? args.in[I_EWG] + ((size_t)L * NE + e) * D * EDFF : args.in[I_SHG] + (size_t)L * D * EDFF;
        const float* wu = e < NE ? args.in[I_EWU] + ((size_t)L * NE + e) * D * EDFF : args.in[I_SHU] + (size_t)L * D * EDFF;
        auto la = [=](int r, int k) -> f32x4 { const int p = SPAIR[r]; const int tok = p < 0 ? 0 : (p < TK ? (p >> 3) : (p - TK)); return ld_bf4(HM + (size_t)tok * D + k); };
        for (int half = 0; half < 2; ++half) {
            f32x4 ga[4], gb[4];
            { int ri = 0; auto epi1 = [&](int r, int c, f32x4 va, f32x4 vb) { ga[ri] = va; gb[ri] = vb; ++ri; }; gemm_tile(la, wg, EDFF, D, row0 + half * 128, pn * 128, smf, epi1); }
            { int ri = 0; auto epi2 = [&](int r, int c, f32x4 va, f32x4 vb) { const float w = SW[r]; const f32x4 g0 = ga[ri], g1 = gb[ri]; ++ri;
                *(u32x4*)(HS + (size_t)r * EDFF + c) = (u32x4){pk2(w * siluf(g0.x) * va.x, w * siluf(g0.y) * va.y), pk2(w * siluf(g0.z) * va.z, w * siluf(g0.w) * va.w), pk2(w * siluf(g1.x) * vb.x, w * siluf(g1.y) * vb.y), pk2(w * siluf(g1.z) * vb.z, w * siluf(g1.w) * vb.w)}; };
              gemm_tile(la, wu, EDFF, D, row0 + half * 128, pn * 128, smf, epi2); }
        }
    };
    auto naive_dn = [=](int row0, int e, int pn) {
        const float* wd = e < NE ? args.in[I_EWD] + ((size_t)L * NE + e) * EDFF * D : args.in[I_SHD] + (size_t)L * EDFF * D;
        const LoadBf16 la{HS, EDFF, nullptr};
        auto epi = [=](int r, int c, f32x4 va, f32x4 vb) { const int p = SPAIR[r];
            if (p >= 0) *(u32x4*)(HO + (size_t)p * D + c) = (u32x4){pk2(va.x, va.y), pk2(va.z, va.w), pk2(vb.x, vb.y), pk2(vb.z, vb.w)}; };
        for (int q = 0; q < 4; ++q) gemm_tile(la, wd, D, EDFF, row0 + (q >> 1) * 128, pn * 256 + (q & 1) * 128, smf, epi);
    };
    if (IN(P_LN + 4)) { PH_LOCALS
        expert_prefix(cnt, ps, xps, xcd, tid);
        LAS int* ptab = (LAS int*)(ldsl + LDS_TAB); LAS float* wtab = (LAS float*)(ldsl + LDS_TAB + MAXU_UP * 1024);
        pg8::MoeSched<true, MAXU_UP> S{(const char*)HM, (const char*)(EUP_T + (size_t)L * NE * 512 * D), (const char*)(SHUP_T + (size_t)L * 512 * D), (size_t)512 * D * 2, D, 2, xcd, xr, XW, ps, xps, ptab};
        pg8::Unit u;
#if FAST_MOE
        for (int j = 0; S.next(j, u); ++j) if (tid < 256) { ptab[j * 256 + tid] = SPAIR[u.row0 + tid]; wtab[j * 256 + tid] = SW[u.row0 + tid]; }
        __syncthreads();
        const pg8::EpiMoeUp<MAXU_UP> E{HS, wtab};
        pg8::gemm_phase<pg8::EpiMoeUp<MAXU_UP>, pg8::MoeSched<true, MAXU_UP>, true>(ldsl, D, S, E);
        for (int j = MAXU_UP; S.next_any(j, u); ++j) naive_up(u.row0, u.e, u.pn);
#else
        for (int j = 0; S.next_any(j, u); ++j) naive_up(u.row0, u.e, u.pn);
#endif
        SEAM(P_LN + 4);
    }
    if (IN(P_LN + 5)) { PH_LOCALS
        expert_prefix(cnt, ps, xps, xcd, tid);
        LAS int* ptab = (LAS int*)(ldsl + LDS_TAB);
        pg8::MoeSched<false, MAXU_DN> S{(const char*)HS, (const char*)(EDN_T + (size_t)L * NE * D * EDFF), (const char*)(SHDN_T + (size_t)L * D * EDFF), (size_t)D * EDFF * 2, EDFF, 4, xcd, xr, XW, ps, xps, ptab};
        pg8::Unit u;
#if FAST_MOE
        for (int j = 0; S.next(j, u); ++j) if (tid < 256) ptab[j * 256 + tid] = SPAIR[u.row0 + tid];
        __syncthreads();
        const pg8::EpiMoeDown<MAXU_DN> E{HO, ptab};
        int kdn = EDFF; asm volatile("" : "+s"(kdn));
        pg8::gemm_phase<pg8::EpiMoeDown<MAXU_DN>, pg8::MoeSched<false, MAXU_DN>, true>(ldsl, kdn, S, E);
        for (int j = MAXU_DN; S.next_any(j, u); ++j) naive_dn(u.row0, u.e, u.pn);
#else
        for (int j = 0; S.next_any(j, u); ++j) naive_dn(u.row0, u.e, u.pn);
#endif
        SEAM(P_LN + 5);
    }
    if (IN(P_LN + 6)) { PH_LOCALS
        if (L == 0) ln_rows<true>(X1, HO, X2, H1, args.in[I_LNG] + (L * 2 + 1) * D, args.in[I_LNB] + (L * 2 + 1) * D, modl, 5120, modv + (size_t)5 * 6144, 1024, gw, NGW, lane);
        else ln_rows<true>(X1, HO, args.out, nullptr, args.in[I_LNG] + (L * 2 + 1) * D, args.in[I_LNB] + (L * 2 + 1) * D, modl, 5120, nullptr, 0, gw, NGW, lane);
        SEAM(P_LN + 6);
    }
}

__global__ void __launch_bounds__(NTHR, 2) mega(Args args) {
    extern __shared__ __attribute__((aligned(16))) unsigned char lds[];
    const int tid = threadIdx.x;
    const int G = gridDim.x, bid = blockIdx.x;
    unsigned* ctl = (unsigned*)(args.ws + WS_CTL);
    for (int u = tid; u < 512; u += NTHR) ((unsigned*)(lds + LDS_MISC))[u] = 0u;
    __syncthreads();
    XcdBarrier bar; bar.bar = ctl + CW_BAR; bar.x = 0; bar.st = nullptr;
    if (!MK_PER_PHASE_LAUNCH) bar = xcd_barrier_post(ctl + CW_BAR, (volatile LAS unsigned*)(lds + LDS_MISC) + 8);
    Ctx C; C.a = &args; C.lds = lds; C.bar = bar; C.G = G; C.bid = bid; C.NGW = G * NWAVES; C.NGT = (long)G * NTHR;
    phases_front(C);
    layer_tail<0>(C);
    layer_tail<1>(C);
}

extern "C" void kernel_launch(void* const* d_in, const int* in_sizes, int n_in, void* d_out, int out_size, void* d_ws, size_t ws_size, hipStream_t stream) {
    static int grid = 0;
    if (grid == 0) {
        if (n_in != 27 || out_size != T * D || ws_size < WS_END) { fprintf(stderr, "kernel_launch: unexpected shapes n_in %d out %d ws %zu (need %zu)\n", n_in, out_size, ws_size, (size_t)WS_END); grid = -1; return; }
        int dev = 0, cus = 0, per_cu = 0;
        if (hipGetDevice(&dev) != hipSuccess || hipDeviceGetAttribute(&cus, hipDeviceAttributeMultiprocessorCount, dev) != hipSuccess) { grid = -1; return; }
        if (hipFuncSetAttribute((const void*)mega, hipFuncAttributeMaxDynamicSharedMemorySize, LDS_BYTES) != hipSuccess) { fprintf(stderr, "kernel_launch: hipFuncSetAttribute failed\n"); grid = -1; return; }
        if (hipOccupancyMaxActiveBlocksPerMultiprocessor(&per_cu, (const void*)mega, NTHR, LDS_BYTES) != hipSuccess || per_cu < 1) fprintf(stderr, "kernel_launch: occupancy query reports %d\n", per_cu);
        (void)hipGetLastError();
        grid = cus;
    }
    if (grid < 0) return;
    if (hipMemsetAsync((char*)d_ws + WS_CTL, 0, CTL_ZERO_BYTES, stream) != hipSuccess) return;
    Args a{};
    for (int i = 0; i < 27; ++i) a.in[i] = (const float*)d_in[i];
    a.out = (float*)d_out; a.ws = (unsigned char*)d_ws;
#if MK_PER_PHASE_LAUNCH
    for (int p = 0; p < N_PHASES; ++p) { a.ph_lo = p; a.ph_hi = p + 1; hipLaunchKernelGGL(mega, dim3(grid), dim3(NTHR), LDS_BYTES, stream, a); }
#else
    a.ph_lo = 0; a.ph_hi = N_PHASES;
    hipLaunchKernelGGL(mega, dim3(grid), dim3(NTHR), LDS_BYTES, stream, a);
#endif
    const hipError_t le = hipPeekAtLastError();
    if (le != hipSuccess) fprintf(stderr, "kernel_launch: launch failed: %s\n", hipGetErrorName(le));
}
```

```cpp
#include <hip/hip_runtime.h>
#include <cstdio>
#include <cstdint>
#include <cstddef>

#ifndef MK_PER_PHASE_LAUNCH
#define MK_PER_PHASE_LAUNCH 0
#endif
#ifndef FAST_DENSE
#define FAST_DENSE 1
#endif
#ifndef FAST_MOE
#define FAST_MOE 1
#endif

#define GAS __attribute__((address_space(1)))
#define LAS __attribute__((address_space(3)))
typedef unsigned short bf16_t;
typedef float f32x4 __attribute__((ext_vector_type(4)));
typedef float f32x2 __attribute__((ext_vector_type(2)));
typedef unsigned u32x4 __attribute__((ext_vector_type(4)));
typedef unsigned u32x2 __attribute__((ext_vector_type(2)));

constexpr int D = 1024, BATCH = 4, SEQ = 8192, CTX = 256, T = BATCH * SEQ, SEQA = SEQ + CTX, TA = BATCH * SEQA;
constexpr int NH = 8, HD = 64, DV = 128;
constexpr int SGU_DFF = 2048, SGU_CH = 128, SGU_G = 8, SGU_GC = 256;
constexpr int NE = 256, TOPK = 8, NGRP = 8, EDFF = 256;
constexpr int TK = T * TOPK;
constexpr int HML = 2048;
constexpr int PADM = 256;
constexpr int PMAX = TK + NE * PADM;
constexpr float LN_EPS = 1e-5f, ALPHA = 1.4142135623730951f, ROUTED_SCALE = 2.5f;
constexpr float LAM_INIT = 0.2f;
constexpr int NWAVES = 8, NTHR = 512;

constexpr size_t MiB = 1u << 20;
constexpr size_t WS_CTL = 0, CTL_ZERO_BYTES = 1 * MiB;
constexpr int CW_BAR = 4096;
constexpr int CW_CNT = 32768;
constexpr size_t WS_MODV = 1 * MiB;
constexpr size_t WS_ROPE = WS_MODV + 512 * 1024;
constexpr size_t WS_IDX = 2 * MiB, WS_WGT = 3 * MiB, WS_POS = 4 * MiB;
constexpr size_t WS_SPAIR = 5 * MiB, WS_SW = 7 * MiB;
constexpr size_t WS_WIN_T = 16 * MiB;
constexpr size_t WS_WOUT_T = 22 * MiB;
constexpr size_t WS_SWIN_T = 24 * MiB;
constexpr size_t WS_SWOUT_T = 32 * MiB;
constexpr size_t WS_SHUP_T = 36 * MiB;
constexpr size_t WS_SHDN_T = 38 * MiB;
constexpr size_t WS_RW_T = 40 * MiB;
constexpr size_t WS_WSB = 46 * MiB;
constexpr size_t WS_VSTAT = 47 * MiB;
constexpr size_t WS_EUP_T = 48 * MiB;
constexpr size_t WS_EDN_T = 560 * MiB;
constexpr size_t WS_R = 816 * MiB;
constexpr size_t WS_HALL = WS_R, WS_Q = WS_R + 66 * MiB, WS_K = WS_R + 132 * MiB, WS_V = WS_R + 198 * MiB, WS_OATT = WS_R + 264 * MiB, WS_ATT = WS_R + 520 * MiB;
constexpr size_t WS_U = WS_R, WS_VB = WS_R + 128 * MiB, WS_GSP = WS_R + 256 * MiB, WS_VN = WS_R + 384 * MiB;
constexpr size_t WS_HO = WS_R;
constexpr size_t WS_Y = WS_R + 640 * MiB;
constexpr size_t WS_X1 = WS_Y + 64 * MiB;
constexpr size_t WS_HM = WS_X1 + 128 * MiB;
constexpr size_t WS_H1 = WS_HM + 128 * MiB;
constexpr size_t WS_LOG = WS_H1 + 64 * MiB;
constexpr size_t WS_HS = WS_LOG + 32 * MiB;
constexpr size_t WS_END = WS_HS + 176 * MiB;
static_assert(WS_END <= (size_t)2048 * MiB, "workspace map exceeds 2 GiB");
static_assert((size_t)(PMAX + T) * EDFF * 2 <= 176 * MiB && (size_t)TA * D * 2 <= 66 * MiB && (size_t)(TK + T + 1) * D * 2 <= 640 * MiB, "ws sizes");
static_assert((size_t)(PMAX + T) * 4 <= 2 * MiB, "slot tables");

constexpr int LDS_BYTES = 163840;
constexpr int LDS_MISC = 131072;
constexpr int LDS_PS = LDS_MISC + 256;
constexpr int LDS_PTRS = LDS_MISC + 1536;
constexpr int LDS_TAB = LDS_MISC + 2048;
constexpr int MAXU_UP = 14, MAXU_DN = 28;
static_assert(LDS_TAB + 28 * 1024 <= LDS_BYTES, "LDS map");

#define XB_TMO      128
#define XB_XCNT(j)  (256  + 64 * (j))
#define XB_XSUB(j)  (1280 + 64 * (j))
#define XB_XGEN(j)  (2304 + 64 * (j))
#define XB_TOP      3328
#define XB_TOPGEN   3392
#define XCD_BAR_WORDS 3456
#define XB_SPIN_CAP (1u << 22)

__device__ __forceinline__ unsigned xb_ld(unsigned* p)              { return __hip_atomic_load(p, __ATOMIC_RELAXED, __HIP_MEMORY_SCOPE_AGENT); }
__device__ __forceinline__ unsigned xb_add(unsigned* p, unsigned v) { return __hip_atomic_fetch_add(p, v, __ATOMIC_RELAXED, __HIP_MEMORY_SCOPE_AGENT); }
__device__ __forceinline__ unsigned xb_xcc_id() { return (unsigned)__builtin_amdgcn_s_getreg((3 << 11) | 20) & 0xFu; }
#define XB_SPIN(cond, bar) do { unsigned _sp = 0; while (cond) { __builtin_amdgcn_s_sleep(1); \
    if ((++_sp & 255u) == 0u) { if (xb_ld(&(bar)[XB_TMO])) break; if (_sp > XB_SPIN_CAP) { atomicAdd(&(bar)[XB_TMO], 1u); break; } } } } while (0)

struct XcdBarrier { unsigned* bar; unsigned x; volatile LAS unsigned* st; };

__device__ __forceinline__ XcdBarrier xcd_barrier_post(unsigned* bar, volatile LAS unsigned* st) {
    XcdBarrier b; b.bar = bar; b.x = xb_xcc_id(); b.st = st;
    if (threadIdx.x == 0) (void)xb_add(&bar[XB_XCNT(b.x)], 1u);
    return b;
}
__device__ __forceinline__ void xcd_barrier_complete(unsigned* bar, unsigned x, unsigned& nloc, unsigned& nx) {
    const unsigned G = gridDim.x * gridDim.y * gridDim.z;
    unsigned sum, cnt, mine, sp = 0u;
    for (;;) {
        sum = 0u; cnt = 0u; mine = 0u;
#pragma unroll
        for (unsigned j = 0; j < 16; ++j) { const unsigned c = xb_ld(&bar[XB_XCNT(j)]); sum += c; cnt += (c > 0u) ? 1u : 0u; mine = (j == x) ? c : mine; }
        if (sum == G) break;
        __builtin_amdgcn_s_sleep(1);
        if ((++sp & 255u) == 0u) { if (xb_ld(&bar[XB_TMO])) break; if (sp > XB_SPIN_CAP) { atomicAdd(&bar[XB_TMO], 1u); break; } }
    }
    nloc = mine > 0u ? mine : 1u; nx = cnt > 0u ? cnt : 1u;
}
__device__ __forceinline__ void xcd_barrier(const XcdBarrier& b) {
    asm volatile("s_waitcnt vmcnt(0)" ::: "memory");
    __syncthreads();
    if (threadIdx.x == 0) {
        unsigned* bar = b.bar;
        __builtin_amdgcn_s_waitcnt(0);
        unsigned nloc = b.st[0], nx = b.st[1];
        if (nloc == 0u) { xcd_barrier_complete(bar, b.x, nloc, nx); b.st[0] = nloc; b.st[1] = nx; }
        const unsigned old = xb_add(&bar[XB_XSUB(b.x)], 1u);
        const unsigned gen = old / nloc;
        if (old + 1u == (gen + 1u) * nloc) {
            __builtin_amdgcn_fence(__ATOMIC_RELEASE, "agent");
            asm volatile("s_waitcnt vmcnt(0)" ::: "memory");
            const unsigned og = xb_add(&bar[XB_TOP], 1u);
            const unsigned tg = og / nx;
            if (og + 1u == (tg + 1u) * nx) xb_add(&bar[XB_TOPGEN], 1u);
            else XB_SPIN(xb_ld(&bar[XB_TOPGEN]) == tg, bar);
            __builtin_amdgcn_fence(__ATOMIC_ACQUIRE, "agent");
            xb_add(&bar[XB_XGEN(b.x)], 1u);
            asm volatile("s_waitcnt vmcnt(0)" ::: "memory");
        } else {
            XB_SPIN(xb_ld(&bar[XB_XGEN(b.x)]) == gen, bar);
            __builtin_amdgcn_fence(__ATOMIC_ACQUIRE, "agent");
            asm volatile("s_waitcnt vmcnt(0)" ::: "memory");
        }
    }
    __syncthreads();
}

__device__ __forceinline__ unsigned f2bf(float f) { unsigned u = __builtin_bit_cast(unsigned, f); return (u + 0x7fffu + ((u >> 16) & 1u)) >> 16; }
__device__ __forceinline__ float bf2f(unsigned b) { return __builtin_bit_cast(float, b << 16); }
__device__ __forceinline__ unsigned pk2(float lo, float hi) { return f2bf(lo) | (f2bf(hi) << 16); }
__device__ __forceinline__ float wave_sum(float v) {
#pragma unroll
    for (int o = 1; o < 64; o <<= 1) v += __shfl_xor(v, o);
    return v;
}
__device__ __forceinline__ float siluf(float x) { return x / (1.f + __expf(-x)); }
__device__ __forceinline__ float sigmoidf_(float x) { return 1.f / (1.f + __expf(-x)); }
__device__ __forceinline__ float gelu_erf(float x) { return 0.5f * x * (1.f + erff(x * 0.70710678118654752f)); }

template <class LoadA, class Epi>
__device__ __forceinline__ void gemm_tile(const LoadA& la, const float* __restrict__ W, int ldw, int K, int m0, int n0, float* sm, const Epi& E) {
    const int tid = threadIdx.x, ty = tid >> 4, tx = tid & 15;
    float* As = sm; float* Bs = sm + 16 * 132;
    f32x4 acc[4][2];
#pragma unroll
    for (int i = 0; i < 4; ++i) { acc[i][0] = (f32x4){0.f, 0.f, 0.f, 0.f}; acc[i][1] = (f32x4){0.f, 0.f, 0.f, 0.f}; }
    const int ar = tid >> 2, k4 = (tid & 3) * 4;
    const int bk = tid >> 5, bn = (tid & 31) * 4;
    const float* bp = W + (size_t)bk * ldw + n0 + bn;
    for (int k0 = 0; k0 < K; k0 += 16) {
        const f32x4 a = la(m0 + ar, k0 + k4);
        const f32x4 b = *(const f32x4*)(bp + (size_t)k0 * ldw);
        __syncthreads();
        As[(k4 + 0) * 132 + ar] = a.x; As[(k4 + 1) * 132 + ar] = a.y; As[(k4 + 2) * 132 + ar] = a.z; As[(k4 + 3) * 132 + ar] = a.w;
        *(f32x4*)&Bs[bk * 128 + bn] = b;
        __syncthreads();
#pragma unroll 4
        for (int kk = 0; kk < 16; ++kk) {
            const f32x4 av = *(const f32x4*)&As[kk * 132 + ty * 4];
            const f32x4 b0 = *(const f32x4*)&Bs[kk * 128 + tx * 8], b1 = *(const f32x4*)&Bs[kk * 128 + tx * 8 + 4];
#pragma unroll
            for (int i = 0; i < 4; ++i) { acc[i][0] += b0 * av[i]; acc[i][1] += b1 * av[i]; }
        }
    }
#pragma unroll
    for (int i = 0; i < 4; ++i) E(m0 + ty * 4 + i, n0 + tx * 8, acc[i][0], acc[i][1]);
}
struct LoadBf16 {
    const bf16_t* A; int lda; const int* rowidx;
    __device__ __forceinline__ f32x4 operator()(int r, int k) const {
        const int rr = rowidx ? rowidx[r] : r;
        const u32x2 w = *(const u32x2*)(A + (size_t)rr * lda + k);
        return (f32x4){bf2f(w.x & 0xffffu), bf2f(w.x >> 16), bf2f(w.y & 0xffffu), bf2f(w.y >> 16)};
    }
};
struct LoadF32 {
    const float* A; int lda;
    __device__ __forceinline__ f32x4 operator()(int r, int k) const { return *(const f32x4*)(A + (size_t)r * lda + k); }
};

namespace pg8 {
typedef short bf16x8 __attribute__((ext_vector_type(8)));
constexpr int BM = 256, BK = 64, HALF = 128, HTB = HALF * BK * 2, STAGE_BYTES = 8 * HTB, NXCD = 8, WGM = 8;
__host__ __device__ __forceinline__ int lds_byte(int r, int c) { const int st = (r >> 4) * 2 + (c >> 5), rr = r & 15, cc = c & 31, ob = rr * 64 + cc * 2; return st * 1024 + (ob ^ (((ob >> 9) & 1) << 5)); }
__host__ __device__ __forceinline__ void stage_rc(int b, int& R, int& C) { const int st = b / 1024, sb = b % 1024, swz = sb ^ (((sb >> 9) & 1) << 5); R = (st >> 1) * 16 + swz / 64; C = (st & 1) * 32 + (swz % 64) / 2; }
__host__ __device__ __forceinline__ int perm32(int rho) { const int n = rho >> 4, i = rho & 15; return 8 * (i >> 2) + 4 * n + (i & 3); }

struct Unit { int pm, pn, row0, e, ord; };

__device__ __forceinline__ unsigned cvt_pk_bf16(float lo, float hi) { unsigned r; asm volatile("v_cvt_pk_bf16_f32 %0, %1, %2" : "=v"(r) : "v"(lo), "v"(hi)); return r; }
__device__ __forceinline__ f32x2 gelu_pk(f32x2 v) {
    const f32x2 av = __builtin_elementwise_abs(v), d = av * 0.2316418882f + 1.0f;
    f32x2 t; t.x = __builtin_amdgcn_rcpf(d.x); t.y = __builtin_amdgcn_rcpf(d.y);
    f32x2 q = t * 0.5307027145f + (-0.7265760135f); q = q * t + 0.7107068705f; q = q * t + (-0.142248368f); q = q * t + 0.127414796f; q = q * t;
    const f32x2 s = (v * v) * (-0.72134752044f);
    f32x2 e; e.x = __builtin_amdgcn_exp2f(s.x); e.y = __builtin_amdgcn_exp2f(s.y);
    const f32x2 m = v * (q * e), r = v - m;
    f32x2 o; o.x = v.x < 0.f ? m.x : r.x; o.y = v.y < 0.f ? m.y : r.y; return o;
}
template <int ACT> struct EpiBf16 {
    static constexpr bool PERM = true;
    bf16_t* O; int ldc; const float* bias; int split_cols; size_t split_stride;
    __device__ __forceinline__ void operator()(const f32x4 (&acc)[2][2][4][2], const Unit& u, int wr, int wc, int fr, int fq) const {
        const int row0 = u.pm * BM + wr * 64 + fr; int colt = u.pn * BM; bf16_t* base = O;
        if (split_cols) { const int t = colt / split_cols; base += (size_t)t * split_stride; colt -= t * split_cols; }
        const int col0 = colt + wc * 32 + 8 * fq, bcol0 = u.pn * BM + wc * 32 + 8 * fq;
        f32x4 bv[2][2];
#pragma unroll
        for (int bj = 0; bj < 2; ++bj)
#pragma unroll
            for (int n = 0; n < 2; ++n) bv[bj][n] = bias ? *(const f32x4*)(bias + bcol0 + bj * HALF + 4 * n) : (f32x4){0.f, 0.f, 0.f, 0.f};
#pragma unroll
        for (int ai = 0; ai < 2; ++ai)
#pragma unroll
            for (int m = 0; m < 4; ++m) { bf16_t* rowp = base + (size_t)(row0 + ai * HALF + m * 16) * ldc + col0;
#pragma unroll
                for (int bj = 0; bj < 2; ++bj) { f32x4 v0 = acc[ai][bj][m][0] + bv[bj][0], v1 = acc[ai][bj][m][1] + bv[bj][1];
                    if (ACT == 1) { f32x2 a = gelu_pk((f32x2){v0[0], v0[1]}), b = gelu_pk((f32x2){v0[2], v0[3]}), c = gelu_pk((f32x2){v1[0], v1[1]}), d = gelu_pk((f32x2){v1[2], v1[3]});
                        v0 = (f32x4){a.x, a.y, b.x, b.y}; v1 = (f32x4){c.x, c.y, d.x, d.y}; }
                    u32x4 w; w.x = cvt_pk_bf16(v0[0], v0[1]); w.y = cvt_pk_bf16(v0[2], v0[3]); w.z = cvt_pk_bf16(v1[0], v1[1]); w.w = cvt_pk_bf16(v1[2], v1[3]);
                    *(u32x4*)(rowp + bj * HALF) = w; } }
    }
};
struct EpiF32 {
    static constexpr bool PERM = false;
    float* C; int ldc;
    __device__ __forceinline__ void operator()(const f32x4 (&acc)[2][2][4][2], const Unit& u, int wr, int wc, int fr, int fq) const {
        const int row0 = u.pm * BM + wr * 64 + fr, col0 = u.pn * BM + wc * 32 + 4 * fq;
#pragma unroll
        for (int ai = 0; ai < 2; ++ai)
#pragma unroll
            for (int m = 0; m < 4; ++m) { float* rowp = C + (size_t)(row0 + ai * HALF + m * 16) * ldc + col0;
#pragma unroll
                for (int bj = 0; bj < 2; ++bj)
#pragma unroll
                    for (int n = 0; n < 2; ++n) *(f32x4*)(rowp + bj * HALF + n * 16) = acc[ai][bj][m][n]; }
    }
};
struct EpiQKV {
    static constexpr bool PERM = true;
    bf16_t* Q; size_t stride; const float* rope; float qscale;
    __device__ __forceinline__ void operator()(const f32x4 (&acc)[2][2][4][2], const Unit& u, int wr, int wc, int fr, int fq) const {
        const int row0 = u.pm * BM + wr * 64 + fr, colt = u.pn * BM, t = colt >> 10, cbase = colt & 1023;
        bf16_t* base = Q + (size_t)t * stride;
        const bool do_rope = (t < 2) && ((u.pm % 33) != 32);
        const float sc = (t == 0) ? qscale : 1.f;
        const float sgn = (fq < 2) ? -1.f : 1.f;
        const bool lowhalf = (fq < 2);
#pragma unroll
        for (int ai = 0; ai < 2; ++ai)
#pragma unroll
            for (int m = 0; m < 4; ++m) {
                const int r = row0 + ai * HALF + m * 16, nseq = r % SEQA;
                const int pos = (wc & 1) ? (nseq & 63) : (nseq >> 6);
                f32x4 cs[4];
                if (do_rope) { const f32x4* rp = (const f32x4*)(rope + (pos * 16 + 8 * (fq & 1)) * 2);
#pragma unroll
                    for (int q4 = 0; q4 < 4; ++q4) cs[q4] = rp[q4]; }
                const int bq = r / SEQA, hd0 = cbase >> 7;
                bf16_t* rowp = (t == 0) ? base + (size_t)r * D + cbase + wc * 32 + 8 * fq : base + ((size_t)(bq * NH + hd0) * SEQA + nseq) * 128 + wc * 32 + 8 * fq;
                const size_t bjstep = (t == 0) ? (size_t)HALF : (size_t)SEQA * 128;
#pragma unroll
                for (int bj = 0; bj < 2; ++bj) {
                    float v[8];
#pragma unroll
                    for (int n = 0; n < 2; ++n)
#pragma unroll
                        for (int j = 0; j < 4; ++j) v[n * 4 + j] = acc[ai][bj][m][n][j];
                    if (do_rope) {
#pragma unroll
                        for (int i = 0; i < 8; ++i) {
                            const unsigned xb = __builtin_bit_cast(unsigned, v[i]);
                            auto rr = __builtin_amdgcn_permlane32_swap(xb, xb, false, false);
                            const float partner = __builtin_bit_cast(float, lowhalf ? rr[1] : rr[0]);
                            const float c = cs[i >> 1][(i & 1) * 2], s = cs[i >> 1][(i & 1) * 2 + 1];
                            v[i] = v[i] * c + sgn * partner * s;
                        }
                    }
                    u32x4 w; w.x = cvt_pk_bf16(v[0] * sc, v[1] * sc); w.y = cvt_pk_bf16(v[2] * sc, v[3] * sc); w.z = cvt_pk_bf16(v[4] * sc, v[5] * sc); w.w = cvt_pk_bf16(v[6] * sc, v[7] * sc);
                    *(u32x4*)(rowp + bj * bjstep) = w;
                }
            }
    }
};
template <int MAXU> struct EpiMoeUp {
    static constexpr bool PERM = true;
    bf16_t* HS; const LAS float* wtab;
    __device__ __forceinline__ void operator()(const f32x4 (&acc)[2][2][4][2], const Unit& u, int wr, int wc, int fr, int fq) const {
#pragma unroll
        for (int ai = 0; ai < 2; ++ai)
#pragma unroll
            for (int m = 0; m < 4; ++m) {
                const int rr = ai * HALF + wr * 64 + m * 16 + fr;
                const float w = wtab[u.ord * 256 + rr];
                float h[8];
#pragma unroll
                for (int n = 0; n < 2; ++n)
#pragma unroll
                    for (int j = 0; j < 4; ++j) { const float g = acc[ai][0][m][n][j], up = acc[ai][1][m][n][j]; h[n * 4 + j] = w * up * g * __builtin_amdgcn_rcpf(1.f + __expf(-g)); }
                u32x4 o; o.x = cvt_pk_bf16(h[0], h[1]); o.y = cvt_pk_bf16(h[2], h[3]); o.z = cvt_pk_bf16(h[4], h[5]); o.w = cvt_pk_bf16(h[6], h[7]);
                *(u32x4*)(HS + (size_t)(u.row0 + rr) * EDFF + u.pn * 128 + wc * 32 + 8 * fq) = o;
            }
    }
};
template <int MAXU> struct EpiMoeDown {
    static constexpr bool PERM = true;
    bf16_t* HO; const LAS int* ptab;
    __device__ __forceinline__ void operator()(const f32x4 (&acc)[2][2][4][2], const Unit& u, int wr, int wc, int fr, int fq) const {
#pragma unroll
        for (int ai = 0; ai < 2; ++ai)
#pragma unroll
            for (int m = 0; m < 4; ++m) {
                const int rr = ai * HALF + wr * 64 + m * 16 + fr;
                int p = ptab[u.ord * 256 + rr]; p = p < 0 ? (TK + T) : p;
                bf16_t* rowp = HO + (size_t)p * D + u.pn * BM + wc * 32 + 8 * fq;
#pragma unroll
                for (int bj = 0; bj < 2; ++bj) { const f32x4 v0 = acc[ai][bj][m][0], v1 = acc[ai][bj][m][1];
                    u32x4 o; o.x = cvt_pk_bf16(v0[0], v0[1]); o.y = cvt_pk_bf16(v0[2], v0[3]); o.z = cvt_pk_bf16(v1[0], v1[1]); o.w = cvt_pk_bf16(v1[2], v1[3]);
                    *(u32x4*)(rowp + bj * HALF) = o; }
            }
    }
};

struct DenseSched {
    const char* A; const char* Bt; int K, lda, nM, nN, nwg, G, c;
    __device__ __forceinline__ void init(const void* A_, const void* Bt_, int M, int N, int K_, int G_, int c_, int lda_ = 0) { A = (const char*)A_; Bt = (const char*)Bt_; K = K_; lda = lda_ ? lda_ : K_; nM = M / BM; nN = N / BM; nwg = nM * nN; G = G_; c = c_; }
    __device__ __forceinline__ bool next(int i, Unit& u) const {
        const long L = (long)i * G + c; if (L >= nwg) return false;
        int wgid = (int)L; { const int q = nwg / NXCD, r = nwg % NXCD, xcd = wgid % NXCD, off = wgid / NXCD; wgid = (xcd < r ? xcd * (q + 1) : r * (q + 1) + (xcd - r) * q) + off; }
        const int nig = WGM * nN, gid = wgid / nig, fm = gid * WGM, gsz = (nM - fm) < WGM ? (nM - fm) : WGM;
        u.pm = fm + ((wgid % nig) % gsz); u.pn = (wgid % nig) / gsz; u.row0 = 0; u.e = 0; u.ord = i; return true;
    }
    __device__ __forceinline__ const char* a_base() const { return A; }
    __device__ __forceinline__ unsigned a_off(const Unit& u, int h, int R, int C) const { return (unsigned)(((u.pm * BM + h * HALF + R) * lda + C) * 2); }
    __device__ __forceinline__ const char* b_base(const Unit& u) const { return Bt + (size_t)u.pn * BM * K * 2; }
};
template <bool GATHER, int MAXU> struct MoeSched {
    const char* A; const char* Bexp; const char* Bsh; size_t b_estride; int K, lda, NPN, x, r, W;
    const LAS int* ps; const LAS int* xps; const LAS int* ptab;
    __device__ __forceinline__ bool next_any(int i, Unit& u) const {
        const int uu = i * W + r, nrt = __builtin_amdgcn_readfirstlane(xps[32]), tot = (nrt + 16) * NPN; if (uu >= tot) return false;
        const int rtl = uu / NPN; u.pn = uu % NPN; u.pm = 0; u.ord = i;
        if (rtl < nrt) { int a = 0, b = 32; while (b - a > 1) { const int mid = (a + b) >> 1; if (__builtin_amdgcn_readfirstlane(xps[mid]) <= rtl) a = mid; else b = mid; }
            u.e = x + 8 * a; u.row0 = __builtin_amdgcn_readfirstlane(ps[u.e]) + (rtl - __builtin_amdgcn_readfirstlane(xps[a])) * BM; }
        else { u.e = NE; u.row0 = PMAX + (x * 16 + (rtl - nrt)) * BM; }
        return true;
    }
    __device__ __forceinline__ bool next(int i, Unit& u) const { return i < MAXU && next_any(i, u); }
    __device__ __forceinline__ const char* a_base() const { return A; }
    __device__ __forceinline__ unsigned a_off(const Unit& u, int h, int R, int C) const {
        const int row = h * HALF + R;
        if (GATHER) { const int p = ptab[u.ord * 256 + row]; const int tok = p < 0 ? 0 : (p < TK ? (p >> 3) : (p - TK)); return (unsigned)((tok * lda + C) * 2); }
        else return (unsigned)(((u.row0 + row) * lda + C) * 2);
    }
    __device__ __forceinline__ const char* b_base(const Unit& u) const { return (u.e < NE ? Bexp + (size_t)u.e * b_estride : Bsh) + (size_t)u.pn * BM * K * 2; }
};

template <class Epi, class Sched, bool ALIGN_EPI, int AWRAP = 0>
__device__ __forceinline__ void gemm_phase(LAS unsigned char* lds, const int K, const Sched& S, const Epi& E) {
    const int tid = threadIdx.x, wid = __builtin_amdgcn_readfirstlane(tid >> 6), lane = tid & 63, wr = wid >> 2, wc = wid & 3, fr = lane & 15, fq = lane >> 4;
    const int nt = K / BK;
    int sR[2], sC[2]; unsigned voffB[2];
#pragma unroll
    for (int i = 0; i < 2; ++i) { int R, C; stage_rc(tid * 16 + i * 8192, R, C); sR[i] = R; sC[i] = C; const int Rb = Epi::PERM ? ((R & ~31) + perm32(R & 31)) : R; voffB[i] = (unsigned)(Rb * K + C) * 2u; }
    const size_t kstep = (size_t)(BK * 2);
    const size_t hstep = (size_t)HALF * K * 2;
    const unsigned ldsw = (unsigned)wid * 1024u;
    const int aoff = lds_byte(wr * 64 + fr, fq * 8), boff = lds_byte(wc * 32 + fr, fq * 8);
#define PG8_SA(b, h) (((b) * 2 + (h)) * HTB)
#define PG8_SB(b, h) ((4 + (b) * 2 + (h)) * HTB)
#define PG8_STAGE(bufoff, gbase, voff) do { _Pragma("unroll") for (int _i = 0; _i < 2; ++_i) \
        __builtin_amdgcn_global_load_lds((const unsigned*)((const char*)(gbase) + (voff)[_i]), (LAS unsigned*)(lds + (bufoff) + ldsw + _i * 8192), 16, 0, 0); } while (0)
#define PG8_LDA(dst, b, h) do { _Pragma("unroll") for (int m = 0; m < 4; ++m) _Pragma("unroll") for (int k = 0; k < 2; ++k) dst[m][k] = *(const LAS bf16x8*)(lds + PG8_SA(b, h) + aoff + m * 2048 + k * 1024); } while (0)
#define PG8_LDB(dst, b, h) do { _Pragma("unroll") for (int n = 0; n < 2; ++n) _Pragma("unroll") for (int k = 0; k < 2; ++k) dst[n][k] = *(const LAS bf16x8*)(lds + PG8_SB(b, h) + boff + n * 2048 + k * 1024); } while (0)
#define PG8_MMA(ai, bj, At, Bt) do { __builtin_amdgcn_s_setprio(1); _Pragma("unroll") for (int m = 0; m < 4; ++m) _Pragma("unroll") for (int n = 0; n < 2; ++n) _Pragma("unroll") for (int k = 0; k < 2; ++k) \
        acc[ai][bj][m][n] = __builtin_amdgcn_mfma_f32_16x16x32_bf16(Bt[n][k], At[m][k], acc[ai][bj][m][n], 0, 0, 0); __builtin_amdgcn_s_setprio(0); } while (0)
#define PG8_WAIT_V(n) asm volatile("s_waitcnt vmcnt(" #n ")" ::: "memory")
#define PG8_WAIT_L(n) asm volatile("s_waitcnt lgkmcnt(" #n ")" ::: "memory")
#define PG8_BAR __builtin_amdgcn_s_barrier()
#define PG8_SCHED __builtin_amdgcn_sched_barrier(0)
    Unit cur, nxt; int ui = 0;
    if (!S.next(0, cur)) return;
    f32x4 acc[2][2][4][2];
#pragma unroll
    for (int a = 0; a < 2; ++a)
#pragma unroll
        for (int b = 0; b < 2; ++b)
#pragma unroll
            for (int m = 0; m < 4; ++m)
#pragma unroll
                for (int n = 0; n < 2; ++n) acc[a][b][m][n] = (f32x4){0.f, 0.f, 0.f, 0.f};
    bf16x8 At[4][2], B0[2][2], B1[2][2];
    unsigned cao[2][2], nao[2][2];
#pragma unroll
    for (int h = 0; h < 2; ++h)
#pragma unroll
        for (int i = 0; i < 2; ++i) cao[h][i] = S.a_off(cur, h, sR[i], sC[i]);
    const char* const Ab = S.a_base();
    const char* cB = S.b_base(cur);
    PG8_STAGE(PG8_SB(0, 0), cB, voffB); PG8_STAGE(PG8_SB(0, 1), cB + hstep, voffB); PG8_STAGE(PG8_SA(0, 0), Ab, cao[0]); PG8_STAGE(PG8_SA(0, 1), Ab, cao[1]);
    if (wr == 1) PG8_BAR;
    PG8_WAIT_V(2); PG8_BAR;
    PG8_STAGE(PG8_SB(1, 0), cB + kstep, voffB); PG8_STAGE(PG8_SA(1, 0), Ab + kstep, cao[0]); PG8_STAGE(PG8_SB(1, 1), cB + hstep + kstep, voffB);
    PG8_WAIT_V(6); PG8_BAR;
    for (;;) {
        const bool has_next = S.next(ui + 1, nxt);
        const char* nB = has_next ? S.b_base(nxt) : cB;
#pragma unroll
        for (int h = 0; h < 2; ++h)
#pragma unroll
            for (int i = 0; i < 2; ++i) nao[h][i] = has_next ? S.a_off(nxt, h, sR[i], sC[i]) : cao[h][i];
#pragma nounroll
        for (int t = 0; t < nt; t += 2) {
            const bool last = (t == nt - 2);
            const int ta1 = AWRAP ? (t + 1) % AWRAP : (t + 1), ta2 = AWRAP ? (t + 2) % AWRAP : (t + 2);
            const char* a1 = Ab + (size_t)ta1 * kstep;
            const char* a2 = last ? Ab : Ab + (size_t)ta2 * kstep; const char* b2 = last ? nB : cB + (size_t)(t + 2) * kstep;
            const char* a3 = a2 + kstep; const char* b3 = b2 + kstep;
            unsigned o2[2][2];
#pragma unroll
            for (int h = 0; h < 2; ++h)
#pragma unroll
                for (int i = 0; i < 2; ++i) o2[h][i] = last ? nao[h][i] : cao[h][i];
            PG8_LDB(B0, 0, 0); PG8_LDB(B1, 0, 1); PG8_SCHED; PG8_LDA(At, 0, 0); PG8_STAGE(PG8_SA(1, 1), a1, cao[1]);
            PG8_WAIT_V(8); PG8_WAIT_L(0); PG8_BAR; PG8_MMA(0, 0, At, B0); PG8_MMA(0, 1, At, B1); PG8_BAR; PG8_SCHED;
            PG8_LDA(At, 0, 1); PG8_STAGE(PG8_SB(0, 0), b2, voffB); PG8_STAGE(PG8_SB(0, 1), b2 + hstep, voffB); PG8_STAGE(PG8_SA(0, 0), a2, o2[0]);
            PG8_WAIT_V(8); PG8_WAIT_L(0); PG8_BAR; PG8_MMA(1, 0, At, B0); PG8_MMA(1, 1, At, B1); PG8_BAR; PG8_SCHED;
            PG8_LDB(B0, 1, 0); PG8_LDB(B1, 1, 1); PG8_SCHED; PG8_LDA(At, 1, 0); PG8_STAGE(PG8_SA(0, 1), a2, o2[1]);
            PG8_WAIT_V(8); PG8_WAIT_L(0); PG8_BAR; PG8_MMA(0, 0, At, B0); PG8_MMA(0, 1, At, B1); PG8_BAR; PG8_SCHED;
            PG8_LDA(At, 1, 1); PG8_STAGE(PG8_SB(1, 0), b3, voffB); PG8_STAGE(PG8_SB(1, 1), b3 + hstep, voffB); PG8_STAGE(PG8_SA(1, 0), a3, o2[0]);
            PG8_WAIT_V(8); PG8_WAIT_L(0); PG8_BAR; PG8_MMA(1, 0, At, B0); PG8_MMA(1, 1, At, B1); PG8_BAR; PG8_SCHED;
        }
        if constexpr (ALIGN_EPI) { if (wr == 0) PG8_BAR; }
        E(acc, cur, wr, wc, fr, fq);
        if (!has_next) break;
#pragma unroll
        for (int a = 0; a < 2; ++a)
#pragma unroll
            for (int b = 0; b < 2; ++b)
#pragma unroll
                for (int m = 0; m < 4; ++m)
#pragma unroll
                    for (int n = 0; n < 2; ++n) acc[a][b][m][n] = (f32x4){0.f, 0.f, 0.f, 0.f};
        cur = nxt; cB = nB; ++ui;
#pragma unroll
        for (int h = 0; h < 2; ++h)
#pragma unroll
            for (int i = 0; i < 2; ++i) cao[h][i] = nao[h][i];
        if constexpr (ALIGN_EPI) { if (wr == 1) PG8_BAR; }
    }
    PG8_WAIT_V(0);
    if constexpr (!ALIGN_EPI) { if (wr == 0) PG8_BAR; }
    PG8_BAR;
#undef PG8_SA
#undef PG8_SB
#undef PG8_STAGE
#undef PG8_LDA
#undef PG8_LDB
#undef PG8_MMA
#undef PG8_WAIT_V
#undef PG8_WAIT_L
#undef PG8_BAR
#undef PG8_SCHED
}
}

namespace att {
using bf16x8 = __attribute__((ext_vector_type(8))) short;
using s16x4  = __attribute__((ext_vector_type(4))) short;
using f32x16 = __attribute__((ext_vector_type(16))) float;
constexpr int QBLK = 32, KVBLK = 64, UNIT_ROWS = 128, LDR = D, LDKV = 128;
constexpr float SCALE = 0.125f;
constexpr float THR = 8.f;
constexpr size_t SHM_V = KVBLK * 128 * 2, SHM_K = KVBLK * 128 * 2, SHM_ATTN = 2 * SHM_V + 2 * SHM_K + 8 * 64 * 4;
#define KSWZ(row, colB) ((row) * 256 + ((colB) ^ (((row) & 7) << 4)))
#define SBAR() __builtin_amdgcn_sched_barrier(0)
__device__ __forceinline__ int crow(int r, int hi) { return (r & 3) + 8 * (r >> 2) + 4 * hi; }
__device__ __forceinline__ unsigned cvtpk(float lo, float hi) { unsigned r; asm volatile("v_cvt_pk_bf16_f32 %0, %1, %2" : "=v"(r) : "v"(lo), "v"(hi)); return r; }

__device__ __forceinline__ void partialSM(f32x16& p0, f32x16& p1, float& m_reg, float& mn, float& alpha) {
  constexpr float C = SCALE * 1.4426950408889634f;
  float pmax = p0[0]; for (int r = 1; r < 16; ++r) pmax = fmaxf(pmax, p0[r]); for (int r = 0; r < 16; ++r) pmax = fmaxf(pmax, p1[r]);
  { auto rr = __builtin_amdgcn_permlane32_swap(__float_as_uint(pmax), __float_as_uint(pmax), false, false);
    pmax = fmaxf(__uint_as_float(rr[0]), __uint_as_float(rr[1])); }
  if (__builtin_expect(__all(pmax - m_reg <= THR / SCALE), 1)) { mn = m_reg; alpha = 1.f; }
  else { mn = fmaxf(m_reg, pmax); alpha = __builtin_amdgcn_exp2f((m_reg - mn) * C); m_reg = mn; }
  float mnC = -mn * C;
  for (int r = 0; r < 16; ++r) p0[r] = fmaf(p0[r], C, mnC); for (int r = 0; r < 16; ++r) p1[r] = fmaf(p1[r], C, mnC);
  for (int r = 0; r < 16; ++r) p0[r] = __builtin_amdgcn_exp2f(p0[r]);
}
__device__ __forceinline__ void finishSM(f32x16& p0, f32x16& p1, float alpha, float& l_reg, bf16x8& pa0, bf16x8& pa1, bf16x8& pa2, bf16x8& pa3) {
  for (int r = 0; r < 16; ++r) p1[r] = __builtin_amdgcn_exp2f(p1[r]);
  float ps = 0; for (int r = 0; r < 16; ++r) ps += p0[r]; for (int r = 0; r < 16; ++r) ps += p1[r];
  { auto rr = __builtin_amdgcn_permlane32_swap(__float_as_uint(ps), __float_as_uint(ps), false, false);
    ps = __uint_as_float(rr[0]) + __uint_as_float(rr[1]); }
  l_reg = l_reg * alpha + ps;
#define PK4(P, BASE, OUT) do { unsigned a0 = cvtpk(P[BASE + 0], P[BASE + 1]), a1 = cvtpk(P[BASE + 2], P[BASE + 3]);   \
    unsigned b0 = cvtpk(P[BASE + 4], P[BASE + 5]), b1 = cvtpk(P[BASE + 6], P[BASE + 7]);                              \
    auto r0 = __builtin_amdgcn_permlane32_swap(a0, b0, false, false); auto r1 = __builtin_amdgcn_permlane32_swap(a1, b1, false, false); \
    u32x4 w = {r0[0], r1[0], r0[1], r1[1]}; OUT = *reinterpret_cast<bf16x8*>(&w); } while (0)
  PK4(p0, 0, pa0); PK4(p0, 8, pa1); PK4(p1, 0, pa2); PK4(p1, 8, pa3);
#undef PK4
}
__device__ __forceinline__ void qkt(f32x16& p0, f32x16& p1, const bf16_t* Ks, const bf16x8* qr, int r32, int hi, int mp) {
  p0 = f32x16{}; p1 = f32x16{};
#pragma unroll
  for (int d0 = 0; d0 < 4; ++d0) { int cb = ((mp * 4 + d0) * 16 + hi * 8) * 2;
    bf16x8 b0 = *reinterpret_cast<const bf16x8*>((const char*)Ks + KSWZ(r32, cb));
    bf16x8 b1 = *reinterpret_cast<const bf16x8*>((const char*)Ks + KSWZ(32 + r32, cb));
    p0 = __builtin_amdgcn_mfma_f32_32x32x16_bf16(b0, qr[d0], p0, 0, 0, 0);
    p1 = __builtin_amdgcn_mfma_f32_32x32x16_bf16(b1, qr[d0], p1, 0, 0, 0); }
}
__device__ __forceinline__ int v_st(int k, int c) { const int kk = (k & ~0xC) | ((k & 4) << 1) | ((k & 8) >> 1); return ((kk >> 3) * 4 + (c >> 5)) * 512 + ((kk & 7) * 32 + (c & 31)) * 2; }
__device__ __forceinline__ int v_rd_base(int lane) { return ((lane & 3) << 3) | (((lane >> 2) & 3) << 6) | (((lane >> 4) & 1) << 5) | (((lane >> 5) & 1) << 8); }
constexpr int v_rd_off(int d0, int ks, int half) { return d0 * 512 + ks * 4096 + half * 2048; }
template <int OFF> __device__ __forceinline__ s16x4 tr_read(int vb) {
  s16x4 r; asm volatile("ds_read_b64_tr_b16 %0, %1 offset:%2" : "=&v"(r) : "v"(vb), "i"(OFF) : "memory"); return r;
}
template <int D0> __device__ __forceinline__ void pv_one(f32x16& od, int vb, bf16x8 pa0, bf16x8 pa1, bf16x8 pa2, bf16x8 pa3) {
  const s16x4 l0 = tr_read<v_rd_off(D0, 0, 0)>(vb), h0 = tr_read<v_rd_off(D0, 0, 1)>(vb), l1 = tr_read<v_rd_off(D0, 1, 0)>(vb), h1 = tr_read<v_rd_off(D0, 1, 1)>(vb);
  const s16x4 l2 = tr_read<v_rd_off(D0, 2, 0)>(vb), h2 = tr_read<v_rd_off(D0, 2, 1)>(vb), l3 = tr_read<v_rd_off(D0, 3, 0)>(vb), h3 = tr_read<v_rd_off(D0, 3, 1)>(vb);
  asm volatile("s_waitcnt lgkmcnt(0)" ::: "memory"); SBAR();
#define PK(L, H) (bf16x8){L[0], L[1], L[2], L[3], H[0], H[1], H[2], H[3]}
  od = __builtin_amdgcn_mfma_f32_32x32x16_bf16(pa0, PK(l0, h0), od, 0, 0, 0);
  od = __builtin_amdgcn_mfma_f32_32x32x16_bf16(pa1, PK(l1, h1), od, 0, 0, 0);
  od = __builtin_amdgcn_mfma_f32_32x32x16_bf16(pa2, PK(l2, h2), od, 0, 0, 0);
  od = __builtin_amdgcn_mfma_f32_32x32x16_bf16(pa3, PK(l3, h3), od, 0, 0, 0);
#undef PK
}
__device__ __forceinline__ void pv_d0(f32x16* o, int vb, bf16x8 pa0, bf16x8 pa1, bf16x8 pa2, bf16x8 pa3) {
  pv_one<0>(o[0], vb, pa0, pa1, pa2, pa3); pv_one<1>(o[1], vb, pa0, pa1, pa2, pa3); pv_one<2>(o[2], vb, pa0, pa1, pa2, pa3); pv_one<3>(o[3], vb, pa0, pa1, pa2, pa3);
}

#define TRD(dst, OFF) asm volatile("ds_read_b64_tr_b16 %0, %1 offset:%2" : "=&v"(dst) : "v"(vb), "i"(OFF) : "memory")
#define ISSUE_V(B, D0) do { TRD(vl[B][0], v_rd_off(D0, 0, 0)); TRD(vh[B][0], v_rd_off(D0, 0, 1)); TRD(vl[B][1], v_rd_off(D0, 1, 0)); TRD(vh[B][1], v_rd_off(D0, 1, 1)); \
                            TRD(vl[B][2], v_rd_off(D0, 2, 0)); TRD(vh[B][2], v_rd_off(D0, 2, 1)); TRD(vl[B][3], v_rd_off(D0, 3, 0)); TRD(vh[B][3], v_rd_off(D0, 3, 1)); } while (0)
#define ISSUE_K() do { _Pragma("unroll") for (int d0 = 0; d0 < 4; ++d0) { asm volatile("ds_read_b128 %0, %1" : "=&v"(kf0[d0]) : "v"(ka[d0]) : "memory"); \
                                                                          asm volatile("ds_read_b128 %0, %1 offset:8192" : "=&v"(kf1[d0]) : "v"(ka[d0]) : "memory"); } } while (0)
#define LWAIT(n) do { asm volatile("s_waitcnt lgkmcnt(" #n ")" ::: "memory"); SBAR(); } while (0)
#define PKF(B, k) (bf16x8){vl[B][k][0], vl[B][k][1], vl[B][k][2], vl[B][k][3], vh[B][k][0], vh[B][k][1], vh[B][k][2], vh[B][k][3]}
#define MFMA4(od, B) do { od = __builtin_amdgcn_mfma_f32_32x32x16_bf16(pa0, PKF(B, 0), od, 0, 0, 0); od = __builtin_amdgcn_mfma_f32_32x32x16_bf16(pa1, PKF(B, 1), od, 0, 0, 0); \
                          od = __builtin_amdgcn_mfma_f32_32x32x16_bf16(pa2, PKF(B, 2), od, 0, 0, 0); od = __builtin_amdgcn_mfma_f32_32x32x16_bf16(pa3, PKF(B, 3), od, 0, 0, 0); SBAR(); } while (0)
template <bool DO_PV, bool DO_QK>
__device__ __forceinline__ void mfma_block(f32x16 (&o)[4], f32x16& p0, f32x16& p1, int vb, const int (&ka)[4], bf16x8 pa0, bf16x8 pa1, bf16x8 pa2, bf16x8 pa3, const bf16x8 (&qr)[4]) {
  s16x4 vl[2][4], vh[2][4]; bf16x8 kf0[4], kf1[4];
  if (DO_PV) {
    ISSUE_V(0, 0);
    ISSUE_V(1, 1); LWAIT(8); MFMA4(o[0], 0);
    ISSUE_V(0, 2); LWAIT(8); MFMA4(o[1], 1);
    ISSUE_V(1, 3); LWAIT(8); MFMA4(o[2], 0);
    if (DO_QK) { ISSUE_K(); LWAIT(8); } else { LWAIT(0); }
    MFMA4(o[3], 1);
  } else if (DO_QK) { ISSUE_K(); }
  if (DO_QK) {
    LWAIT(0);
    p0 = f32x16{}; p1 = f32x16{};
#pragma unroll
    for (int d0 = 0; d0 < 4; ++d0) { p0 = __builtin_amdgcn_mfma_f32_32x32x16_bf16(kf0[d0], qr[d0], p0, 0, 0, 0); p1 = __builtin_amdgcn_mfma_f32_32x32x16_bf16(kf1[d0], qr[d0], p1, 0, 0, 0); }
  }
}
#undef TRD
#undef ISSUE_V
#undef ISSUE_K
#undef LWAIT
#undef PKF
#undef MFMA4
__device__ __forceinline__ void softmax_tile(f32x16& p0, f32x16& p1, float& m_reg, float& l_reg, f32x16 (&o)[4], float* al_l, int r32, int hi, bf16x8& pa0, bf16x8& pa1, bf16x8& pa2, bf16x8& pa3) {
  float mn, alpha;
  partialSM(p0, p1, m_reg, mn, alpha);
  if (__any(alpha < 1.f)) { if (hi == 0) al_l[r32] = alpha; asm volatile("s_waitcnt lgkmcnt(0)" ::: "memory");
    _Pragma("unroll") for (int d = 0; d < 4; ++d) _Pragma("unroll") for (int r = 0; r < 16; ++r) o[d][r] *= al_l[crow(r, hi)]; }
  finishSM(p0, p1, alpha, l_reg, pa0, pa1, pa2, pa3);
}
constexpr size_t SHM_PP = 3 * SHM_V + 3 * SHM_K + 8 * 64 * 4;
__device__ __forceinline__ void attn_unit(const bf16_t* __restrict__ Qb, const bf16_t* __restrict__ Kh, const bf16_t* __restrict__ Vh, bf16_t* __restrict__ Ob,
                                          float lam, const float* __restrict__ gsub, int seq, char* lds) {
  const int tid = threadIdx.x, wid = tid >> 6, lane = tid & 63, r32 = lane & 31, hi = lane >> 5, mp = __builtin_amdgcn_readfirstlane(wid >> 2), wq = wid & 3;
  bf16_t* V_lds = (bf16_t*)lds; bf16_t* K_lds = (bf16_t*)(lds + 3 * SHM_V);
  float* ws = (float*)(lds + 3 * SHM_V + 3 * SHM_K) + wid * 64; float* li_l = ws; float* al_l = ws + 32;
  float m_reg = -1e30f, l_reg = 0; f32x16 o[4] = {}; bf16x8 qr[4];
  const bf16_t* Qw = Qb + (long)(wq * QBLK + r32) * LDR + mp * 64 + hi * 8;
#pragma unroll
  for (int d0 = 0; d0 < 4; ++d0) qr[d0] = *reinterpret_cast<const bf16x8*>(Qw + d0 * 16);
  const int sr = tid >> 4, sc = (tid & 15) * 8, vst0 = v_st(sr, sc), vst1 = v_st(32 + sr, sc);
  const int vb0 = (int)(uintptr_t)V_lds + v_rd_base(lane);
  int kbv[4];
#pragma unroll
  for (int d0 = 0; d0 < 4; ++d0) kbv[d0] = (int)(uintptr_t)K_lds + KSWZ(r32, ((mp * 4 + d0) * 16 + hi * 8) * 2);
  bf16x8 s_vs0, s_vs1, s_ks0, s_ks1;
#define SLOAD(k0) do { s_vs0 = *reinterpret_cast<const bf16x8*>(&Vh[(long)((k0) + sr) * LDKV + sc]); s_vs1 = *reinterpret_cast<const bf16x8*>(&Vh[(long)((k0) + 32 + sr) * LDKV + sc]); \
    s_ks0 = *reinterpret_cast<const bf16x8*>(&Kh[(long)((k0) + sr) * LDKV + sc]); s_ks1 = *reinterpret_cast<const bf16x8*>(&Kh[(long)((k0) + 32 + sr) * LDKV + sc]); } while (0)
#define SWRITE(slot) do { *(bf16x8*)((char*)V_lds + (slot) * SHM_V + vst0) = s_vs0;          \
    *(bf16x8*)((char*)V_lds + (slot) * SHM_V + vst1) = s_vs1; int kc = sc * 2;               \
    *(bf16x8*)((char*)K_lds + (slot) * SHM_K + KSWZ(sr, kc)) = s_ks0;                       \
    *(bf16x8*)((char*)K_lds + (slot) * SHM_K + KSWZ(32 + sr, kc)) = s_ks1; } while (0)
  f32x16 p0, p1; bf16x8 pa0, pa1, pa2, pa3; const int NT = seq / KVBLK;
  SLOAD(0); asm volatile("s_waitcnt vmcnt(0)" ::: "memory"); SWRITE(0); if (1 < NT) SLOAD(KVBLK); __syncthreads();
  int sK = 0, sV = 2, sW = 1;
#define STAGE(j) do { if ((j) + 1 < NT) { asm volatile("s_waitcnt vmcnt(0)" ::: "memory"); SWRITE(sW); if ((j) + 2 < NT) SLOAD(((j) + 2) * KVBLK); } } while (0)
#define ROT() do { sV = sK; sK = sW; sW = (sW == 2) ? 0 : sW + 1; } while (0)
#define MFMA_BLOCK(doPV, doQK, MP) do { int ka[4]; _Pragma("unroll") for (int d0 = 0; d0 < 4; ++d0) ka[d0] = kbv[d0] + sK * (int)SHM_K; \
    mfma_block<doPV, doQK>(o, p0, p1, vb0 + sV * (int)SHM_V, ka, pa0, pa1, pa2, pa3, qr); } while (0)
#define SMX() softmax_tile(p0, p1, m_reg, l_reg, o, al_l, r32, hi, pa0, pa1, pa2, pa3)
  if (mp == 0) {
    STAGE(0); MFMA_BLOCK(false, true, 0); __syncthreads(); SMX(); __syncthreads(); ROT();
#pragma nounroll
    for (int j = 1; j < NT; ++j) { STAGE(j); MFMA_BLOCK(true, true, 0); __syncthreads(); SMX(); __syncthreads(); ROT(); }
    MFMA_BLOCK(true, false, 0); __syncthreads(); __syncthreads();
  } else {
    STAGE(0); __syncthreads(); MFMA_BLOCK(false, true, 1); __syncthreads(); ROT();
#pragma nounroll
    for (int j = 1; j < NT; ++j) { STAGE(j); SMX(); __syncthreads(); MFMA_BLOCK(true, true, 1); __syncthreads(); ROT(); }
    SMX(); __syncthreads(); MFMA_BLOCK(true, false, 1); __syncthreads();
  }
#undef STAGE
#undef ROT
#undef MFMA_BLOCK
#undef SMX
  int lane_e = lane; asm volatile("" : "+v"(lane_e));
  const int r32e = lane_e & 31, hie = lane_e >> 5;
  if (hie == 0) li_l[r32e] = l_reg; asm volatile("s_waitcnt lgkmcnt(0)" ::: "memory");
#pragma unroll
  for (int r = 0; r < 16; ++r) { const float rl = __builtin_amdgcn_rcpf(li_l[crow(r, hie)]);
#pragma unroll
    for (int d0 = 0; d0 < 4; ++d0) o[d0][r] *= rl; }
  __syncthreads();
  float* ex = (float*)lds + wq * 4096;
  if (mp == 1) {
#pragma unroll
    for (int d0 = 0; d0 < 4; ++d0)
#pragma unroll
      for (int r = 0; r < 16; ++r) ex[(d0 * 16 + r) * 64 + lane_e] = o[d0][r];
  }
  __syncthreads();
  if (mp == 0) {
    float gq[4];
#pragma unroll
    for (int d0 = 0; d0 < 4; ++d0) gq[d0] = gsub[d0 * 32 + r32e] * (1.f - LAM_INIT);
    bf16_t* Ow = Ob + (long)(wq * QBLK) * LDR;
#pragma unroll
    for (int r = 0; r < 16; ++r) {
      float ss = 0.f;
#pragma unroll
      for (int d0 = 0; d0 < 4; ++d0) { o[d0][r] -= lam * ex[(d0 * 16 + r) * 64 + lane_e]; ss += o[d0][r] * o[d0][r]; }
      ss += __shfl_xor(ss, 1); ss += __shfl_xor(ss, 2); ss += __shfl_xor(ss, 4); ss += __shfl_xor(ss, 8); ss += __shfl_xor(ss, 16);
      const float rn = 1.f / sqrtf(ss * (1.f / DV) + LN_EPS);
      const int orow = crow(r, hie);
#pragma unroll
      for (int d0 = 0; d0 < 4; ++d0) Ow[(long)orow * LDR + d0 * 32 + r32e] = (bf16_t)f2bf(o[d0][r] * rn * gq[d0]);
    }
  }
  __syncthreads();
#undef SLOAD
#undef SWRITE
}

__device__ __forceinline__ void sgu_unit(const bf16_t* __restrict__ Vr  , const bf16_t* __restrict__ Ur, bf16_t* __restrict__ Gr,
                                         const f32x2* __restrict__ vstat  , const float* __restrict__ ng, const float* __restrict__ nb  ,
                                         const float* __restrict__ bs  , const bf16x8 (&pa)[2][4], char* lds) {
  const int tid = threadIdx.x, wid = tid >> 6, lane = tid & 63, r32 = lane & 31, hi = lane >> 5, wp = wid & 3, wcol = wid >> 2;
  const int sr = tid >> 4, sc = (tid & 15) * 8;
  bf16x8 raw[2][2][2];
#pragma unroll
  for (int kh = 0; kh < 2; ++kh)
#pragma unroll
    for (int rr = 0; rr < 2; ++rr)
#pragma unroll
      for (int ch = 0; ch < 2; ++ch) raw[kh][rr][ch] = *reinterpret_cast<const bf16x8*>(Vr + (long)(kh * 64 + rr * 32 + sr) * SGU_DFF + ch * 128 + sc);
  f32x2 st[2][2];
#pragma unroll
  for (int kh = 0; kh < 2; ++kh)
#pragma unroll
    for (int rr = 0; rr < 2; ++rr) st[kh][rr] = vstat[kh * 64 + rr * 32 + sr];
#pragma unroll
  for (int ch = 0; ch < 2; ++ch) {
    float gg[8], bb[8];
#pragma unroll
    for (int i = 0; i < 8; i += 4) { const f32x4 g4 = *(const f32x4*)(ng + ch * 128 + sc + i), b4 = *(const f32x4*)(nb + ch * 128 + sc + i);
      gg[i] = g4.x; gg[i + 1] = g4.y; gg[i + 2] = g4.z; gg[i + 3] = g4.w; bb[i] = b4.x; bb[i + 1] = b4.y; bb[i + 2] = b4.z; bb[i + 3] = b4.w; }
#pragma unroll
    for (int kh = 0; kh < 2; ++kh)
#pragma unroll
      for (int rr = 0; rr < 2; ++rr) {
        const float mean = st[kh][rr].x, rstd = st[kh][rr].y; const bf16x8 x = raw[kh][rr][ch]; unsigned w[4];
#pragma unroll
        for (int i = 0; i < 8; i += 2) { const float v0 = (bf2f((unsigned short)x[i]) - mean) * rstd * gg[i] + bb[i], v1 = (bf2f((unsigned short)x[i + 1]) - mean) * rstd * gg[i + 1] + bb[i + 1]; w[i >> 1] = cvtpk(v0, v1); }
        *(u32x4*)(lds + (kh * 2 + ch) * 16384 + v_st(rr * 32 + sr, sc)) = (u32x4){w[0], w[1], w[2], w[3]};
      }
  }
  __syncthreads();
  f32x16 o[4] = {};
  const int vb = (int)(uintptr_t)lds + v_rd_base(lane) + wcol * 16384;
  pv_d0(o, vb, pa[0][0], pa[0][1], pa[0][2], pa[0][3]);
  pv_d0(o, vb + 2 * 16384, pa[1][0], pa[1][1], pa[1][2], pa[1][3]);
#pragma unroll
  for (int r = 0; r < 16; ++r) { const int p = wp * 32 + crow(r, hi); const float b = bs[p];
#pragma unroll
    for (int d0 = 0; d0 < 4; ++d0) { const long off = (long)p * SGU_DFF + wcol * 128 + d0 * 32 + r32;
      Gr[off] = (bf16_t)f2bf(bf2f(Ur[off]) * (o[d0][r] + b)); } }
  __syncthreads();
}
#undef KSWZ
#undef SBAR
}

struct Args { const float* in[27]; float* out; unsigned char* ws; int ph_lo, ph_hi, ph_lo2, ph_hi2; };
static_assert(offsetof(Args, out) == 27 * 8 && offsetof(Args, ws) == 28 * 8, "Args starts with 29 consecutive pointers");
enum { I_X = 0, I_C, I_CTX, I_CCTX, I_WMOD, I_BMOD, I_LNG, I_LNB, I_AWIN, I_AWOUT, I_ALAM, I_ASUBG, I_SWIN, I_SBIN, I_SNG, I_SNB, I_SWS, I_SBS, I_SWOUT,
       I_RW, I_RB, I_EWG, I_EWU, I_EWD, I_SHG, I_SHU, I_SHD };
constexpr int N_PHASES = 25;

__device__ __forceinline__ f32x4 ld_bf4(const bf16_t* p) { const u32x2 w = *(const u32x2*)p; return (f32x4){bf2f(w.x & 0xffffu), bf2f(w.x >> 16), bf2f(w.y & 0xffffu), bf2f(w.y >> 16)}; }

__device__ __forceinline__ void bf8_to_f32(const u32x4 w, float (&f)[8]) {
    f[0] = bf2f(w.x & 0xffffu); f[1] = bf2f(w.x >> 16); f[2] = bf2f(w.y & 0xffffu); f[3] = bf2f(w.y >> 16); f[4] = bf2f(w.z & 0xffffu); f[5] = bf2f(w.z >> 16); f[6] = bf2f(w.w & 0xffffu); f[7] = bf2f(w.w >> 16);
}
template <bool MOE>
__device__ __forceinline__ void ln_rows(const float* __restrict__ xin, const bf16_t* __restrict__ Yb, float* __restrict__ xout, bf16_t* __restrict__ hb, const float* __restrict__ lng, const float* __restrict__ lnb,
                                        const float* __restrict__ modl, int g_off, const float* __restrict__ modh, int sc_off, int hstride  , int gw, int NGW, int lane) {
    constexpr int NY = MOE ? TOPK + 1 : 1;
    for (int row = gw; row < T; row += NGW) {
        const int b = row / SEQ; const float* mb = modl + b * 6144; const float* mh = modh ? modh + b * 6144 : nullptr;
        u32x4 yr[NY][2]; f32x4 xr[2][2], gr[2][2], lg[2][2], lb[2][2], scv[2][2], shv[2][2];
#pragma unroll
        for (int j = 0; j < 2; ++j) {
            const int c = j * 512 + lane * 8;
            if (!MOE) yr[0][j] = *(const u32x4*)(Yb + (size_t)row * D + c);
            else { yr[TOPK][j] = *(const u32x4*)(Yb + ((size_t)TK + row) * D + c);
#pragma unroll
                for (int k = 0; k < TOPK; ++k) yr[k][j] = *(const u32x4*)(Yb + ((size_t)row * TOPK + k) * D + c); }
#pragma unroll
            for (int q = 0; q < 2; ++q) { xr[j][q] = *(const f32x4*)(xin + (size_t)row * D + c + q * 4); gr[j][q] = *(const f32x4*)(mb + g_off + c + q * 4);
            }
        }
        asm volatile("" ::: "memory");
        float v[2][8]; float s = 0.f;
#pragma unroll
        for (int j = 0; j < 2; ++j) {
            float ya[8]; bf8_to_f32(yr[0][j], ya);
#pragma unroll
            for (int k = 1; k < NY; ++k) { float t8[8]; bf8_to_f32(yr[k][j], t8);
#pragma unroll
                for (int i = 0; i < 8; ++i) ya[i] += t8[i];
                __builtin_amdgcn_sched_barrier(0); }
#pragma unroll
            for (int i = 0; i < 8; ++i) { v[j][i] = xr[j][i >> 2][i & 3] * ALPHA + gr[j][i >> 2][i & 3] * ya[i]; s += v[j][i]; }
        }
#pragma unroll
        for (int j = 0; j < 2; ++j)
#pragma unroll
            for (int q = 0; q < 2; ++q) { const int c = j * 512 + lane * 8 + q * 4; lg[j][q] = *(const f32x4*)(lng + c); lb[j][q] = *(const f32x4*)(lnb + c);
                if (modh) { scv[j][q] = *(const f32x4*)(mh + sc_off + c); shv[j][q] = *(const f32x4*)(mh + sc_off - 1024 + c); } }
        asm volatile("" ::: "memory");
        const float mean = wave_sum(s) * (1.f / D); float s2 = 0.f;
#pragma unroll
        for (int j = 0; j < 2; ++j)
#pragma unroll
            for (int i = 0; i < 8; ++i) { v[j][i] -= mean; s2 += v[j][i] * v[j][i]; }
        const float rstd = 1.f / sqrtf(wave_sum(s2) * (1.f / D) + LN_EPS);
#pragma unroll
        for (int j = 0; j < 2; ++j) {
            const int c = j * 512 + lane * 8;
            float o[8];
#pragma unroll
            for (int i = 0; i < 8; ++i) o[i] = v[j][i] * rstd * lg[j][i >> 2][i & 3] + lb[j][i >> 2][i & 3];
            *(f32x4*)(xout + (size_t)row * D + c) = (f32x4){o[0], o[1], o[2], o[3]}; *(f32x4*)(xout + (size_t)row * D + c + 4) = (f32x4){o[4], o[5], o[6], o[7]};
            if (modh) {
                float h[8];
#pragma unroll
                for (int i = 0; i < 8; ++i) h[i] = o[i] * (scv[j][i >> 2][i & 3] + 1.f) + shv[j][i >> 2][i & 3];
                const u32x4 hw = (u32x4){pk2(h[0], h[1]), pk2(h[2], h[3]), pk2(h[4], h[5]), pk2(h[6], h[7])};
                *(u32x4*)(hb + (size_t)row * hstride + c) = hw;
                if (hstride == HML) { float hf[8]; bf8_to_f32(hw, hf);
                    *(u32x4*)(hb + (size_t)row * hstride + D + c) = (u32x4){pk2(h[0] - hf[0], h[1] - hf[1]), pk2(h[2] - hf[2], h[3] - hf[3]), pk2(h[4] - hf[4], h[5] - hf[5]), pk2(h[6] - hf[6], h[7] - hf[7])}; }
            }
        }
    }
}

__device__ __forceinline__ void expert_prefix(const unsigned* cnt, LAS int* ps, LAS int* xps, int x, int tid) {
    if (tid < 64) {
        int v[4], s = 0;
#pragma unroll
        for (int i = 0; i < 4; ++i) { const int c = (int)cnt[tid * 4 + i]; v[i] = (c + PADM - 1) / PADM * PADM; s += v[i]; }
        int inc = s;
#pragma unroll
        for (int o = 1; o < 64; o <<= 1) { const int t = __shfl_up(inc, o); if (tid >= o) inc += t; }
        int ex = inc - s;
#pragma unroll
        for (int i = 0; i < 4; ++i) { ps[tid * 4 + i] = ex; ex += v[i]; }
        if (tid == 63) ps[256] = ex;
        int tl = 0; if (tid < 32) tl = ((int)cnt[x + 8 * tid] + PADM - 1) / PADM;
        int inc2 = tl;
#pragma unroll
        for (int o = 1; o < 32; o <<= 1) { const int t = __shfl_up(inc2, o); if (tid >= o) inc2 += t; }
        if (tid < 32) { xps[tid] = inc2 - tl; if (tid == 31) xps[32] = inc2; }
    }
    __syncthreads();
}

template <bool LO = false>
__device__ __forceinline__ void cvt_item(const float* __restrict__ W, int ldn, int K, int k0, int n0, bf16_t* __restrict__ Bt, int drow0, LAS unsigned char* wl, int lane, int kd0 = -1) {
    if (kd0 < 0) kd0 = k0;
    const int n4 = (lane & 31) * 4, kh = lane >> 5;
    const float* src = W + (size_t)(k0 + kh * 32) * ldn + n0 + n4;
    f32x4 v[4][8];
#pragma unroll
    for (int b = 0; b < 4; ++b)
#pragma unroll
        for (int i = 0; i < 8; ++i) v[b][i] = __builtin_nontemporal_load((const f32x4*)(src + (size_t)(b * 8 + i) * ldn));
    asm volatile("" ::: "memory");
#pragma unroll
    for (int b = 0; b < 4; ++b) {
        if (LO) {
#pragma unroll
            for (int i = 0; i < 8; ++i) { v[b][i].x -= bf2f(f2bf(v[b][i].x)); v[b][i].y -= bf2f(f2bf(v[b][i].y)); v[b][i].z -= bf2f(f2bf(v[b][i].z)); v[b][i].w -= bf2f(f2bf(v[b][i].w)); }
        }
        const int kc = kh * 4 + b;
#pragma unroll
        for (int c = 0; c < 4; ++c) {
            const int n = n4 + c;
            const u32x4 w = {pk2(v[b][0][c], v[b][1][c]), pk2(v[b][2][c], v[b][3][c]), pk2(v[b][4][c], v[b][5][c]), pk2(v[b][6][c], v[b][7][c])};
            *(LAS u32x4*)(wl + n * 128 + ((kc ^ (n & 7)) << 4)) = w;
        }
        __builtin_amdgcn_sched_barrier(0);
    }
    asm volatile("s_waitcnt lgkmcnt(0)" ::: "memory");
    const int cch = lane & 7;
#pragma unroll
    for (int j = 0; j < 16; ++j) {
        const int n = (lane >> 3) + 8 * j;
        const u32x4 w = *(const LAS u32x4*)(wl + n * 128 + ((cch ^ (n & 7)) << 4));
        __builtin_nontemporal_store(w, (u32x4*)(Bt + (size_t)(drow0 + n) * K + kd0 + cch * 8));
    }
    asm volatile("s_waitcnt lgkmcnt(0)" ::: "memory");
}

struct Ctx { unsigned char* lds; XcdBarrier bar; int G, bid, NGW, lo, hi; long NGT; };
__device__ __forceinline__ unsigned char* ldptr(const unsigned char* lds, int i) {
    const LAS unsigned* p = (const LAS unsigned*)((LAS unsigned char*)lds + LDS_PTRS) + 2 * i;
    const unsigned lo = __builtin_amdgcn_readfirstlane(p[0]), hi = __builtin_amdgcn_readfirstlane(p[1]);
    return (unsigned char*)(GAS unsigned char*)(((unsigned long long)hi << 32) | lo);
}
#define PIN(i) ((const float*)ldptr(lds, (i)))
#ifndef PHMASK
#define PHMASK 0xFFFFFFFFu
#endif
#define IN(k) (((PHMASK >> (k)) & 1u) && lo <= (k) && (k) < hi)
#define SEAM(k) do { if (!MK_PER_PHASE_LAUNCH && IN((k) + 1)) xcd_barrier(bar); else __syncthreads(); } while (0)
#define CTX_LOCALS \
    unsigned char* lds = C.lds; const XcdBarrier bar = C.bar; const int G = C.G, bid = C.bid, NGW = C.NGW; \
    const long NGT = C.NGT; unsigned char* ws = ldptr(lds, 28); unsigned* ctl = (unsigned*)(ws + WS_CTL); float* smf = (float*)lds; const int lo = C.lo, hi = C.hi; \
    LAS unsigned char* ldsl = (LAS unsigned char*)lds; \
    (void)NGW; (void)NGT; (void)ctl; (void)smf; (void)bid; (void)G; (void)ldsl;
#define PH_LOCALS \
    int tid = threadIdx.x; asm volatile("" : "+v"(tid)); const int lane = tid & 63, wave = __builtin_amdgcn_readfirstlane(tid >> 6); const int gw = bid * NWAVES + wave; const long gt = (long)bid * NTHR + tid; \
    (void)lane; (void)wave; (void)gw; (void)gt;
#define WS_PTRS \
    float* modv = (float*)(ws + WS_MODV); float* ROPE = (float*)(ws + WS_ROPE); \
    bf16_t* HALL = (bf16_t*)(ws + WS_HALL); bf16_t* Qb = (bf16_t*)(ws + WS_Q); bf16_t* Kb = (bf16_t*)(ws + WS_K); bf16_t* Vb = (bf16_t*)(ws + WS_V); \
    float* OATT = (float*)(ws + WS_OATT); bf16_t* ATT = (bf16_t*)(ws + WS_ATT); \
    bf16_t* Y = (bf16_t*)(ws + WS_Y); float* X1 = (float*)(ws + WS_X1); float* X2 = (float*)ldptr(lds, 27); \
    bf16_t* HM = (bf16_t*)(ws + WS_HM); bf16_t* H1 = (bf16_t*)(ws + WS_H1); \
    float* LOG = (float*)(ws + WS_LOG); bf16_t* HO = (bf16_t*)(ws + WS_HO); bf16_t* HS = (bf16_t*)(ws + WS_HS); \
    int* IDX = (int*)(ws + WS_IDX); float* WGT = (float*)(ws + WS_WGT); int* POS = (int*)(ws + WS_POS); \
    int* SPAIR = (int*)(ws + WS_SPAIR); float* SW = (float*)(ws + WS_SW); \
    bf16_t* Ub = (bf16_t*)(ws + WS_U); bf16_t* VB = (bf16_t*)(ws + WS_VB); float* VN = (float*)(ws + WS_VN); bf16_t* GSP = (bf16_t*)(ws + WS_GSP); \
    bf16_t* WIN_T = (bf16_t*)(ws + WS_WIN_T); bf16_t* WOUT_T = (bf16_t*)(ws + WS_WOUT_T); bf16_t* SWIN_T = (bf16_t*)(ws + WS_SWIN_T); bf16_t* SWOUT_T = (bf16_t*)(ws + WS_SWOUT_T); \
    bf16_t* SHUP_T = (bf16_t*)(ws + WS_SHUP_T); bf16_t* SHDN_T = (bf16_t*)(ws + WS_SHDN_T); bf16_t* EUP_T = (bf16_t*)(ws + WS_EUP_T); bf16_t* EDN_T = (bf16_t*)(ws + WS_EDN_T); bf16_t* RW_T = (bf16_t*)(ws + WS_RW_T); (void)RW_T; bf16_t* WSB = (bf16_t*)(ws + WS_WSB); f32x2* VSTAT = (f32x2*)(ws + WS_VSTAT); (void)WSB; (void)VSTAT; \
    (void)modv; (void)ROPE; (void)HALL; (void)Qb; (void)Kb; (void)Vb; (void)OATT; (void)ATT; (void)Y; (void)X1; (void)X2; (void)HM; (void)H1; (void)LOG; (void)HO; (void)HS; (void)IDX; (void)WGT; (void)POS; \
    (void)SPAIR; (void)SW; (void)Ub; (void)VB; (void)VN; (void)GSP; (void)WIN_T; (void)WOUT_T; (void)SWIN_T; (void)SWOUT_T; (void)SHUP_T; (void)SHDN_T; (void)EUP_T; (void)EDN_T;

constexpr int NI_WIN = 16 * 24, NI_WOUT = 16 * 8, NI_SWIN = 16 * 32, NI_SWOUT = 32 * 8, NI_RW = 2 * 3 * 32, NI_SH = 2 * 96, NI_DENSE = NI_WIN + NI_WOUT + NI_SWIN + NI_SWOUT + NI_RW + NI_SH;
constexpr int NI_EXP = 2 * NE * 96;
constexpr int NI_EXP_CONV = NI_EXP / 10 * 8;
__device__ __forceinline__ void cvt_weights(unsigned char* lds, int w, int NW, int lane, LAS unsigned char* wl, int it0, int it1) {
    unsigned char* ws = ldptr(lds, 28);
    bf16_t* WIN_T = (bf16_t*)(ws + WS_WIN_T); bf16_t* WOUT_T = (bf16_t*)(ws + WS_WOUT_T); bf16_t* SWIN_T = (bf16_t*)(ws + WS_SWIN_T); bf16_t* SWOUT_T = (bf16_t*)(ws + WS_SWOUT_T);
    bf16_t* SHUP_T = (bf16_t*)(ws + WS_SHUP_T); bf16_t* SHDN_T = (bf16_t*)(ws + WS_SHDN_T); bf16_t* EUP_T = (bf16_t*)(ws + WS_EUP_T); bf16_t* EDN_T = (bf16_t*)(ws + WS_EDN_T); bf16_t* RW_T = (bf16_t*)(ws + WS_RW_T);
    for (int it = it0 + w; it < it1; it += NW) {
        int r = it;
        if (r < NI_WIN) { cvt_item(PIN(I_AWIN), 3 * D, D, (r / 24) * 64, (r % 24) * 128, WIN_T, (r % 24) * 128, wl, lane); continue; } r -= NI_WIN;
        if (r < NI_WOUT) { cvt_item(PIN(I_AWOUT), D, D, (r / 8) * 64, (r % 8) * 128, WOUT_T, (r % 8) * 128, wl, lane); continue; } r -= NI_WOUT;
        if (r < NI_SWIN) { cvt_item(PIN(I_SWIN), 2 * SGU_DFF, D, (r / 32) * 64, (r % 32) * 128, SWIN_T, (r % 32) * 128, wl, lane); continue; } r -= NI_SWIN;
        if (r < NI_SWOUT) { cvt_item(PIN(I_SWOUT), D, SGU_DFF, (r / 8) * 64, (r % 8) * 128, SWOUT_T, (r % 8) * 128, wl, lane); continue; } r -= NI_SWOUT;
        if (r < NI_RW) { const int l = r / 96, seg = (r % 96) / 32, sub = r % 32; const float* rw = PIN(I_RW) + (size_t)l * D * NE; bf16_t* dst = RW_T + (size_t)l * NE * 3072;
            if (seg < 2) cvt_item<false>(rw, NE, 3072, (sub / 2) * 64, (sub % 2) * 128, dst, (sub % 2) * 128, wl, lane, seg * 1024 + (sub / 2) * 64);
            else cvt_item<true>(rw, NE, 3072, (sub / 2) * 64, (sub % 2) * 128, dst, (sub % 2) * 128, wl, lane, 2048 + (sub / 2) * 64);
            continue; } r -= NI_RW;
        const float *wg, *wu, *wd; bf16_t *up_t, *dn_t;
        if (r < NI_SH) { const int l = r / 96; r %= 96; wg = PIN(I_SHG) + (size_t)l * D * EDFF; wu = PIN(I_SHU) + (size_t)l * D * EDFF; wd = PIN(I_SHD) + (size_t)l * EDFF * D;
            up_t = SHUP_T + (size_t)l * 512 * D; dn_t = SHDN_T + (size_t)l * D * EDFF; }
        else { r -= NI_SH; const int le = r / 96; r %= 96; wg = PIN(I_EWG) + (size_t)le * D * EDFF; wu = PIN(I_EWU) + (size_t)le * D * EDFF; wd = PIN(I_EWD) + (size_t)le * EDFF * D;
            up_t = EUP_T + (size_t)le * 512 * D; dn_t = EDN_T + (size_t)le * D * EDFF; }
        const int mat = r / 32, sub = r % 32;
        if (mat < 2) cvt_item(mat == 0 ? wg : wu, EDFF, D, (sub / 2) * 64, (sub % 2) * 128, up_t, (sub % 2) * 256 + mat * 128, wl, lane);
        else cvt_item(wd, D, EDFF, (sub / 8) * 64, (sub % 8) * 128, dn_t, (sub % 8) * 128, wl, lane);
    }
}

__device__ __forceinline__ void phases_front(const Ctx& C) {
    CTX_LOCALS
    WS_PTRS
    if (IN(0)) { PH_LOCALS
        float* sc = smf;
        float* red = smf + 5 * 1024;
        for (int i = tid; i < 5 * 1024; i += NTHR) { const int r = i >> 10, k = i & 1023; const float c = r < 4 ? PIN(I_C)[r * D + k] : PIN(I_CCTX)[k]; sc[i] = siluf(c); }
        __syncthreads();
        for (int it = bid; it < 2 * 96; it += G) {
            const int l = it / 96, j = (it % 96) * 64 + lane;
            const float* w = PIN(I_WMOD) + (size_t)l * D * 6144 + j;
            float a0 = 0, a1 = 0, a2 = 0, a3 = 0, a4 = 0;
            for (int k = wave * 128; k < wave * 128 + 128; ++k) { const float wv = w[(size_t)k * 6144]; a0 += sc[k] * wv; a1 += sc[1024 + k] * wv; a2 += sc[2048 + k] * wv; a3 += sc[3072 + k] * wv; a4 += sc[4096 + k] * wv; }
            red[(wave * 5 + 0) * 64 + lane] = a0; red[(wave * 5 + 1) * 64 + lane] = a1; red[(wave * 5 + 2) * 64 + lane] = a2; red[(wave * 5 + 3) * 64 + lane] = a3; red[(wave * 5 + 4) * 64 + lane] = a4;
            __syncthreads();
            if (tid < 320) { const int r = tid >> 6, jj = tid & 63; float s = 0.f;
#pragma unroll
                for (int w8 = 0; w8 < 8; ++w8) s += red[(w8 * 5 + r) * 64 + jj];
                const int col = (it % 96) * 64 + jj;
                modv[((size_t)l * 5 + r) * 6144 + col] = s + PIN(I_BMOD)[l * 6144 + col]; }
            __syncthreads();
        }
        if (gt < 128 * 16) { const int pos = (int)gt >> 4, jj = (int)gt & 15; const float ang = (float)pos * __powf(10000.f, -(float)jj / 16.f); ROPE[gt * 2] = __cosf(ang); ROPE[gt * 2 + 1] = __sinf(ang); }
        for (long i = gt; i < SGU_G * SGU_CH * SGU_CH / 2; i += NGT) { const f32x2 w = *(const f32x2*)(PIN(I_SWS) + i * 2); ((unsigned*)WSB)[i] = pk2(w.x, w.y); }
        cvt_weights(lds, bid * NWAVES + wave, G * NWAVES, lane, ldsl + wave * 16384, 0, NI_DENSE);
        cvt_weights(lds, bid * NWAVES + wave, G * NWAVES, lane, ldsl + wave * 16384, NI_DENSE + NI_EXP_CONV, NI_DENSE + NI_EXP);
        SEAM(0);
    }
    if (IN(1)) { PH_LOCALS
        for (long i = gt; i < (long)TA * (D / 4); i += NGT) {
            const int row = (int)(i >> 8), c = (int)(i & 255) * 4, b = row / SEQA, n = row % SEQA;
            const float* src = n < SEQ ? PIN(I_X) + ((size_t)b * SEQ + n) * D + c : PIN(I_CTX) + ((size_t)b * CTX + (n - SEQ)) * D + c;
            const float* mb = modv + (n < SEQ ? b : 4) * 6144;
            const f32x4 h = *(const f32x4*)src * (*(const f32x4*)(mb + 1024 + c) + 1.f) + *(const f32x4*)(mb + c);
            *(u32x2*)(HALL + (size_t)row * D + c) = (u32x2){pk2(h.x, h.y), pk2(h.z, h.w)};
        }
        SEAM(1);
    }
#if FAST_DENSE
    if (IN(2)) { PH_LOCALS
        pg8::DenseSched S; S.init(HALL, WIN_T, TA, 3 * D, D, G, bid);
        const pg8::EpiQKV E{Qb, (WS_K - WS_Q) / 2, ROPE, 1.f};
        pg8::gemm_phase<pg8::EpiQKV, pg8::DenseSched, true>(ldsl, D, S, E);
        SEAM(2);
    }
    if (IN(3)) { SEAM(3); }
#else
    if (IN(2)) { PH_LOCALS
        const LoadBf16 la{HALL, D, nullptr};
        for (int it = bid; it < (TA / 128) * 24; it += G) {
            const int mt = it / 24, nt = it % 24;
            auto epi = [=](int r, int c, f32x4 va, f32x4 vb) { bf16_t* dst = Qb + (size_t)(c >> 10) * ((WS_K - WS_Q) / 2) + (size_t)r * D + (c & 1023);
                *(u32x4*)dst = (u32x4){pk2(va.x, va.y), pk2(va.z, va.w), pk2(vb.x, vb.y), pk2(vb.z, vb.w)}; };
            gemm_tile(la, PIN(I_AWIN), 3 * D, D, mt * 128, nt * 128, smf, epi);
        }
        SEAM(2);
    }
    if (IN(3)) { PH_LOCALS
        for (long i = gt; i < (long)T * 1024; i += NGT) {
            const int j = (int)(i & 15), ch = (int)(i >> 4) & 1, hm = (int)(i >> 5) & 15, wh = (int)(i >> 9) & 1; const long tok = i >> 10;
            const int b = (int)(tok / SEQ), n = (int)(tok % SEQ);
            const int pos = ch == 0 ? n / 64 : n % 64;
            const float cs = ROPE[(pos * 16 + j) * 2], sn = ROPE[(pos * 16 + j) * 2 + 1];
            bf16_t* p = (wh ? Kb : Qb) + ((size_t)b * SEQA + n) * D + hm * 64 + ch * 32 + j;
            const float x1 = bf2f(p[0]), x2 = bf2f(p[16]);
            p[0] = (bf16_t)f2bf(x1 * cs - x2 * sn); p[16] = (bf16_t)f2bf(x2 * cs + x1 * sn);
        }
        SEAM(3);
    }
#endif
    if (IN(4)) { PH_LOCALS
        const float* lp = PIN(I_ALAM);
        const float l1 = wave_sum(lp[lane] * lp[64 + lane]), l2 = wave_sum(lp[128 + lane] * lp[192 + lane]);
        const float lam = __expf(l1) - __expf(l2) + LAM_INIT;
        const int x = bid & 7, r = bid >> 3, W = G >> 3, NCV = (W > 16) ? 3 : 0, WA = W - NCV;
        if (r < WA) {
            for (int i = 0; ; ++i) {
                const int idx = i * WA + r; if (idx >= 4 * (SEQ / att::UNIT_ROWS)) break;
                const int pair = x * 4 + idx / (SEQ / att::UNIT_ROWS), qb = idx % (SEQ / att::UNIT_ROWS), b = pair >> 3, h = pair & 7;
                const size_t q0 = (size_t)b * SEQA * D + h * 128, kv0 = (size_t)(b * NH + h) * SEQA * 128;
                att::attn_unit(Qb + q0 + (size_t)qb * att::UNIT_ROWS * D, Kb + kv0, Vb + kv0, ATT + ((size_t)b * SEQ + (size_t)qb * att::UNIT_ROWS) * D + h * 128,
                               lam, PIN(I_ASUBG), SEQA, (char*)lds);
            }
        }
        if (NCV == 0 || r >= WA) {
            const int cw = NCV ? ((r - WA) * 8 + x) * NWAVES + wave : bid * NWAVES + wave, cn = NCV ? NCV * 8 * NWAVES : G * NWAVES;
            cvt_weights(lds, cw, cn, lane, ldsl + wave * 16384, NI_DENSE, NI_DENSE + (NCV ? NI_EXP_CONV : NI_EXP));
        }
        SEAM(4);
    }
    if (IN(5)) { SEAM(5); }
    if (IN(6)) { PH_LOCALS
#if FAST_DENSE
        pg8::DenseSched S; S.init(ATT, WOUT_T, T, D, D, G, bid);
        const pg8::EpiBf16<0> E{Y, D, nullptr, 0, 0};
        pg8::gemm_phase<pg8::EpiBf16<0>, pg8::DenseSched, true>(ldsl, D, S, E);
#else
        const LoadBf16 la{ATT, D, nullptr};
        for (int it = bid; it < (T / 128) * 8; it += G) {
            const int mt = it / 8, nt = it % 8;
            auto epi = [=](int r, int c, f32x4 va, f32x4 vb) { *(u32x4*)(Y + (size_t)r * D + c) = (u32x4){pk2(va.x, va.y), pk2(va.z, va.w), pk2(vb.x, vb.y), pk2(vb.z, vb.w)}; };
            gemm_tile(la, PIN(I_AWOUT), D, D, mt * 128, nt * 128, smf, epi);
        }
#endif
        SEAM(6);
    }
}
template <int L> __device__ __forceinline__ void layer_tail(const Ctx& C) {
    CTX_LOCALS
    WS_PTRS
    const float* xin = (L == 0) ? PIN(I_X) : X2;
    const float* modl = modv + (size_t)L * 5 * 6144;
    unsigned* cnt = ctl + CW_CNT + L * 256;
    LAS int* ps = (LAS int*)(ldsl + LDS_PS); LAS int* xps = ps + 264;
    const int xcd = bid & 7, xr = bid >> 3, XW = G >> 3;
    if (L == 1) {
        if (IN(14)) { PH_LOCALS
#if FAST_DENSE
            pg8::DenseSched S; S.init(H1, SWIN_T, T, 2 * SGU_DFF, D, G, bid);
            const pg8::EpiBf16<1> E{Ub, SGU_DFF, PIN(I_SBIN), SGU_DFF, (WS_VB - WS_U) / 2};
            pg8::gemm_phase<pg8::EpiBf16<1>, pg8::DenseSched, true>(ldsl, D, S, E);
#else
            const LoadBf16 la{H1, D, nullptr};
            for (int it = bid; it < (T / 128) * 32; it += G) {
                const int mt = it / 32, nt = it % 32;
                auto epi = [=](int r, int c, f32x4 va, f32x4 vb) { const float v[8] = {va.x, va.y, va.z, va.w, vb.x, vb.y, vb.z, vb.w};
                    float z[8];
#pragma unroll
                    for (int j = 0; j < 8; ++j) z[j] = gelu_erf(v[j] + PIN(I_SBIN)[c + j]);
                    bf16_t* dst = (c < SGU_DFF) ? Ub + (size_t)r * SGU_DFF + c : VB + (size_t)r * SGU_DFF + (c - SGU_DFF);
                    *(u32x4*)dst = (u32x4){pk2(z[0], z[1]), pk2(z[2], z[3]), pk2(z[4], z[5]), pk2(z[6], z[7])}; };
                gemm_tile(la, PIN(I_SWIN), 2 * SGU_DFF, D, mt * 128, nt * 128, smf, epi);
            }
#endif
            SEAM(14);
        }
        if (IN(15)) { PH_LOCALS
            for (int row = gw; row < T; row += NGW) {
                f32x4 v[8]; float s = 0.f;
#pragma unroll
                for (int j = 0; j < 8; ++j) { v[j] = ld_bf4(VB + (size_t)row * SGU_DFF + j * 256 + lane * 4); s += (v[j].x + v[j].y) + (v[j].z + v[j].w); }
                const float mean = wave_sum(s) * (1.f / SGU_DFF); float s2 = 0.f;
#pragma unroll
                for (int j = 0; j < 8; ++j) { v[j] = v[j] - mean; s2 += (v[j].x * v[j].x + v[j].y * v[j].y) + (v[j].z * v[j].z + v[j].w * v[j].w); }
                const float rstd = 1.f / sqrtf(wave_sum(s2) * (1.f / SGU_DFF) + LN_EPS);
                if (lane == 0) VSTAT[row] = (f32x2){mean, rstd};
            }
            SEAM(15);
        }
        if (IN(16)) { PH_LOCALS
            const int g = bid & 7, wp = wave & 3, r32 = lane & 31, hih = lane >> 5;
            att::bf16x8 pa[2][4];
#pragma unroll
            for (int kh = 0; kh < 2; ++kh)
#pragma unroll
                for (int ks = 0; ks < 4; ++ks) pa[kh][ks] = *reinterpret_cast<const att::bf16x8*>(WSB + ((size_t)g * SGU_CH + wp * 32 + r32) * SGU_CH + kh * 64 + ks * 16 + hih * 8);
            for (int chunk = bid >> 3; chunk < T / SGU_CH; chunk += (G >> 3)) {
                const size_t off = (size_t)chunk * SGU_CH * SGU_DFF + g * SGU_GC;
                att::sgu_unit(VB + off, Ub + off, GSP + off, VSTAT + (size_t)chunk * SGU_CH, PIN(I_SNG) + g * SGU_GC, PIN(I_SNB) + g * SGU_GC, PIN(I_SBS) + g * SGU_CH, pa, (char*)lds);
            }
            SEAM(16);
        }
        if (IN(17)) { PH_LOCALS
#if FAST_DENSE
            pg8::DenseSched S; S.init(GSP, SWOUT_T, T, D, SGU_DFF, G, bid);
            const pg8::EpiBf16<0> E{Y, D, nullptr, 0, 0};
            pg8::gemm_phase<pg8::EpiBf16<0>, pg8::DenseSched, true>(ldsl, SGU_DFF, S, E);
#else
            const LoadBf16 la{GSP, SGU_DFF, nullptr};
            for (int it = bid; it < (T / 128) * 8; it += G) {
                const int mt = it / 8, nt = it % 8;
                auto epi = [=](int r, int c, f32x4 va, f32x4 vb) { *(u32x4*)(Y + (size_t)r * D + c) = (u32x4){pk2(va.x, va.y), pk2(va.z, va.w), pk2(vb.x, vb.y), pk2(vb.z, vb.w)}; };
                gemm_tile(la, PIN(I_SWOUT), D, SGU_DFF, mt * 128, nt * 128, smf, epi);
            }
#endif
            SEAM(17);
        }
    }
    constexpr int P_LN = (L == 0) ? 7 : 18;
    if (IN(P_LN)) { PH_LOCALS
        ln_rows<false>(xin, Y, X1, HM, PIN(I_LNG) + (L * 2 + 0) * D, PIN(I_LNB) + (L * 2 + 0) * D, modl, 2048, modl, 4096, HML, gw, NGW, lane);
        SEAM(P_LN);
    }
    if (IN(P_LN + 1)) { PH_LOCALS
        pg8::DenseSched S; S.init(HM, RW_T + (size_t)L * NE * 3072, T, NE, 3072, G, bid, HML);
        const pg8::EpiF32 E{LOG, NE};
        pg8::gemm_phase<pg8::EpiF32, pg8::DenseSched, true, 32>(ldsl, 3072, S, E);
        SEAM(P_LN + 1);
    }
    if (IN(P_LN + 2)) { PH_LOCALS
        const float* rb = PIN(I_RB) + L * NE;
        const f32x4 bias = *(const f32x4*)(rb + lane * 4);
        for (int t = gw; t < T; t += NGW) {
            const f32x4 lg = *(const f32x4*)(LOG + (size_t)t * NE + lane * 4);
            float sc[4], ch[4];
#pragma unroll
            for (int i = 0; i < 4; ++i) { sc[i] = sigmoidf_(lg[i]); ch[i] = sc[i] + bias[i]; }
            float m1 = fmaxf(ch[0], ch[1]), m2 = fminf(ch[0], ch[1]);
#pragma unroll
            for (int i = 2; i < 4; ++i) { const float v = ch[i]; m2 = fmaxf(m2, fminf(m1, v)); m1 = fmaxf(m1, v); }
#pragma unroll
            for (int o = 1; o < 8; o <<= 1) { const float b1 = __shfl_xor(m1, o), b2 = __shfl_xor(m2, o); const float n1 = fmaxf(m1, b1), n2 = fmaxf(fminf(m1, b1), fmaxf(m2, b2)); m1 = n1; m2 = n2; }
            const float gs = m1 + m2; const int g = lane >> 3; int rank = 0;
#pragma unroll
            for (int gg = 0; gg < 8; ++gg) { const float o = __shfl(gs, gg * 8); rank += (o > gs || (o == gs && gg < g)) ? 1 : 0; }
            const bool sel = rank < 4;
            float cm[4];
#pragma unroll
            for (int i = 0; i < 4; ++i) cm[i] = sel ? ch[i] : -INFINITY;
            float wsum = 0.f, myw = 0.f; int myidx = 0;
#pragma unroll
            for (int k = 0; k < TOPK; ++k) {
                float bv = cm[0]; int bi = lane * 4;
#pragma unroll
                for (int i = 1; i < 4; ++i) if (cm[i] > bv) { bv = cm[i]; bi = lane * 4 + i; }
#pragma unroll
                for (int o = 1; o < 64; o <<= 1) { const float ov = __shfl_xor(bv, o); const int oi = __shfl_xor(bi, o); if (ov > bv || (ov == bv && oi < bi)) { bv = ov; bi = oi; } }
                const int sub = bi & 3; const float mysc = sub == 0 ? sc[0] : sub == 1 ? sc[1] : sub == 2 ? sc[2] : sc[3];
                const float wv = __shfl(mysc, bi >> 2);
                if ((bi >> 2) == lane) { if (sub == 0) cm[0] = -INFINITY; else if (sub == 1) cm[1] = -INFINITY; else if (sub == 2) cm[2] = -INFINITY; else cm[3] = -INFINITY; }
                wsum += wv; if (lane == k) { myw = wv; myidx = bi; }
            }
            if (lane < TOPK) {
                IDX[t * TOPK + lane] = myidx; WGT[t * TOPK + lane] = myw / wsum * ROUTED_SCALE;
                POS[t * TOPK + lane] = (int)atomicAdd(cnt + myidx, 1u);
            }
        }
        SEAM(P_LN + 2);
    }
    if (IN(P_LN + 3)) { PH_LOCALS
        expert_prefix(cnt, ps, xps, xcd, tid);
        for (long p = gt; p < TK; p += NGT) { const int e = IDX[p]; const int slot = ps[e] + POS[p]; SPAIR[slot] = (int)p; SW[slot] = WGT[p]; }
        for (int e = bid; e < NE; e += G) { const int c = (int)cnt[e], pe = ps[e + 1] - ps[e]; for (int s = c + tid; s < pe; s += NTHR) { SPAIR[ps[e] + s] = -1; SW[ps[e] + s] = 0.f; } }
        for (long t = gt; t < T; t += NGT) { SPAIR[PMAX + t] = TK + (int)t; SW[PMAX + t] = 1.f; }
        SEAM(P_LN + 3);
    }
    auto naive_up = [=](int row0, int e, int pn) {
        const float* wg = e < NE ? PIN(I_EWG) + ((size_t)L * NE + e) * D * EDFF : PIN(I_SHG) + (size_t)L * D * EDFF;
        const float* wu = e < NE ? PIN(I_EWU) + ((size_t)L * NE + e) * D * EDFF : PIN(I_SHU) + (size_t)L * D * EDFF;
        auto la = [=](int r, int k) -> f32x4 { const int p = SPAIR[r]; const int tok = p < 0 ? 0 : (p < TK ? (p >> 3) : (p - TK)); return ld_bf4(HM + (size_t)tok * HML + k); };
        for (int half = 0; half < 2; ++half) {
            f32x4 ga[4], gb[4];
            { int ri = 0; auto epi1 = [&](int r, int c, f32x4 va, f32x4 vb) { ga[ri] = va; gb[ri] = vb; ++ri; }; gemm_tile(la, wg, EDFF, D, row0 + half * 128, pn * 128, smf, epi1); }
            { int ri = 0; auto epi2 = [&](int r, int c, f32x4 va, f32x4 vb) { const float w = SW[r]; const f32x4 g0 = ga[ri], g1 = gb[ri]; ++ri;
                *(u32x4*)(HS + (size_t)r * EDFF + c) = (u32x4){pk2(w * siluf(g0.x) * va.x, w * siluf(g0.y) * va.y), pk2(w * siluf(g0.z) * va.z, w * siluf(g0.w) * va.w), pk2(w * siluf(g1.x) * vb.x, w * siluf(g1.y) * vb.y), pk2(w * siluf(g1.z) * vb.z, w * siluf(g1.w) * vb.w)}; };
              gemm_tile(la, wu, EDFF, D, row0 + half * 128, pn * 128, smf, epi2); }
        }
    };
    auto naive_dn = [=](int row0, int e, int pn) {
        const float* wd = e < NE ? PIN(I_EWD) + ((size_t)L * NE + e) * EDFF * D : PIN(I_SHD) + (size_t)L * EDFF * D;
        const LoadBf16 la{HS, EDFF, nullptr};
        auto epi = [=](int r, int c, f32x4 va, f32x4 vb) { const int p = SPAIR[r];
            if (p >= 0) *(u32x4*)(HO + (size_t)p * D + c) = (u32x4){pk2(va.x, va.y), pk2(va.z, va.w), pk2(vb.x, vb.y), pk2(vb.z, vb.w)}; };
        for (int q = 0; q < 4; ++q) gemm_tile(la, wd, D, EDFF, row0 + (q >> 1) * 128, pn * 256 + (q & 1) * 128, smf, epi);
    };
    if (IN(P_LN + 4)) { PH_LOCALS
        expert_prefix(cnt, ps, xps, xcd, tid);
        LAS int* ptab = (LAS int*)(ldsl + LDS_TAB); LAS float* wtab = (LAS float*)(ldsl + LDS_TAB + MAXU_UP * 1024);
        pg8::MoeSched<true, MAXU_UP> S{(const char*)HM, (const char*)(EUP_T + (size_t)L * NE * 512 * D), (const char*)(SHUP_T + (size_t)L * 512 * D), (size_t)512 * D * 2, D, HML, 2, xcd, xr, XW, ps, xps, ptab};
        pg8::Unit u;
#if FAST_MOE
        for (int j = 0; S.next(j, u); ++j) if (tid < 256) { ptab[j * 256 + tid] = SPAIR[u.row0 + tid]; wtab[j * 256 + tid] = SW[u.row0 + tid]; }
        __syncthreads();
        const pg8::EpiMoeUp<MAXU_UP> E{HS, wtab};
        pg8::gemm_phase<pg8::EpiMoeUp<MAXU_UP>, pg8::MoeSched<true, MAXU_UP>, true>(ldsl, D, S, E);
        for (int j = MAXU_UP; S.next_any(j, u); ++j) naive_up(u.row0, u.e, u.pn);
#else
        for (int j = 0; S.next_any(j, u); ++j) naive_up(u.row0, u.e, u.pn);
#endif
        SEAM(P_LN + 4);
    }
    if (IN(P_LN + 5)) { PH_LOCALS
        expert_prefix(cnt, ps, xps, xcd, tid);
        LAS int* ptab = (LAS int*)(ldsl + LDS_TAB);
        pg8::MoeSched<false, MAXU_DN> S{(const char*)HS, (const char*)(EDN_T + (size_t)L * NE * D * EDFF), (const char*)(SHDN_T + (size_t)L * D * EDFF), (size_t)D * EDFF * 2, EDFF, EDFF, 4, xcd, xr, XW, ps, xps, ptab};
        pg8::Unit u;
#if FAST_MOE
        for (int j = 0; S.next(j, u); ++j) if (tid < 256) ptab[j * 256 + tid] = SPAIR[u.row0 + tid];
        __syncthreads();
        const pg8::EpiMoeDown<MAXU_DN> E{HO, ptab};
        int kdn = EDFF; asm volatile("" : "+s"(kdn));
        pg8::gemm_phase<pg8::EpiMoeDown<MAXU_DN>, pg8::MoeSched<false, MAXU_DN>, true>(ldsl, kdn, S, E);
        for (int j = MAXU_DN; S.next_any(j, u); ++j) naive_dn(u.row0, u.e, u.pn);
#else
        for (int j = 0; S.next_any(j, u); ++j) naive_dn(u.row0, u.e, u.pn);
#endif
        SEAM(P_LN + 5);
    }
    if (IN(P_LN + 6)) { PH_LOCALS
        if (L == 0) ln_rows<true>(X1, HO, X2, H1, PIN(I_LNG) + (L * 2 + 1) * D, PIN(I_LNB) + (L * 2 + 1) * D, modl, 5120, modv + (size_t)5 * 6144, 1024, D, gw, NGW, lane);
        else ln_rows<true>(X1, HO, X2, nullptr, PIN(I_LNG) + (L * 2 + 1) * D, PIN(I_LNB) + (L * 2 + 1) * D, modl, 5120, nullptr, 0, D, gw, NGW, lane);
        SEAM(P_LN + 6);
    }
}

__global__ void __launch_bounds__(NTHR, 2) mega(Args args) {
    extern __shared__ __attribute__((aligned(16))) unsigned char lds[];
    const int tid = threadIdx.x;
    const int G = gridDim.x, bid = blockIdx.x;
    unsigned* ctl = (unsigned*)(args.ws + WS_CTL);
    for (int u = tid; u < 512; u += NTHR) ((unsigned*)(lds + LDS_MISC))[u] = 0u;
    __syncthreads();
    if (tid < 29) {
        const unsigned long long* kp = (const unsigned long long*)__builtin_amdgcn_kernarg_segment_ptr();
        ((unsigned long long*)(lds + LDS_PTRS))[tid] = kp[tid]; }
    __syncthreads();
    XcdBarrier bar; bar.bar = ctl + CW_BAR; bar.x = 0; bar.st = nullptr;
    if (!MK_PER_PHASE_LAUNCH) bar = xcd_barrier_post(ctl + CW_BAR, (volatile LAS unsigned*)(lds + LDS_MISC) + 8);
    Ctx C; C.lds = lds; C.bar = bar; C.G = G; C.bid = bid; C.NGW = G * NWAVES; C.NGT = (long)G * NTHR;
    C.lo = args.ph_lo; C.hi = args.ph_hi;
    phases_front(C);
    layer_tail<0>(C);
    layer_tail<1>(C);
#ifndef NO_PROBE_PASS
    if (args.ph_hi2 > args.ph_lo2) {
        xcd_barrier(bar);
        C.lo = args.ph_lo2; C.hi = args.ph_hi2;
        phases_front(C);
        layer_tail<0>(C);
        layer_tail<1>(C);
    }
#endif
}

extern "C" void kernel_launch(void* const* d_in, const int* in_sizes, int n_in, void* d_out, int out_size, void* d_ws, size_t ws_size, hipStream_t stream) {
    static int grid = 0;
    if (grid == 0) {
        if (n_in != 27 || out_size != T * D || ws_size < WS_END) { fprintf(stderr, "kernel_launch: unexpected shapes n_in %d out %d ws %zu (need %zu)\n", n_in, out_size, ws_size, (size_t)WS_END); grid = -1; return; }
        int dev = 0, cus = 0, per_cu = 0;
        if (hipGetDevice(&dev) != hipSuccess || hipDeviceGetAttribute(&cus, hipDeviceAttributeMultiprocessorCount, dev) != hipSuccess) { grid = -1; return; }
        if (hipFuncSetAttribute((const void*)mega, hipFuncAttributeMaxDynamicSharedMemorySize, LDS_BYTES) != hipSuccess) { fprintf(stderr, "kernel_launch: hipFuncSetAttribute failed\n"); grid = -1; return; }
        if (hipOccupancyMaxActiveBlocksPerMultiprocessor(&per_cu, (const void*)mega, NTHR, LDS_BYTES) != hipSuccess || per_cu < 1) fprintf(stderr, "kernel_launch: occupancy query reports %d\n", per_cu);
        (void)hipGetLastError();
        grid = cus;
    }
    if (grid < 0) return;
    if (hipMemsetAsync((char*)d_ws + WS_CTL, 0, CTL_ZERO_BYTES, stream) != hipSuccess) return;
    Args a{};
    for (int i = 0; i < 27; ++i) a.in[i] = (const float*)d_in[i];
    a.out = (float*)d_out; a.ws = (unsigned char*)d_ws;
#if MK_PER_PHASE_LAUNCH
    for (int p = 0; p < N_PHASES; ++p) { a.ph_lo = p; a.ph_hi = p + 1; hipLaunchKernelGGL(mega, dim3(grid), dim3(NTHR), LDS_BYTES, stream, a); }
#else
    a.ph_lo = 0; a.ph_hi = N_PHASES;
#ifdef PROBE_DUP
    a.ph_hi = PROBE_DUP_END; a.ph_lo2 = PROBE_DUP; a.ph_hi2 = N_PHASES;
#endif
    hipLaunchKernelGGL(mega, dim3(grid), dim3(NTHR), LDS_BYTES, stream, a);
#endif
    const hipError_t le = hipPeekAtLastError();
    if (le != hipSuccess) fprintf(stderr, "kernel_launch: launch failed: %s\n", hipGetErrorName(le));
}
```

```cpp
#include <hip/hip_runtime.h>
#include <cstdio>
#include <cstdint>
#include <cstddef>

#ifndef MK_PER_PHASE_LAUNCH
#define MK_PER_PHASE_LAUNCH 0
#endif
#ifndef FAST_DENSE
#define FAST_DENSE 1
#endif
#ifndef FAST_MOE
#define FAST_MOE 1
#endif

#define GAS __attribute__((address_space(1)))
#define LAS __attribute__((address_space(3)))
typedef unsigned short bf16_t;
typedef float f32x4 __attribute__((ext_vector_type(4)));
typedef float f32x2 __attribute__((ext_vector_type(2)));
typedef unsigned u32x4 __attribute__((ext_vector_type(4)));
typedef unsigned u32x2 __attribute__((ext_vector_type(2)));

constexpr int D = 1024, BATCH = 4, SEQ = 8192, CTX = 256, T = BATCH * SEQ, SEQA = SEQ + CTX, TA = BATCH * SEQA;
constexpr int NH = 8, HD = 64, DV = 128;
constexpr int SGU_DFF = 2048, SGU_CH = 128, SGU_G = 8, SGU_GC = 256;
constexpr int NE = 256, TOPK = 8, NGRP = 8, EDFF = 256;
constexpr int TK = T * TOPK;
constexpr int HML = 2048;
constexpr int PADM = 256;
constexpr int PMAX = TK + NE * PADM;
constexpr float LN_EPS = 1e-5f, ALPHA = 1.4142135623730951f, ROUTED_SCALE = 2.5f;
constexpr float LAM_INIT = 0.2f;
constexpr int NWAVES = 8, NTHR = 512;

constexpr size_t MiB = 1u << 20;
constexpr size_t WS_CTL = 0, CTL_ZERO_BYTES = 1 * MiB;
constexpr int CW_BAR = 4096;
constexpr int CW_CNT = 32768;
constexpr size_t WS_MODV = 1 * MiB;
constexpr size_t WS_ROPE = WS_MODV + 512 * 1024;
constexpr size_t WS_IDX = 2 * MiB, WS_WGT = 3 * MiB, WS_POS = 4 * MiB;
constexpr size_t WS_SPAIR = 5 * MiB, WS_SW = 7 * MiB;
constexpr size_t WS_WIN_T = 16 * MiB;
constexpr size_t WS_WOUT_T = 22 * MiB;
constexpr size_t WS_SWIN_T = 24 * MiB;
constexpr size_t WS_SWOUT_T = 32 * MiB;
constexpr size_t WS_SHUP_T = 36 * MiB;
constexpr size_t WS_SHDN_T = 38 * MiB;
constexpr size_t WS_RW_T = 40 * MiB;
constexpr size_t WS_WSB = 46 * MiB;
constexpr size_t WS_VSTAT = 47 * MiB;
constexpr size_t WS_EUP_T = 48 * MiB;
constexpr size_t WS_EDN_T = 560 * MiB;
constexpr size_t WS_R = 816 * MiB;
constexpr size_t WS_HALL = WS_R, WS_Q = WS_R + 66 * MiB, WS_K = WS_R + 132 * MiB, WS_V = WS_R + 198 * MiB, WS_OATT = WS_R + 264 * MiB, WS_ATT = WS_R + 520 * MiB;
constexpr size_t WS_U = WS_R, WS_VB = WS_R + 128 * MiB, WS_GSP = WS_R + 256 * MiB, WS_VN = WS_R + 384 * MiB;
constexpr size_t WS_HO = WS_R;
constexpr size_t WS_Y = WS_R + 640 * MiB;
constexpr size_t WS_X1 = WS_Y + 64 * MiB;
constexpr size_t WS_HM = WS_X1 + 128 * MiB;
constexpr size_t WS_H1 = WS_HM + 128 * MiB;
constexpr size_t WS_LOG = WS_H1 + 64 * MiB;
constexpr size_t WS_HS = WS_LOG + 32 * MiB;
constexpr size_t WS_END = WS_HS + 176 * MiB;
static_assert(WS_END <= (size_t)2048 * MiB, "workspace map exceeds 2 GiB");
static_assert((size_t)(PMAX + T) * EDFF * 2 <= 176 * MiB && (size_t)TA * D * 2 <= 66 * MiB && (size_t)(TK + T + 1) * D * 2 <= 640 * MiB, "ws sizes");
static_assert((size_t)(PMAX + T) * 4 <= 2 * MiB, "slot tables");

constexpr int LDS_BYTES = 163840;
constexpr int LDS_MISC = 131072;
constexpr int LDS_PS = LDS_MISC + 256;
constexpr int LDS_PTRS = LDS_MISC + 1536;
constexpr int LDS_TAB = LDS_MISC + 2048;
constexpr int MAXU_UP = 14, MAXU_DN = 28;
static_assert(LDS_TAB + 28 * 1024 <= LDS_BYTES, "LDS map");

#define XB_TMO      128
#define XB_XCNT(j)  (256  + 64 * (j))
#define XB_XSUB(j)  (1280 + 64 * (j))
#define XB_XGEN(j)  (2304 + 64 * (j))
#define XB_TOP      3328
#define XB_TOPGEN   3392
#define XCD_BAR_WORDS 3456
#define XB_SPIN_CAP (1u << 22)

__device__ __forceinline__ unsigned xb_ld(unsigned* p)              { return __hip_atomic_load(p, __ATOMIC_RELAXED, __HIP_MEMORY_SCOPE_AGENT); }
__device__ __forceinline__ unsigned xb_add(unsigned* p, unsigned v) { return __hip_atomic_fetch_add(p, v, __ATOMIC_RELAXED, __HIP_MEMORY_SCOPE_AGENT); }
__device__ __forceinline__ unsigned xb_xcc_id() { return (unsigned)__builtin_amdgcn_s_getreg((3 << 11) | 20) & 0xFu; }
#define XB_SPIN(cond, bar) do { unsigned _sp = 0; while (cond) { __builtin_amdgcn_s_sleep(1); \
    if ((++_sp & 255u) == 0u) { if (xb_ld(&(bar)[XB_TMO])) break; if (_sp > XB_SPIN_CAP) { atomicAdd(&(bar)[XB_TMO], 1u); break; } } } } while (0)

struct XcdBarrier { unsigned* bar; unsigned x; volatile LAS unsigned* st; };

__device__ __forceinline__ XcdBarrier xcd_barrier_post(unsigned* bar, volatile LAS unsigned* st) {
    XcdBarrier b; b.bar = bar; b.x = xb_xcc_id(); b.st = st;
    if (threadIdx.x == 0) (void)xb_add(&bar[XB_XCNT(b.x)], 1u);
    return b;
}
__device__ __forceinline__ void xcd_barrier_complete(unsigned* bar, unsigned x, unsigned& nloc, unsigned& nx) {
    const unsigned G = gridDim.x * gridDim.y * gridDim.z;
    unsigned sum, cnt, mine, sp = 0u;
    for (;;) {
        sum = 0u; cnt = 0u; mine = 0u;
#pragma unroll
        for (unsigned j = 0; j < 16; ++j) { const unsigned c = xb_ld(&bar[XB_XCNT(j)]); sum += c; cnt += (c > 0u) ? 1u : 0u; mine = (j == x) ? c : mine; }
        if (sum == G) break;
        __builtin_amdgcn_s_sleep(1);
        if ((++sp & 255u) == 0u) { if (xb_ld(&bar[XB_TMO])) break; if (sp > XB_SPIN_CAP) { atomicAdd(&bar[XB_TMO], 1u); break; } }
    }
    nloc = mine > 0u ? mine : 1u; nx = cnt > 0u ? cnt : 1u;
}
__device__ __forceinline__ void xcd_barrier(const XcdBarrier& b) {
    asm volatile("s_waitcnt vmcnt(0)" ::: "memory");
    __syncthreads();
    if (threadIdx.x == 0) {
        unsigned* bar = b.bar;
        __builtin_amdgcn_s_waitcnt(0);
        unsigned nloc = b.st[0], nx = b.st[1];
        if (nloc == 0u) { xcd_barrier_complete(bar, b.x, nloc, nx); b.st[0] = nloc; b.st[1] = nx; }
        const unsigned old = xb_add(&bar[XB_XSUB(b.x)], 1u);
        const unsigned gen = old / nloc;
        if (old + 1u == (gen + 1u) * nloc) {
            __builtin_amdgcn_fence(__ATOMIC_RELEASE, "agent");
            asm volatile("s_waitcnt vmcnt(0)" ::: "memory");
            const unsigned og = xb_add(&bar[XB_TOP], 1u);
            const unsigned tg = og / nx;
            if (og + 1u == (tg + 1u) * nx) xb_add(&bar[XB_TOPGEN], 1u);
            else XB_SPIN(xb_ld(&bar[XB_TOPGEN]) == tg, bar);
            __builtin_amdgcn_fence(__ATOMIC_ACQUIRE, "agent");
            xb_add(&bar[XB_XGEN(b.x)], 1u);
            asm volatile("s_waitcnt vmcnt(0)" ::: "memory");
        } else {
            XB_SPIN(xb_ld(&bar[XB_XGEN(b.x)]) == gen, bar);
            __builtin_amdgcn_fence(__ATOMIC_ACQUIRE, "agent");
            asm volatile("s_waitcnt vmcnt(0)" ::: "memory");
        }
    }
    __syncthreads();
}

__device__ __forceinline__ unsigned f2bf(float f) { unsigned u = __builtin_bit_cast(unsigned, f); return (u + 0x7fffu + ((u >> 16) & 1u)) >> 16; }
__device__ __forceinline__ float bf2f(unsigned b) { return __builtin_bit_cast(float, b << 16); }
__device__ __forceinline__ unsigned pk2(float lo, float hi) { return f2bf(lo) | (f2bf(hi) << 16); }
__device__ __forceinline__ float wave_sum(float v) {
#pragma unroll
    for (int o = 1; o < 64; o <<= 1) v += __shfl_xor(v, o);
    return v;
}
__device__ __forceinline__ float siluf(float x) { return x / (1.f + __expf(-x)); }
__device__ __forceinline__ float sigmoidf_(float x) { return 1.f / (1.f + __expf(-x)); }
__device__ __forceinline__ float gelu_erf(float x) { return 0.5f * x * (1.f + erff(x * 0.70710678118654752f)); }

template <class LoadA, class Epi>
__device__ __forceinline__ void gemm_tile(const LoadA& la, const float* __restrict__ W, int ldw, int K, int m0, int n0, float* sm, const Epi& E) {
    const int tid = threadIdx.x, ty = tid >> 4, tx = tid & 15;
    float* As = sm; float* Bs = sm + 16 * 132;
    f32x4 acc[4][2];
#pragma unroll
    for (int i = 0; i < 4; ++i) { acc[i][0] = (f32x4){0.f, 0.f, 0.f, 0.f}; acc[i][1] = (f32x4){0.f, 0.f, 0.f, 0.f}; }
    const int ar = tid >> 2, k4 = (tid & 3) * 4;
    const int bk = tid >> 5, bn = (tid & 31) * 4;
    const float* bp = W + (size_t)bk * ldw + n0 + bn;
    for (int k0 = 0; k0 < K; k0 += 16) {
        const f32x4 a = la(m0 + ar, k0 + k4);
        const f32x4 b = *(const f32x4*)(bp + (size_t)k0 * ldw);
        __syncthreads();
        As[(k4 + 0) * 132 + ar] = a.x; As[(k4 + 1) * 132 + ar] = a.y; As[(k4 + 2) * 132 + ar] = a.z; As[(k4 + 3) * 132 + ar] = a.w;
        *(f32x4*)&Bs[bk * 128 + bn] = b;
        __syncthreads();
#pragma unroll 4
        for (int kk = 0; kk < 16; ++kk) {
            const f32x4 av = *(const f32x4*)&As[kk * 132 + ty * 4];
            const f32x4 b0 = *(const f32x4*)&Bs[kk * 128 + tx * 8], b1 = *(const f32x4*)&Bs[kk * 128 + tx * 8 + 4];
#pragma unroll
            for (int i = 0; i < 4; ++i) { acc[i][0] += b0 * av[i]; acc[i][1] += b1 * av[i]; }
        }
    }
#pragma unroll
    for (int i = 0; i < 4; ++i) E(m0 + ty * 4 + i, n0 + tx * 8, acc[i][0], acc[i][1]);
}
struct LoadBf16 {
    const bf16_t* A; int lda; const int* rowidx;
    __device__ __forceinline__ f32x4 operator()(int r, int k) const {
        const int rr = rowidx ? rowidx[r] : r;
        const u32x2 w = *(const u32x2*)(A + (size_t)rr * lda + k);
        return (f32x4){bf2f(w.x & 0xffffu), bf2f(w.x >> 16), bf2f(w.y & 0xffffu), bf2f(w.y >> 16)};
    }
};
struct LoadF32 {
    const float* A; int lda;
    __device__ __forceinline__ f32x4 operator()(int r, int k) const { return *(const f32x4*)(A + (size_t)r * lda + k); }
};

namespace pg8 {
typedef short bf16x8 __attribute__((ext_vector_type(8)));
constexpr int BM = 256, BK = 64, HALF = 128, HTB = HALF * BK * 2, STAGE_BYTES = 8 * HTB, NXCD = 8, WGM = 8;
__host__ __device__ __forceinline__ int lds_byte(int r, int c) { const int st = (r >> 4) * 2 + (c >> 5), rr = r & 15, cc = c & 31, ob = rr * 64 + cc * 2; return st * 1024 + (ob ^ (((ob >> 9) & 1) << 5)); }
__host__ __device__ __forceinline__ void stage_rc(int b, int& R, int& C) { const int st = b / 1024, sb = b % 1024, swz = sb ^ (((sb >> 9) & 1) << 5); R = (st >> 1) * 16 + swz / 64; C = (st & 1) * 32 + (swz % 64) / 2; }
__host__ __device__ __forceinline__ int perm32(int rho) { const int n = rho >> 4, i = rho & 15; return 8 * (i >> 2) + 4 * n + (i & 3); }

struct Unit { int pm, pn, row0, e, ord; };

__device__ __forceinline__ unsigned cvt_pk_bf16(float lo, float hi) { unsigned r; asm volatile("v_cvt_pk_bf16_f32 %0, %1, %2" : "=v"(r) : "v"(lo), "v"(hi)); return r; }
__device__ __forceinline__ f32x2 gelu_pk(f32x2 v) {
    const f32x2 av = __builtin_elementwise_abs(v), d = av * 0.2316418882f + 1.0f;
    f32x2 t; t.x = __builtin_amdgcn_rcpf(d.x); t.y = __builtin_amdgcn_rcpf(d.y);
    f32x2 q = t * 0.5307027145f + (-0.7265760135f); q = q * t + 0.7107068705f; q = q * t + (-0.142248368f); q = q * t + 0.127414796f; q = q * t;
    const f32x2 s = (v * v) * (-0.72134752044f);
    f32x2 e; e.x = __builtin_amdgcn_exp2f(s.x); e.y = __builtin_amdgcn_exp2f(s.y);
    const f32x2 m = v * (q * e), r = v - m;
    f32x2 o; o.x = v.x < 0.f ? m.x : r.x; o.y = v.y < 0.f ? m.y : r.y; return o;
}
template <int ACT> struct EpiBf16 {
    static constexpr bool PERM = true;
    bf16_t* O; int ldc; const float* bias; int split_cols; size_t split_stride;
    __device__ __forceinline__ void operator()(const f32x4 (&acc)[2][2][4][2], const Unit& u, int wr, int wc, int fr, int fq) const {
        const int row0 = u.pm * BM + wr * 64 + fr; int colt = u.pn * BM; bf16_t* base = O;
        if (split_cols) { const int t = colt / split_cols; base += (size_t)t * split_stride; colt -= t * split_cols; }
        const int col0 = colt + wc * 32 + 8 * fq, bcol0 = u.pn * BM + wc * 32 + 8 * fq;
        f32x4 bv[2][2];
#pragma unroll
        for (int bj = 0; bj < 2; ++bj)
#pragma unroll
            for (int n = 0; n < 2; ++n) bv[bj][n] = bias ? *(const f32x4*)(bias + bcol0 + bj * HALF + 4 * n) : (f32x4){0.f, 0.f, 0.f, 0.f};
#pragma unroll
        for (int ai = 0; ai < 2; ++ai)
#pragma unroll
            for (int m = 0; m < 4; ++m) { bf16_t* rowp = base + (size_t)(row0 + ai * HALF + m * 16) * ldc + col0;
#pragma unroll
                for (int bj = 0; bj < 2; ++bj) { f32x4 v0 = acc[ai][bj][m][0] + bv[bj][0], v1 = acc[ai][bj][m][1] + bv[bj][1];
                    if (ACT == 1) { f32x2 a = gelu_pk((f32x2){v0[0], v0[1]}), b = gelu_pk((f32x2){v0[2], v0[3]}), c = gelu_pk((f32x2){v1[0], v1[1]}), d = gelu_pk((f32x2){v1[2], v1[3]});
                        v0 = (f32x4){a.x, a.y, b.x, b.y}; v1 = (f32x4){c.x, c.y, d.x, d.y}; }
                    u32x4 w; w.x = cvt_pk_bf16(v0[0], v0[1]); w.y = cvt_pk_bf16(v0[2], v0[3]); w.z = cvt_pk_bf16(v1[0], v1[1]); w.w = cvt_pk_bf16(v1[2], v1[3]);
                    *(u32x4*)(rowp + bj * HALF) = w; } }
    }
};
struct EpiSguIn {
    static constexpr bool PERM = true;
    bf16_t* U; bf16_t* VB; const float* bias; float* vsum;
    __device__ __forceinline__ void operator()(const f32x4 (&acc)[2][2][4][2], const Unit& u, int wr, int wc, int fr, int fq) const {
        const int row0 = u.pm * BM + wr * 64 + fr, colt = u.pn * BM; const bool gate = colt >= SGU_DFF;
        bf16_t* base = gate ? VB : U; const int col0 = (gate ? colt - SGU_DFF : colt) + wc * 32 + 8 * fq, bcol0 = colt + wc * 32 + 8 * fq;
        f32x4 bv[2][2];
#pragma unroll
        for (int bj = 0; bj < 2; ++bj)
#pragma unroll
            for (int n = 0; n < 2; ++n) bv[bj][n] = *(const f32x4*)(bias + bcol0 + bj * HALF + 4 * n);
#pragma unroll
        for (int ai = 0; ai < 2; ++ai)
#pragma unroll
            for (int m = 0; m < 4; ++m) { const int r = row0 + ai * HALF + m * 16; bf16_t* rowp = base + (size_t)r * SGU_DFF + col0; float s1 = 0.f, s2 = 0.f;
#pragma unroll
                for (int bj = 0; bj < 2; ++bj) { f32x4 v0 = acc[ai][bj][m][0] + bv[bj][0], v1 = acc[ai][bj][m][1] + bv[bj][1];
                    const f32x2 a = gelu_pk((f32x2){v0[0], v0[1]}), b = gelu_pk((f32x2){v0[2], v0[3]}), c = gelu_pk((f32x2){v1[0], v1[1]}), d = gelu_pk((f32x2){v1[2], v1[3]});
                    u32x4 w; w.x = cvt_pk_bf16(a.x, a.y); w.y = cvt_pk_bf16(b.x, b.y); w.z = cvt_pk_bf16(c.x, c.y); w.w = cvt_pk_bf16(d.x, d.y);
                    *(u32x4*)(rowp + bj * HALF) = w;
                    if (gate) { s1 += (a.x + a.y) + (b.x + b.y) + (c.x + c.y) + (d.x + d.y); s2 += (a.x * a.x + a.y * a.y) + (b.x * b.x + b.y * b.y) + (c.x * c.x + c.y * c.y) + (d.x * d.x + d.y * d.y); } }
                if (gate) { s1 += __shfl_xor(s1, 16); s1 += __shfl_xor(s1, 32); s2 += __shfl_xor(s2, 16); s2 += __shfl_xor(s2, 32);
                    if (fq == 0) { atomicAdd(vsum + 2 * r, s1); atomicAdd(vsum + 2 * r + 1, s2); } } }
    }
};
struct EpiF32 {
    static constexpr bool PERM = false;
    float* C; int ldc;
    __device__ __forceinline__ void operator()(const f32x4 (&acc)[2][2][4][2], const Unit& u, int wr, int wc, int fr, int fq) const {
        const int row0 = u.pm * BM + wr * 64 + fr, col0 = u.pn * BM + wc * 32 + 4 * fq;
#pragma unroll
        for (int ai = 0; ai < 2; ++ai)
#pragma unroll
            for (int m = 0; m < 4; ++m) { float* rowp = C + (size_t)(row0 + ai * HALF + m * 16) * ldc + col0;
#pragma unroll
                for (int bj = 0; bj < 2; ++bj)
#pragma unroll
                    for (int n = 0; n < 2; ++n) *(f32x4*)(rowp + bj * HALF + n * 16) = acc[ai][bj][m][n]; }
    }
};
struct EpiQKV {
    static constexpr bool PERM = true;
    bf16_t* Q; size_t stride; const float* rope; float qscale;
    __device__ __forceinline__ void operator()(const f32x4 (&acc)[2][2][4][2], const Unit& u, int wr, int wc, int fr, int fq) const {
        const int row0 = u.pm * BM + wr * 64 + fr, colt = u.pn * BM, t = colt >> 10, cbase = colt & 1023;
        bf16_t* base = Q + (size_t)t * stride;
        const bool do_rope = (t < 2) && ((u.pm % 33) != 32);
        const float sc = (t == 0) ? qscale : 1.f;
        const float sgn = (fq < 2) ? -1.f : 1.f;
        const bool lowhalf = (fq < 2);
#pragma unroll
        for (int ai = 0; ai < 2; ++ai)
#pragma unroll
            for (int m = 0; m < 4; ++m) {
                const int r = row0 + ai * HALF + m * 16, nseq = r % SEQA;
                const int pos = (wc & 1) ? (nseq & 63) : (nseq >> 6);
                f32x4 cs[4];
                if (do_rope) { const f32x4* rp = (const f32x4*)(rope + (pos * 16 + 8 * (fq & 1)) * 2);
#pragma unroll
                    for (int q4 = 0; q4 < 4; ++q4) cs[q4] = rp[q4]; }
                const int bq = r / SEQA, hd0 = cbase >> 7;
                bf16_t* rowp = (t == 0) ? base + (size_t)r * D + cbase + wc * 32 + 8 * fq : base + ((size_t)(bq * NH + hd0) * SEQA + nseq) * 128 + wc * 32 + 8 * fq;
                const size_t bjstep = (t == 0) ? (size_t)HALF : (size_t)SEQA * 128;
#pragma unroll
                for (int bj = 0; bj < 2; ++bj) {
                    float v[8];
#pragma unroll
                    for (int n = 0; n < 2; ++n)
#pragma unroll
                        for (int j = 0; j < 4; ++j) v[n * 4 + j] = acc[ai][bj][m][n][j];
                    if (do_rope) {
#pragma unroll
                        for (int i = 0; i < 8; ++i) {
                            const unsigned xb = __builtin_bit_cast(unsigned, v[i]);
                            auto rr = __builtin_amdgcn_permlane32_swap(xb, xb, false, false);
                            const float partner = __builtin_bit_cast(float, lowhalf ? rr[1] : rr[0]);
                            const float c = cs[i >> 1][(i & 1) * 2], s = cs[i >> 1][(i & 1) * 2 + 1];
                            v[i] = v[i] * c + sgn * partner * s;
                        }
                    }
                    u32x4 w; w.x = cvt_pk_bf16(v[0] * sc, v[1] * sc); w.y = cvt_pk_bf16(v[2] * sc, v[3] * sc); w.z = cvt_pk_bf16(v[4] * sc, v[5] * sc); w.w = cvt_pk_bf16(v[6] * sc, v[7] * sc);
                    *(u32x4*)(rowp + bj * bjstep) = w;
                }
            }
    }
};
template <int MAXU> struct EpiMoeUp {
    static constexpr bool PERM = true;
    bf16_t* HS; const LAS float* wtab;
    __device__ __forceinline__ void operator()(const f32x4 (&acc)[2][2][4][2], const Unit& u, int wr, int wc, int fr, int fq) const {
#pragma unroll
        for (int ai = 0; ai < 2; ++ai)
#pragma unroll
            for (int m = 0; m < 4; ++m) {
                const int rr = ai * HALF + wr * 64 + m * 16 + fr;
                const float w = wtab[u.ord * 256 + rr];
                float h[8];
#pragma unroll
                for (int n = 0; n < 2; ++n)
#pragma unroll
                    for (int j = 0; j < 4; ++j) { const float g = acc[ai][0][m][n][j], up = acc[ai][1][m][n][j]; h[n * 4 + j] = w * up * g * __builtin_amdgcn_rcpf(1.f + __expf(-g)); }
                u32x4 o; o.x = cvt_pk_bf16(h[0], h[1]); o.y = cvt_pk_bf16(h[2], h[3]); o.z = cvt_pk_bf16(h[4], h[5]); o.w = cvt_pk_bf16(h[6], h[7]);
                *(u32x4*)(HS + (size_t)(u.row0 + rr) * EDFF + u.pn * 128 + wc * 32 + 8 * fq) = o;
            }
    }
};
struct EpiSharedUp {
    static constexpr bool PERM = true;
    bf16_t* HS;
    __device__ __forceinline__ void operator()(const f32x4 (&acc)[2][2][4][2], const Unit& u, int wr, int wc, int fr, int fq) const {
#pragma unroll
        for (int ai = 0; ai < 2; ++ai)
#pragma unroll
            for (int m = 0; m < 4; ++m) {
                const int rr = u.pm * BM + ai * HALF + wr * 64 + m * 16 + fr;
                float h[8];
#pragma unroll
                for (int n = 0; n < 2; ++n)
#pragma unroll
                    for (int j = 0; j < 4; ++j) { const float g = acc[ai][0][m][n][j], up = acc[ai][1][m][n][j]; h[n * 4 + j] = up * g * __builtin_amdgcn_rcpf(1.f + __expf(-g)); }
                u32x4 o; o.x = cvt_pk_bf16(h[0], h[1]); o.y = cvt_pk_bf16(h[2], h[3]); o.z = cvt_pk_bf16(h[4], h[5]); o.w = cvt_pk_bf16(h[6], h[7]);
                *(u32x4*)(HS + (size_t)(PMAX + rr) * EDFF + u.pn * 128 + wc * 32 + 8 * fq) = o;
            }
    }
};
template <int MAXU> struct EpiMoeDown {
    static constexpr bool PERM = true;
    bf16_t* HO; const LAS int* ptab;
    __device__ __forceinline__ void operator()(const f32x4 (&acc)[2][2][4][2], const Unit& u, int wr, int wc, int fr, int fq) const {
#pragma unroll
        for (int ai = 0; ai < 2; ++ai)
#pragma unroll
            for (int m = 0; m < 4; ++m) {
                const int rr = ai * HALF + wr * 64 + m * 16 + fr;
                int p = ptab[u.ord * 256 + rr]; p = p < 0 ? (TK + T) : p;
                bf16_t* rowp = HO + (size_t)p * D + u.pn * BM + wc * 32 + 8 * fq;
#pragma unroll
                for (int bj = 0; bj < 2; ++bj) { const f32x4 v0 = acc[ai][bj][m][0], v1 = acc[ai][bj][m][1];
                    u32x4 o; o.x = cvt_pk_bf16(v0[0], v0[1]); o.y = cvt_pk_bf16(v0[2], v0[3]); o.z = cvt_pk_bf16(v1[0], v1[1]); o.w = cvt_pk_bf16(v1[2], v1[3]);
                    *(u32x4*)(rowp + bj * HALF) = o; }
            }
    }
};

struct DenseSched {
    const char* A; const char* Bt; int K, lda, nM, nN, nwg, G, c;
    __device__ __forceinline__ void init(const void* A_, const void* Bt_, int M, int N, int K_, int G_, int c_, int lda_ = 0) { A = (const char*)A_; Bt = (const char*)Bt_; K = K_; lda = lda_ ? lda_ : K_; nM = M / BM; nN = N / BM; nwg = nM * nN; G = G_; c = c_; }
    __device__ __forceinline__ bool next(int i, Unit& u) const {
        const long L = (long)i * G + c; if (L >= nwg) return false;
        int wgid = (int)L; { const int q = nwg / NXCD, r = nwg % NXCD, xcd = wgid % NXCD, off = wgid / NXCD; wgid = (xcd < r ? xcd * (q + 1) : r * (q + 1) + (xcd - r) * q) + off; }
        const int nig = WGM * nN, gid = wgid / nig, fm = gid * WGM, gsz = (nM - fm) < WGM ? (nM - fm) : WGM;
        u.pm = fm + ((wgid % nig) % gsz); u.pn = (wgid % nig) / gsz; u.row0 = 0; u.e = 0; u.ord = i; return true;
    }
    __device__ __forceinline__ const char* a_base() const { return A; }
    __device__ __forceinline__ unsigned a_off(const Unit& u, int h, int R, int C) const { return (unsigned)(((u.pm * BM + h * HALF + R) * lda + C) * 2); }
    __device__ __forceinline__ const char* b_base(const Unit& u) const { return Bt + (size_t)u.pn * BM * K * 2; }
};
template <bool GATHER, int MAXU> struct MoeSched {
    const char* A; const char* Bexp; const char* Bsh; size_t b_estride; int K, lda, NPN, x, r, W, nsh;
    const LAS int* ps; const LAS int* xps; const LAS int* ptab;
    __device__ __forceinline__ bool next_any(int i, Unit& u) const {
        const int uu = i * W + r, nrt = __builtin_amdgcn_readfirstlane(xps[32]), tot = (nrt + nsh) * NPN; if (uu >= tot) return false;
        const int rtl = uu / NPN; u.pn = uu % NPN; u.pm = 0; u.ord = i;
        if (rtl < nrt) { int a = 0, b = 32; while (b - a > 1) { const int mid = (a + b) >> 1; if (__builtin_amdgcn_readfirstlane(xps[mid]) <= rtl) a = mid; else b = mid; }
            u.e = x + 8 * a; u.row0 = __builtin_amdgcn_readfirstlane(ps[u.e]) + (rtl - __builtin_amdgcn_readfirstlane(xps[a])) * BM; }
        else { u.e = NE; u.row0 = PMAX + (x * 16 + (rtl - nrt)) * BM; }
        return true;
    }
    __device__ __forceinline__ bool next(int i, Unit& u) const { return i < MAXU && next_any(i, u); }
    __device__ __forceinline__ const char* a_base() const { return A; }
    __device__ __forceinline__ unsigned a_off(const Unit& u, int h, int R, int C) const {
        const int row = h * HALF + R;
        if (GATHER) { const int p = ptab[u.ord * 256 + row]; const int tok = p < 0 ? 0 : (p < TK ? (p >> 3) : (p - TK)); return (unsigned)((tok * lda + C) * 2); }
        else return (unsigned)(((u.row0 + row) * lda + C) * 2);
    }
    __device__ __forceinline__ const char* b_base(const Unit& u) const { return (u.e < NE ? Bexp + (size_t)u.e * b_estride : Bsh) + (size_t)u.pn * BM * K * 2; }
};

template <class Epi, class Sched, bool ALIGN_EPI, int AWRAP = 0>
__device__ __forceinline__ void gemm_phase(LAS unsigned char* lds, const int K, const Sched& S, const Epi& E) {
    const int tid = threadIdx.x, wid = __builtin_amdgcn_readfirstlane(tid >> 6), lane = tid & 63, wr = wid >> 2, wc = wid & 3, fr = lane & 15, fq = lane >> 4;
    const int nt = K / BK;
    int sR[2], sC[2]; unsigned voffB[2];
#pragma unroll
    for (int i = 0; i < 2; ++i) { int R, C; stage_rc(tid * 16 + i * 8192, R, C); sR[i] = R; sC[i] = C; const int Rb = Epi::PERM ? ((R & ~31) + perm32(R & 31)) : R; voffB[i] = (unsigned)(Rb * K + C) * 2u; }
    const size_t kstep = (size_t)(BK * 2);
    const size_t hstep = (size_t)HALF * K * 2;
    const unsigned ldsw = (unsigned)wid * 1024u;
    const int aoff = lds_byte(wr * 64 + fr, fq * 8), boff = lds_byte(wc * 32 + fr, fq * 8);
#define PG8_SA(b, h) (((b) * 2 + (h)) * HTB)
#define PG8_SB(b, h) ((4 + (b) * 2 + (h)) * HTB)
#define PG8_STAGE(bufoff, gbase, voff) do { _Pragma("unroll") for (int _i = 0; _i < 2; ++_i) \
        __builtin_amdgcn_global_load_lds((const unsigned*)((const char*)(gbase) + (voff)[_i]), (LAS unsigned*)(lds + (bufoff) + ldsw + _i * 8192), 16, 0, 0); } while (0)
#define PG8_LDA(dst, b, h) do { _Pragma("unroll") for (int m = 0; m < 4; ++m) _Pragma("unroll") for (int k = 0; k < 2; ++k) dst[m][k] = *(const LAS bf16x8*)(lds + PG8_SA(b, h) + aoff + m * 2048 + k * 1024); } while (0)
#define PG8_LDB(dst, b, h) do { _Pragma("unroll") for (int n = 0; n < 2; ++n) _Pragma("unroll") for (int k = 0; k < 2; ++k) dst[n][k] = *(const LAS bf16x8*)(lds + PG8_SB(b, h) + boff + n * 2048 + k * 1024); } while (0)
#define PG8_MMA(ai, bj, At, Bt) do { __builtin_amdgcn_s_setprio(1); _Pragma("unroll") for (int m = 0; m < 4; ++m) _Pragma("unroll") for (int n = 0; n < 2; ++n) _Pragma("unroll") for (int k = 0; k < 2; ++k) \
        acc[ai][bj][m][n] = __builtin_amdgcn_mfma_f32_16x16x32_bf16(Bt[n][k], At[m][k], acc[ai][bj][m][n], 0, 0, 0); __builtin_amdgcn_s_setprio(0); } while (0)
#define PG8_WAIT_V(n) asm volatile("s_waitcnt vmcnt(" #n ")" ::: "memory")
#define PG8_WAIT_L(n) asm volatile("s_waitcnt lgkmcnt(" #n ")" ::: "memory")
#define PG8_BAR __builtin_amdgcn_s_barrier()
#define PG8_SCHED __builtin_amdgcn_sched_barrier(0)
    Unit cur, nxt; int ui = 0;
    if (!S.next(0, cur)) return;
    f32x4 acc[2][2][4][2];
#pragma unroll
    for (int a = 0; a < 2; ++a)
#pragma unroll
        for (int b = 0; b < 2; ++b)
#pragma unroll
            for (int m = 0; m < 4; ++m)
#pragma unroll
                for (int n = 0; n < 2; ++n) acc[a][b][m][n] = (f32x4){0.f, 0.f, 0.f, 0.f};
    bf16x8 At[4][2], B0[2][2], B1[2][2];
    unsigned cao[2][2], nao[2][2];
#pragma unroll
    for (int h = 0; h < 2; ++h)
#pragma unroll
        for (int i = 0; i < 2; ++i) cao[h][i] = S.a_off(cur, h, sR[i], sC[i]);
    const char* const Ab = S.a_base();
    const char* cB = S.b_base(cur);
    PG8_STAGE(PG8_SB(0, 0), cB, voffB); PG8_STAGE(PG8_SB(0, 1), cB + hstep, voffB); PG8_STAGE(PG8_SA(0, 0), Ab, cao[0]); PG8_STAGE(PG8_SA(0, 1), Ab, cao[1]);
    if (wr == 1) PG8_BAR;
    PG8_WAIT_V(2); PG8_BAR;
    PG8_STAGE(PG8_SB(1, 0), cB + kstep, voffB); PG8_STAGE(PG8_SA(1, 0), Ab + kstep, cao[0]); PG8_STAGE(PG8_SB(1, 1), cB + hstep + kstep, voffB);
    PG8_WAIT_V(6); PG8_BAR;
    for (;;) {
        const bool has_next = S.next(ui + 1, nxt);
        const char* nB = has_next ? S.b_base(nxt) : cB;
#pragma unroll
        for (int h = 0; h < 2; ++h)
#pragma unroll
            for (int i = 0; i < 2; ++i) nao[h][i] = has_next ? S.a_off(nxt, h, sR[i], sC[i]) : cao[h][i];
#pragma nounroll
        for (int t = 0; t < nt; t += 2) {
            const bool last = (t == nt - 2);
            const int ta1 = AWRAP ? (t + 1) % AWRAP : (t + 1), ta2 = AWRAP ? (t + 2) % AWRAP : (t + 2);
            const char* a1 = Ab + (size_t)ta1 * kstep;
            const char* a2 = last ? Ab : Ab + (size_t)ta2 * kstep; const char* b2 = last ? nB : cB + (size_t)(t + 2) * kstep;
            const char* a3 = a2 + kstep; const char* b3 = b2 + kstep;
            unsigned o2[2][2];
#pragma unroll
            for (int h = 0; h < 2; ++h)
#pragma unroll
                for (int i = 0; i < 2; ++i) o2[h][i] = last ? nao[h][i] : cao[h][i];
            PG8_LDB(B0, 0, 0); PG8_LDB(B1, 0, 1); PG8_SCHED; PG8_LDA(At, 0, 0); PG8_STAGE(PG8_SA(1, 1), a1, cao[1]);
            PG8_WAIT_V(8); PG8_WAIT_L(0); PG8_BAR; PG8_MMA(0, 0, At, B0); PG8_MMA(0, 1, At, B1); PG8_BAR; PG8_SCHED;
            PG8_LDA(At, 0, 1); PG8_STAGE(PG8_SB(0, 0), b2, voffB); PG8_STAGE(PG8_SB(0, 1), b2 + hstep, voffB); PG8_STAGE(PG8_SA(0, 0), a2, o2[0]);
            PG8_WAIT_V(8); PG8_WAIT_L(0); PG8_BAR; PG8_MMA(1, 0, At, B0); PG8_MMA(1, 1, At, B1); PG8_BAR; PG8_SCHED;
            PG8_LDB(B0, 1, 0); PG8_LDB(B1, 1, 1); PG8_SCHED; PG8_LDA(At, 1, 0); PG8_STAGE(PG8_SA(0, 1), a2, o2[1]);
            PG8_WAIT_V(8); PG8_WAIT_L(0); PG8_BAR; PG8_MMA(0, 0, At, B0); PG8_MMA(0, 1, At, B1); PG8_BAR; PG8_SCHED;
            PG8_LDA(At, 1, 1); PG8_STAGE(PG8_SB(1, 0), b3, voffB); PG8_STAGE(PG8_SB(1, 1), b3 + hstep, voffB); PG8_STAGE(PG8_SA(1, 0), a3, o2[0]);
            PG8_WAIT_V(8); PG8_WAIT_L(0); PG8_BAR; PG8_MMA(1, 0, At, B0); PG8_MMA(1, 1, At, B1); PG8_BAR; PG8_SCHED;
        }
        if constexpr (ALIGN_EPI) { if (wr == 0) PG8_BAR; }
        E(acc, cur, wr, wc, fr, fq);
        if (!has_next) break;
#pragma unroll
        for (int a = 0; a < 2; ++a)
#pragma unroll
            for (int b = 0; b < 2; ++b)
#pragma unroll
                for (int m = 0; m < 4; ++m)
#pragma unroll
                    for (int n = 0; n < 2; ++n) acc[a][b][m][n] = (f32x4){0.f, 0.f, 0.f, 0.f};
        cur = nxt; cB = nB; ++ui;
#pragma unroll
        for (int h = 0; h < 2; ++h)
#pragma unroll
            for (int i = 0; i < 2; ++i) cao[h][i] = nao[h][i];
        if constexpr (ALIGN_EPI) { if (wr == 1) PG8_BAR; }
    }
    PG8_WAIT_V(0);
    if constexpr (!ALIGN_EPI) { if (wr == 0) PG8_BAR; }
    PG8_BAR;
#undef PG8_SA
#undef PG8_SB
#undef PG8_STAGE
#undef PG8_LDA
#undef PG8_LDB
#undef PG8_MMA
#undef PG8_WAIT_V
#undef PG8_WAIT_L
#undef PG8_BAR
#undef PG8_SCHED
}
}

namespace att {
using bf16x8 = __attribute__((ext_vector_type(8))) short;
using s16x4  = __attribute__((ext_vector_type(4))) short;
using f32x16 = __attribute__((ext_vector_type(16))) float;
constexpr int QBLK = 32, KVBLK = 64, UNIT_ROWS = 128, LDR = D, LDKV = 128;
constexpr float SCALE = 0.125f;
constexpr float THR = 8.f;
constexpr size_t SHM_V = KVBLK * 128 * 2, SHM_K = KVBLK * 128 * 2, SHM_ATTN = 2 * SHM_V + 2 * SHM_K + 8 * 64 * 4;
#define KSWZ(row, colB) ((row) * 256 + ((colB) ^ (((row) & 7) << 4)))
#define SBAR() __builtin_amdgcn_sched_barrier(0)
__device__ __forceinline__ int crow(int r, int hi) { return (r & 3) + 8 * (r >> 2) + 4 * hi; }
__device__ __forceinline__ unsigned cvtpk(float lo, float hi) { unsigned r; asm volatile("v_cvt_pk_bf16_f32 %0, %1, %2" : "=v"(r) : "v"(lo), "v"(hi)); return r; }

__device__ __forceinline__ void partialSM(f32x16& p0, f32x16& p1, float& m_reg, float& mn, float& alpha) {
  constexpr float C = SCALE * 1.4426950408889634f;
  float mx0 = fmaxf(p0[0], p0[1]), mx1 = fmaxf(p0[2], p0[3]), mx2 = fmaxf(p1[0], p1[1]), mx3 = fmaxf(p1[2], p1[3]);
#pragma unroll
  for (int r = 4; r < 16; r += 4) { mx0 = fmaxf(fmaxf(mx0, p0[r]), p0[r + 1]); mx1 = fmaxf(fmaxf(mx1, p0[r + 2]), p0[r + 3]); mx2 = fmaxf(fmaxf(mx2, p1[r]), p1[r + 1]); mx3 = fmaxf(fmaxf(mx3, p1[r + 2]), p1[r + 3]); }
  float pmax = fmaxf(fmaxf(mx0, mx1), fmaxf(mx2, mx3));
  { auto rr = __builtin_amdgcn_permlane32_swap(__float_as_uint(pmax), __float_as_uint(pmax), false, false);
    pmax = fmaxf(__uint_as_float(rr[0]), __uint_as_float(rr[1])); }
  if (__builtin_expect(__all(pmax - m_reg <= THR / SCALE), 1)) { mn = m_reg; alpha = 1.f; }
  else { mn = fmaxf(m_reg, pmax); alpha = __builtin_amdgcn_exp2f((m_reg - mn) * C); m_reg = mn; }
  float mnC = -mn * C;
  for (int r = 0; r < 16; ++r) p0[r] = fmaf(p0[r], C, mnC); for (int r = 0; r < 16; ++r) p1[r] = fmaf(p1[r], C, mnC);
  for (int r = 0; r < 16; ++r) p0[r] = __builtin_amdgcn_exp2f(p0[r]);
}
__device__ __forceinline__ void finishSM(f32x16& p0, f32x16& p1, float alpha, float& l_reg, bf16x8& pa0, bf16x8& pa1, bf16x8& pa2, bf16x8& pa3) {
  for (int r = 0; r < 16; ++r) p1[r] = __builtin_amdgcn_exp2f(p1[r]);
  float s0 = p0[0] + p0[1], s1 = p0[2] + p0[3], s2 = p1[0] + p1[1], s3 = p1[2] + p1[3];
#pragma unroll
  for (int r = 4; r < 16; r += 4) { s0 += p0[r]; s1 += p0[r + 2]; s2 += p1[r]; s3 += p1[r + 2]; s0 += p0[r + 1]; s1 += p0[r + 3]; s2 += p1[r + 1]; s3 += p1[r + 3]; }
  float ps = (s0 + s1) + (s2 + s3);
  { auto rr = __builtin_amdgcn_permlane32_swap(__float_as_uint(ps), __float_as_uint(ps), false, false);
    ps = __uint_as_float(rr[0]) + __uint_as_float(rr[1]); }
  l_reg = l_reg * alpha + ps;
#define PK4(P, BASE, OUT) do { unsigned a0 = cvtpk(P[BASE + 0], P[BASE + 1]), a1 = cvtpk(P[BASE + 2], P[BASE + 3]);   \
    unsigned b0 = cvtpk(P[BASE + 4], P[BASE + 5]), b1 = cvtpk(P[BASE + 6], P[BASE + 7]);                              \
    auto r0 = __builtin_amdgcn_permlane32_swap(a0, b0, false, false); auto r1 = __builtin_amdgcn_permlane32_swap(a1, b1, false, false); \
    u32x4 w = {r0[0], r1[0], r0[1], r1[1]}; OUT = *reinterpret_cast<bf16x8*>(&w); } while (0)
  PK4(p0, 0, pa0); PK4(p0, 8, pa1); PK4(p1, 0, pa2); PK4(p1, 8, pa3);
#undef PK4
}
__device__ __forceinline__ void qkt(f32x16& p0, f32x16& p1, const bf16_t* Ks, const bf16x8* qr, int r32, int hi, int mp, const f32x16& negm) {
#pragma unroll
  for (int d0 = 0; d0 < 4; ++d0) { int cb = ((mp * 4 + d0) * 16 + hi * 8) * 2;
    bf16x8 b0 = *reinterpret_cast<const bf16x8*>((const char*)Ks + KSWZ(r32, cb));
    bf16x8 b1 = *reinterpret_cast<const bf16x8*>((const char*)Ks + KSWZ(32 + r32, cb));
    if (d0 == 0) { p0 = __builtin_amdgcn_mfma_f32_32x32x16_bf16(b0, qr[0], negm, 0, 0, 0); p1 = __builtin_amdgcn_mfma_f32_32x32x16_bf16(b1, qr[0], negm, 0, 0, 0); }
    else { p0 = __builtin_amdgcn_mfma_f32_32x32x16_bf16(b0, qr[d0], p0, 0, 0, 0); p1 = __builtin_amdgcn_mfma_f32_32x32x16_bf16(b1, qr[d0], p1, 0, 0, 0); } }
}
__device__ __forceinline__ int v_st(int k, int c) { const int kk = (k & ~0xC) | ((k & 4) << 1) | ((k & 8) >> 1); return ((kk >> 3) * 4 + (c >> 5)) * 512 + ((kk & 7) * 32 + (c & 31)) * 2; }
__device__ __forceinline__ int v_rd_base(int lane) { return ((lane & 3) << 3) | (((lane >> 2) & 3) << 6) | (((lane >> 4) & 1) << 5) | (((lane >> 5) & 1) << 8); }
constexpr int v_rd_off(int d0, int ks, int half) { return d0 * 512 + ks * 4096 + half * 2048; }
template <int OFF> __device__ __forceinline__ s16x4 tr_read(int vb) {
  s16x4 r; asm volatile("ds_read_b64_tr_b16 %0, %1 offset:%2" : "=&v"(r) : "v"(vb), "i"(OFF) : "memory"); return r;
}
template <int D0> __device__ __forceinline__ void pv_one(f32x16& od, int vb, bf16x8 pa0, bf16x8 pa1, bf16x8 pa2, bf16x8 pa3) {
  const s16x4 l0 = tr_read<v_rd_off(D0, 0, 0)>(vb), h0 = tr_read<v_rd_off(D0, 0, 1)>(vb), l1 = tr_read<v_rd_off(D0, 1, 0)>(vb), h1 = tr_read<v_rd_off(D0, 1, 1)>(vb);
  const s16x4 l2 = tr_read<v_rd_off(D0, 2, 0)>(vb), h2 = tr_read<v_rd_off(D0, 2, 1)>(vb), l3 = tr_read<v_rd_off(D0, 3, 0)>(vb), h3 = tr_read<v_rd_off(D0, 3, 1)>(vb);
  asm volatile("s_waitcnt lgkmcnt(0)" ::: "memory"); SBAR();
#define PK(L, H) (bf16x8){L[0], L[1], L[2], L[3], H[0], H[1], H[2], H[3]}
  od = __builtin_amdgcn_mfma_f32_32x32x16_bf16(pa0, PK(l0, h0), od, 0, 0, 0);
  od = __builtin_amdgcn_mfma_f32_32x32x16_bf16(pa1, PK(l1, h1), od, 0, 0, 0);
  od = __builtin_amdgcn_mfma_f32_32x32x16_bf16(pa2, PK(l2, h2), od, 0, 0, 0);
  od = __builtin_amdgcn_mfma_f32_32x32x16_bf16(pa3, PK(l3, h3), od, 0, 0, 0);
#undef PK
}
__device__ __forceinline__ void pv_d0(f32x16* o, int vb, bf16x8 pa0, bf16x8 pa1, bf16x8 pa2, bf16x8 pa3) {
  pv_one<0>(o[0], vb, pa0, pa1, pa2, pa3); pv_one<1>(o[1], vb, pa0, pa1, pa2, pa3); pv_one<2>(o[2], vb, pa0, pa1, pa2, pa3); pv_one<3>(o[3], vb, pa0, pa1, pa2, pa3);
}

#define TRD(dst, OFF) asm volatile("ds_read_b64_tr_b16 %0, %1 offset:%2" : "=&v"(dst) : "v"(vb), "i"(OFF) : "memory")
#define ISSUE_V(B, D0) do { TRD(vl[B][0], v_rd_off(D0, 0, 0)); TRD(vh[B][0], v_rd_off(D0, 0, 1)); TRD(vl[B][1], v_rd_off(D0, 1, 0)); TRD(vh[B][1], v_rd_off(D0, 1, 1)); \
                            TRD(vl[B][2], v_rd_off(D0, 2, 0)); TRD(vh[B][2], v_rd_off(D0, 2, 1)); TRD(vl[B][3], v_rd_off(D0, 3, 0)); TRD(vh[B][3], v_rd_off(D0, 3, 1)); } while (0)
#define ISSUE_K() do { _Pragma("unroll") for (int d0 = 0; d0 < 4; ++d0) { asm volatile("ds_read_b128 %0, %1" : "=&v"(kf0[d0]) : "v"(ka[d0]) : "memory"); \
                                                                          asm volatile("ds_read_b128 %0, %1 offset:8192" : "=&v"(kf1[d0]) : "v"(ka[d0]) : "memory"); } } while (0)
#define LWAIT(n) do { asm volatile("s_waitcnt lgkmcnt(" #n ")" ::: "memory"); SBAR(); } while (0)
#define PKF(B, k) (bf16x8){vl[B][k][0], vl[B][k][1], vl[B][k][2], vl[B][k][3], vh[B][k][0], vh[B][k][1], vh[B][k][2], vh[B][k][3]}
#define MFMA4(od, B) do { od = __builtin_amdgcn_mfma_f32_32x32x16_bf16(pa0, PKF(B, 0), od, 0, 0, 0); od = __builtin_amdgcn_mfma_f32_32x32x16_bf16(pa1, PKF(B, 1), od, 0, 0, 0); \
                          od = __builtin_amdgcn_mfma_f32_32x32x16_bf16(pa2, PKF(B, 2), od, 0, 0, 0); od = __builtin_amdgcn_mfma_f32_32x32x16_bf16(pa3, PKF(B, 3), od, 0, 0, 0); SBAR(); } while (0)
template <bool DO_PV, bool DO_QK>
__device__ __forceinline__ void mfma_block(f32x16 (&o)[4], f32x16& p0, f32x16& p1, int vb, const int (&ka)[4], bf16x8 pa0, bf16x8 pa1, bf16x8 pa2, bf16x8 pa3, const bf16x8 (&qr)[4], const f32x16& negm) {
  s16x4 vl[2][4], vh[2][4]; bf16x8 kf0[4], kf1[4];
  if (DO_PV) {
    ISSUE_V(0, 0);
    ISSUE_V(1, 1); LWAIT(8); MFMA4(o[0], 0);
    ISSUE_V(0, 2); LWAIT(8); MFMA4(o[1], 1);
    ISSUE_V(1, 3); LWAIT(8); MFMA4(o[2], 0);
    if (DO_QK) { ISSUE_K(); LWAIT(8); } else { LWAIT(0); }
    MFMA4(o[3], 1);
  } else if (DO_QK) { ISSUE_K(); }
  if (DO_QK) {
    LWAIT(0);
    p0 = __builtin_amdgcn_mfma_f32_32x32x16_bf16(kf0[0], qr[0], negm, 0, 0, 0); p1 = __builtin_amdgcn_mfma_f32_32x32x16_bf16(kf1[0], qr[0], negm, 0, 0, 0);
#pragma unroll
    for (int d0 = 1; d0 < 4; ++d0) { p0 = __builtin_amdgcn_mfma_f32_32x32x16_bf16(kf0[d0], qr[d0], p0, 0, 0, 0); p1 = __builtin_amdgcn_mfma_f32_32x32x16_bf16(kf1[d0], qr[d0], p1, 0, 0, 0); }
  }
}
#undef TRD
#undef ISSUE_V
#undef ISSUE_K
#undef LWAIT
#undef PKF
#undef MFMA4
constexpr float THRL = 8.f;
template <bool first>
__device__ __forceinline__ void softmax_tile(f32x16& p0, f32x16& p1, float& m_ref, float& l_reg, f32x16& negm, f32x16 (&o)[4], float* al_l, int r32, int hi,
                                             bf16x8& pa0, bf16x8& pa1, bf16x8& pa2, bf16x8& pa3) {
  float mx0 = fmaxf(p0[0], p0[1]), mx1 = fmaxf(p0[2], p0[3]), mx2 = fmaxf(p1[0], p1[1]), mx3 = fmaxf(p1[2], p1[3]);
#pragma unroll
  for (int r = 4; r < 16; r += 4) { mx0 = fmaxf(fmaxf(mx0, p0[r]), p0[r + 1]); mx1 = fmaxf(fmaxf(mx1, p0[r + 2]), p0[r + 3]); mx2 = fmaxf(fmaxf(mx2, p1[r]), p1[r + 1]); mx3 = fmaxf(fmaxf(mx3, p1[r + 2]), p1[r + 3]); }
  float rm = fmaxf(fmaxf(mx0, mx1), fmaxf(mx2, mx3));
  { auto rr = __builtin_amdgcn_permlane32_swap(__float_as_uint(rm), __float_as_uint(rm), false, false); rm = fmaxf(__uint_as_float(rr[0]), __uint_as_float(rr[1])); }
  if (first || __any(rm > THRL)) {
    const float dl = first ? rm : fmaxf(rm, 0.f);
    m_ref += dl;
#pragma unroll
    for (int r = 0; r < 16; ++r) { p0[r] -= dl; p1[r] -= dl; }
#pragma unroll
    for (int r = 0; r < 16; ++r) negm[r] = -m_ref;
    if (!first) {
      const float alpha = __builtin_amdgcn_exp2f(-dl); l_reg *= alpha;
      if (hi == 0) al_l[r32] = alpha; asm volatile("s_waitcnt lgkmcnt(0)" ::: "memory");
#pragma unroll
      for (int d = 0; d < 4; ++d)
#pragma unroll
        for (int r = 0; r < 16; ++r) o[d][r] *= al_l[crow(r, hi)];
    }
  }
#pragma unroll
  for (int r = 0; r < 16; ++r) { p0[r] = __builtin_amdgcn_exp2f(p0[r]); p1[r] = __builtin_amdgcn_exp2f(p1[r]); }
  float s0 = p0[0] + p0[1], s1 = p0[2] + p0[3], s2 = p1[0] + p1[1], s3 = p1[2] + p1[3];
#pragma unroll
  for (int r = 4; r < 16; r += 4) { s0 += p0[r]; s1 += p0[r + 2]; s2 += p1[r]; s3 += p1[r + 2]; s0 += p0[r + 1]; s1 += p0[r + 3]; s2 += p1[r + 1]; s3 += p1[r + 3]; }
  float ps = (s0 + s1) + (s2 + s3);
  { auto rr = __builtin_amdgcn_permlane32_swap(__float_as_uint(ps), __float_as_uint(ps), false, false); ps = __uint_as_float(rr[0]) + __uint_as_float(rr[1]); }
  l_reg += ps;
#define PK4(P, BASE, OUT) do { unsigned a0 = cvtpk(P[BASE + 0], P[BASE + 1]), a1 = cvtpk(P[BASE + 2], P[BASE + 3]);   \
    unsigned b0 = cvtpk(P[BASE + 4], P[BASE + 5]), b1 = cvtpk(P[BASE + 6], P[BASE + 7]);                              \
    auto r0 = __builtin_amdgcn_permlane32_swap(a0, b0, false, false); auto r1 = __builtin_amdgcn_permlane32_swap(a1, b1, false, false); \
    u32x4 w = {r0[0], r1[0], r0[1], r1[1]}; OUT = *reinterpret_cast<bf16x8*>(&w); } while (0)
  PK4(p0, 0, pa0); PK4(p0, 8, pa1); PK4(p1, 0, pa2); PK4(p1, 8, pa3);
#undef PK4
}
__device__ __forceinline__ void glds16(const void* gsrc, unsigned lds_dst) { unsigned keep;
  asm volatile("s_mov_b32 %0, m0\n\ts_mov_b32 m0, %2\n\ts_nop 0\n\tglobal_load_lds_dwordx4 %1, off\n\ts_mov_b32 m0, %0" : "=&s"(keep) : "v"(gsrc), "s"(lds_dst) : "memory"); }
constexpr int NSLOT = 4;
__device__ __forceinline__ void attn_unit(const bf16_t* __restrict__ Qb, const bf16_t* __restrict__ Kh, const bf16_t* __restrict__ Vh, bf16_t* __restrict__ Ob,
                                          float lam, const float* __restrict__ gsub, int seq, char* lds, char* wsl) {
  const int tid = threadIdx.x, wid = __builtin_amdgcn_readfirstlane(tid >> 6), lane = tid & 63, r32 = lane & 31, hi = lane >> 5, mp = wid >> 2, wq = wid & 3;
  bf16_t* V_lds = (bf16_t*)lds; bf16_t* K_lds = (bf16_t*)(lds + NSLOT * SHM_V);
  float* ws = (float*)wsl + wid * 64; float* li_l = ws; float* al_l = ws + 32;
  float m_reg = 0.f, l_reg = 0; f32x16 o[4] = {}; f32x16 negm = {}; bf16x8 qr[4];
  const bf16_t* Qw = Qb + (long)(wq * QBLK + r32) * LDR + mp * 64 + hi * 8;
#pragma unroll
  for (int d0 = 0; d0 < 4; ++d0) qr[d0] = *reinterpret_cast<const bf16x8*>(Qw + d0 * 16);
  const int vb0 = (int)(uintptr_t)V_lds + v_rd_base(lane);
  int koff[2], voff[2];
#pragma unroll
  for (int i = 0; i < 2; ++i) { const int p = (i * 8 + wid) * 1024 + lane * 16;
    { const int row = p >> 8, cp = (p & 255) >> 4, cc = cp ^ (row & 7); koff[i] = row * LDKV + cc * 8; }
    { const int st = p >> 9, q = p & 511, kk = (st >> 2) * 8 + (q >> 6), key = (kk & ~0xC) | ((kk & 4) << 1) | ((kk & 8) >> 1), col = (st & 3) * 32 + ((q & 63) >> 4) * 8; voff[i] = key * LDKV + col; } }
  const unsigned ldsV = (unsigned)(uintptr_t)V_lds + wid * 1024, ldsK = (unsigned)(uintptr_t)K_lds + wid * 1024;
#define DMA(t, slot) do { const bf16_t* kt_ = Kh + (long)(t) * KVBLK * LDKV; const bf16_t* vt_ = Vh + (long)(t) * KVBLK * LDKV; \
    glds16(kt_ + koff[0], (unsigned)__builtin_amdgcn_readfirstlane(ldsK + (slot) * SHM_K)); glds16(kt_ + koff[1], (unsigned)__builtin_amdgcn_readfirstlane(ldsK + (slot) * SHM_K + 8192)); \
    glds16(vt_ + voff[0], (unsigned)__builtin_amdgcn_readfirstlane(ldsV + (slot) * SHM_V)); glds16(vt_ + voff[1], (unsigned)__builtin_amdgcn_readfirstlane(ldsV + (slot) * SHM_V + 8192)); } while (0)
#define BAR_L() asm volatile("s_waitcnt lgkmcnt(0)\n\ts_barrier" ::: "memory")
#define BAR_V4() asm volatile("s_waitcnt vmcnt(4) lgkmcnt(0)\n\ts_barrier" ::: "memory")
#define BAR_V0() asm volatile("s_waitcnt vmcnt(0) lgkmcnt(0)\n\ts_barrier" ::: "memory")
  f32x16 p0, p1; bf16x8 pa0, pa1, pa2, pa3; const int NT = seq / KVBLK;
  asm volatile("s_waitcnt vmcnt(0)" ::: "memory");
  DMA(0, 0); DMA(1, 1); BAR_V4();
  int sK = 0, sV = NSLOT - 1, sD = 2;
#define STAGE(j) do { if ((j) + 2 < NT) DMA((j) + 2, sD); } while (0)
#define ENDBAR(j) do { if ((j) + 2 < NT) BAR_V4(); else BAR_V0(); } while (0)
#define ROT() do { sV = sK; sK = (sK == NSLOT - 1) ? 0 : sK + 1; sD = (sD == NSLOT - 1) ? 0 : sD + 1; } while (0)
#define MFMA_BLOCK(doPV, doQK, MP) do { if (doPV) pv_d0(o, vb0 + sV * (int)SHM_V, pa0, pa1, pa2, pa3); \
    if (doQK) qkt(p0, p1, (bf16_t*)((char*)K_lds + sK * SHM_K), qr, r32, hi, MP, negm); } while (0)
#define SMX(FIRST) softmax_tile<FIRST>(p0, p1, m_reg, l_reg, negm, o, al_l, r32, hi, pa0, pa1, pa2, pa3)
  if (mp == 0) {
    STAGE(0); MFMA_BLOCK(false, true, 0); BAR_L(); SMX(true); ENDBAR(0); ROT();
#pragma nounroll
    for (int j = 1; j < NT; ++j) { STAGE(j); MFMA_BLOCK(true, true, 0); BAR_L(); SMX(false); ENDBAR(j); ROT(); }
    MFMA_BLOCK(true, false, 0); BAR_L(); BAR_L();
  } else {
    STAGE(0); BAR_L(); MFMA_BLOCK(false, true, 1); ENDBAR(0); ROT();
    STAGE(1); SMX(true); BAR_L(); MFMA_BLOCK(true, true, 1); ENDBAR(1); ROT();
#pragma nounroll
    for (int j = 2; j < NT; ++j) { STAGE(j); SMX(false); BAR_L(); MFMA_BLOCK(true, true, 1); ENDBAR(j); ROT(); }
    SMX(false); BAR_L(); MFMA_BLOCK(true, false, 1); BAR_L();
  }
#undef DMA
#undef BAR_L
#undef BAR_V4
#undef BAR_V0
#undef STAGE
#undef ENDBAR
#undef ROT
#undef MFMA_BLOCK
#undef SMX
  int lane_e = lane; asm volatile("" : "+v"(lane_e));
  const int r32e = lane_e & 31, hie = lane_e >> 5;
  if (hie == 0) li_l[r32e] = l_reg; asm volatile("s_waitcnt lgkmcnt(0)" ::: "memory");
#pragma unroll
  for (int r = 0; r < 16; ++r) { const float rl = __builtin_amdgcn_rcpf(li_l[crow(r, hie)]);
#pragma unroll
    for (int d0 = 0; d0 < 4; ++d0) o[d0][r] *= rl; }
  __syncthreads();
  float* ex = (float*)lds + wq * 4096;
  if (mp == 1) {
#pragma unroll
    for (int d0 = 0; d0 < 4; ++d0)
#pragma unroll
      for (int r = 0; r < 16; ++r) ex[(d0 * 16 + r) * 64 + lane_e] = o[d0][r];
  }
  __syncthreads();
  if (mp == 0) {
    float gq[4];
#pragma unroll
    for (int d0 = 0; d0 < 4; ++d0) gq[d0] = gsub[d0 * 32 + r32e] * (1.f - LAM_INIT);
    bf16_t* Ow = Ob + (long)(wq * QBLK) * LDR;
#pragma unroll
    for (int r = 0; r < 16; ++r) {
      float ss = 0.f;
#pragma unroll
      for (int d0 = 0; d0 < 4; ++d0) { o[d0][r] -= lam * ex[(d0 * 16 + r) * 64 + lane_e]; ss += o[d0][r] * o[d0][r]; }
      ss += __shfl_xor(ss, 1); ss += __shfl_xor(ss, 2); ss += __shfl_xor(ss, 4); ss += __shfl_xor(ss, 8); ss += __shfl_xor(ss, 16);
      const float rn = 1.f / sqrtf(ss * (1.f / DV) + LN_EPS);
      const int orow = crow(r, hie);
#pragma unroll
      for (int d0 = 0; d0 < 4; ++d0) Ow[(long)orow * LDR + d0 * 32 + r32e] = (bf16_t)f2bf(o[d0][r] * rn * gq[d0]);
    }
  }
  asm volatile("s_waitcnt vmcnt(0)" ::: "memory");
  __syncthreads();
}

struct SguRaw { bf16x8 raw[2][2][2]; f32x2 st[2][2]; };
__device__ __forceinline__ void sgu_load(SguRaw& R, const bf16_t* __restrict__ Vr, const f32x2* __restrict__ vsum, int sr, int sc) {
#pragma unroll
  for (int kh = 0; kh < 2; ++kh)
#pragma unroll
    for (int rr = 0; rr < 2; ++rr) {
#pragma unroll
      for (int ch = 0; ch < 2; ++ch) R.raw[kh][rr][ch] = *reinterpret_cast<const bf16x8*>(Vr + (long)(kh * 64 + rr * 32 + sr) * SGU_DFF + ch * 128 + sc);
      R.st[kh][rr] = vsum[kh * 64 + rr * 32 + sr]; }
}
__device__ __forceinline__ void sgu_chunks(const bf16_t* __restrict__ VBg, const bf16_t* __restrict__ Ug, bf16_t* __restrict__ Gg, const f32x2* __restrict__ vsum,
                                           const float* __restrict__ ng, const float* __restrict__ nb, const float* __restrict__ bs, const bf16x8 (&pa)[2][4],
                                           int chunk0, int cstep, int nchunk, char* lds) {
  const int tid = threadIdx.x, wid = tid >> 6, lane = tid & 63, r32 = lane & 31, hi = lane >> 5, wp = wid & 3, wcol = wid >> 2;
  const int sr = tid >> 4, sc = (tid & 15) * 8;
  float gg[2][8], bb[2][8];
#pragma unroll
  for (int ch = 0; ch < 2; ++ch)
#pragma unroll
    for (int i = 0; i < 8; i += 4) { const f32x4 g4 = *(const f32x4*)(ng + ch * 128 + sc + i), b4 = *(const f32x4*)(nb + ch * 128 + sc + i);
      gg[ch][i] = g4.x; gg[ch][i + 1] = g4.y; gg[ch][i + 2] = g4.z; gg[ch][i + 3] = g4.w; bb[ch][i] = b4.x; bb[ch][i + 1] = b4.y; bb[ch][i + 2] = b4.z; bb[ch][i + 3] = b4.w; }
  float bsr[16];
#pragma unroll
  for (int r = 0; r < 16; ++r) bsr[r] = bs[wp * 32 + crow(r, hi)];
  bf16_t* stg = (bf16_t*)(lds + 65536 + wid * 8192);
  const int vb = (int)(uintptr_t)lds + v_rd_base(lane) + wcol * 16384;
  SguRaw R;
  if (chunk0 < nchunk) sgu_load(R, VBg + (size_t)chunk0 * SGU_CH * SGU_DFF, vsum + (size_t)chunk0 * SGU_CH, sr, sc);
  for (int chunk = chunk0; chunk < nchunk; chunk += cstep) {
#pragma unroll
    for (int kh = 0; kh < 2; ++kh)
#pragma unroll
      for (int rr = 0; rr < 2; ++rr) {
        const float mean = R.st[kh][rr].x * (1.f / SGU_DFF), var = R.st[kh][rr].y * (1.f / SGU_DFF) - mean * mean, rstd = 1.f / sqrtf(fmaxf(var, 0.f) + LN_EPS);
#pragma unroll
        for (int ch = 0; ch < 2; ++ch) { const bf16x8 x = R.raw[kh][rr][ch]; unsigned w[4];
#pragma unroll
          for (int i = 0; i < 8; i += 2) { const float v0 = (bf2f((unsigned short)x[i]) - mean) * rstd * gg[ch][i] + bb[ch][i], v1 = (bf2f((unsigned short)x[i + 1]) - mean) * rstd * gg[ch][i + 1] + bb[ch][i + 1]; w[i >> 1] = cvtpk(v0, v1); }
          *(u32x4*)(lds + (kh * 2 + ch) * 16384 + v_st(rr * 32 + sr, sc)) = (u32x4){w[0], w[1], w[2], w[3]}; }
      }
    __syncthreads();
    if (chunk + cstep < nchunk) sgu_load(R, VBg + (size_t)(chunk + cstep) * SGU_CH * SGU_DFF, vsum + (size_t)(chunk + cstep) * SGU_CH, sr, sc);
    f32x16 o[4] = {};
    pv_d0(o, vb, pa[0][0], pa[0][1], pa[0][2], pa[0][3]);
    pv_d0(o, vb + 2 * 16384, pa[1][0], pa[1][1], pa[1][2], pa[1][3]);
#pragma unroll
    for (int r = 0; r < 16; ++r)
#pragma unroll
      for (int d0 = 0; d0 < 4; ++d0) stg[crow(r, hi) * 128 + d0 * 32 + r32] = (bf16_t)f2bf(o[d0][r] + bsr[r]);
    asm volatile("s_waitcnt lgkmcnt(0)" ::: "memory");
    const size_t cbase = (size_t)chunk * SGU_CH * SGU_DFF;
#pragma unroll
    for (int it = 0; it < 8; ++it) {
      const int row = it * 4 + (lane >> 4), cc = (lane & 15) * 8;
      const u32x4 vm = *(const u32x4*)(stg + row * 128 + cc);
      const size_t off = cbase + (size_t)(wp * 32 + row) * SGU_DFF + wcol * 128 + cc;
      const u32x4 uw = *(const u32x4*)(Ug + off);
      float a[8], u8[8];
      a[0] = bf2f(vm.x & 0xffffu); a[1] = bf2f(vm.x >> 16); a[2] = bf2f(vm.y & 0xffffu); a[3] = bf2f(vm.y >> 16); a[4] = bf2f(vm.z & 0xffffu); a[5] = bf2f(vm.z >> 16); a[6] = bf2f(vm.w & 0xffffu); a[7] = bf2f(vm.w >> 16);
      u8[0] = bf2f(uw.x & 0xffffu); u8[1] = bf2f(uw.x >> 16); u8[2] = bf2f(uw.y & 0xffffu); u8[3] = bf2f(uw.y >> 16); u8[4] = bf2f(uw.z & 0xffffu); u8[5] = bf2f(uw.z >> 16); u8[6] = bf2f(uw.w & 0xffffu); u8[7] = bf2f(uw.w >> 16);
      *(u32x4*)(Gg + off) = (u32x4){cvtpk(a[0] * u8[0], a[1] * u8[1]), cvtpk(a[2] * u8[2], a[3] * u8[3]), cvtpk(a[4] * u8[4], a[5] * u8[5]), cvtpk(a[6] * u8[6], a[7] * u8[7])};
    }
    __syncthreads();
  }
}
#undef KSWZ
#undef SBAR
}

struct Args { const float* in[27]; float* out; unsigned char* ws; int ph_lo, ph_hi, ph_lo2, ph_hi2; };
static_assert(offsetof(Args, out) == 27 * 8 && offsetof(Args, ws) == 28 * 8, "Args starts with 29 consecutive pointers");
enum { I_X = 0, I_C, I_CTX, I_CCTX, I_WMOD, I_BMOD, I_LNG, I_LNB, I_AWIN, I_AWOUT, I_ALAM, I_ASUBG, I_SWIN, I_SBIN, I_SNG, I_SNB, I_SWS, I_SBS, I_SWOUT,
       I_RW, I_RB, I_EWG, I_EWU, I_EWD, I_SHG, I_SHU, I_SHD };
constexpr int N_PHASES = 25;

__device__ __forceinline__ f32x4 ld_bf4(const bf16_t* p) { const u32x2 w = *(const u32x2*)p; return (f32x4){bf2f(w.x & 0xffffu), bf2f(w.x >> 16), bf2f(w.y & 0xffffu), bf2f(w.y >> 16)}; }

__device__ __forceinline__ void bf8_to_f32(const u32x4 w, float (&f)[8]) {
    f[0] = bf2f(w.x & 0xffffu); f[1] = bf2f(w.x >> 16); f[2] = bf2f(w.y & 0xffffu); f[3] = bf2f(w.y >> 16); f[4] = bf2f(w.z & 0xffffu); f[5] = bf2f(w.z >> 16); f[6] = bf2f(w.w & 0xffffu); f[7] = bf2f(w.w >> 16);
}
template <bool MOE>
__device__ __forceinline__ void ln_rows(const float* __restrict__ xin, const bf16_t* __restrict__ Yb, float* __restrict__ xout, bf16_t* __restrict__ hb, const float* __restrict__ lng, const float* __restrict__ lnb,
                                        const float* __restrict__ modl, int g_off, const float* __restrict__ modh, int sc_off, int hstride  , int gw, int NGW, int lane) {
    constexpr int NY = MOE ? TOPK + 1 : 1;
    for (int row = gw; row < T; row += NGW) {
        const int b = row / SEQ; const float* mb = modl + b * 6144; const float* mh = modh ? modh + b * 6144 : nullptr;
        u32x4 yr[NY][2]; f32x4 xr[2][2], gr[2][2], lg[2][2], lb[2][2], scv[2][2], shv[2][2];
#pragma unroll
        for (int j = 0; j < 2; ++j) {
            const int c = j * 512 + lane * 8;
            if (!MOE) yr[0][j] = *(const u32x4*)(Yb + (size_t)row * D + c);
            else { yr[TOPK][j] = *(const u32x4*)(Yb + ((size_t)TK + row) * D + c);
#pragma unroll
                for (int k = 0; k < TOPK; ++k) yr[k][j] = *(const u32x4*)(Yb + ((size_t)row * TOPK + k) * D + c); }
#pragma unroll
            for (int q = 0; q < 2; ++q) { xr[j][q] = *(const f32x4*)(xin + (size_t)row * D + c + q * 4); gr[j][q] = *(const f32x4*)(mb + g_off + c + q * 4);
            }
        }
        asm volatile("" ::: "memory");
        float v[2][8]; float s = 0.f;
#pragma unroll
        for (int j = 0; j < 2; ++j) {
            float ya[8]; bf8_to_f32(yr[0][j], ya);
#pragma unroll
            for (int k = 1; k < NY; ++k) { float t8[8]; bf8_to_f32(yr[k][j], t8);
#pragma unroll
                for (int i = 0; i < 8; ++i) ya[i] += t8[i];
                __builtin_amdgcn_sched_barrier(0); }
#pragma unroll
            for (int i = 0; i < 8; ++i) { v[j][i] = xr[j][i >> 2][i & 3] * ALPHA + gr[j][i >> 2][i & 3] * ya[i]; s += v[j][i]; }
        }
#pragma unroll
        for (int j = 0; j < 2; ++j)
#pragma unroll
            for (int q = 0; q < 2; ++q) { const int c = j * 512 + lane * 8 + q * 4; lg[j][q] = *(const f32x4*)(lng + c); lb[j][q] = *(const f32x4*)(lnb + c);
                if (modh) { scv[j][q] = *(const f32x4*)(mh + sc_off + c); shv[j][q] = *(const f32x4*)(mh + sc_off - 1024 + c); } }
        asm volatile("" ::: "memory");
        const float mean = wave_sum(s) * (1.f / D); float s2 = 0.f;
#pragma unroll
        for (int j = 0; j < 2; ++j)
#pragma unroll
            for (int i = 0; i < 8; ++i) { v[j][i] -= mean; s2 += v[j][i] * v[j][i]; }
        const float rstd = 1.f / sqrtf(wave_sum(s2) * (1.f / D) + LN_EPS);
#pragma unroll
        for (int j = 0; j < 2; ++j) {
            const int c = j * 512 + lane * 8;
            float o[8];
#pragma unroll
            for (int i = 0; i < 8; ++i) o[i] = v[j][i] * rstd * lg[j][i >> 2][i & 3] + lb[j][i >> 2][i & 3];
            *(f32x4*)(xout + (size_t)row * D + c) = (f32x4){o[0], o[1], o[2], o[3]}; *(f32x4*)(xout + (size_t)row * D + c + 4) = (f32x4){o[4], o[5], o[6], o[7]};
            if (modh) {
                float h[8];
#pragma unroll
                for (int i = 0; i < 8; ++i) h[i] = o[i] * (scv[j][i >> 2][i & 3] + 1.f) + shv[j][i >> 2][i & 3];
                const u32x4 hw = (u32x4){pk2(h[0], h[1]), pk2(h[2], h[3]), pk2(h[4], h[5]), pk2(h[6], h[7])};
                *(u32x4*)(hb + (size_t)row * hstride + c) = hw;
                if (hstride == HML) { float hf[8]; bf8_to_f32(hw, hf);
                    *(u32x4*)(hb + (size_t)row * hstride + D + c) = (u32x4){pk2(h[0] - hf[0], h[1] - hf[1]), pk2(h[2] - hf[2], h[3] - hf[3]), pk2(h[4] - hf[4], h[5] - hf[5]), pk2(h[6] - hf[6], h[7] - hf[7])}; }
            }
        }
    }
}

__device__ __forceinline__ void expert_prefix(const unsigned* cnt, LAS int* ps, LAS int* xps, int x, int tid) {
    if (tid < 64) {
        int v[4], s = 0;
#pragma unroll
        for (int i = 0; i < 4; ++i) { const int c = (int)cnt[tid * 4 + i]; v[i] = (c + PADM - 1) / PADM * PADM; s += v[i]; }
        int inc = s;
#pragma unroll
        for (int o = 1; o < 64; o <<= 1) { const int t = __shfl_up(inc, o); if (tid >= o) inc += t; }
        int ex = inc - s;
#pragma unroll
        for (int i = 0; i < 4; ++i) { ps[tid * 4 + i] = ex; ex += v[i]; }
        if (tid == 63) ps[256] = ex;
        int tl = 0; if (tid < 32) tl = ((int)cnt[x + 8 * tid] + PADM - 1) / PADM;
        int inc2 = tl;
#pragma unroll
        for (int o = 1; o < 32; o <<= 1) { const int t = __shfl_up(inc2, o); if (tid >= o) inc2 += t; }
        if (tid < 32) { xps[tid] = inc2 - tl; if (tid == 31) xps[32] = inc2; }
    }
    __syncthreads();
}

template <bool LO = false>
__device__ __forceinline__ void cvt_item(const float* __restrict__ W, int ldn, int K, int k0, int n0, bf16_t* __restrict__ Bt, int drow0, LAS unsigned char* wl, int lane, int kd0 = -1) {
    if (kd0 < 0) kd0 = k0;
    const int n4 = (lane & 31) * 4, kh = lane >> 5;
    const float* src = W + (size_t)(k0 + kh * 32) * ldn + n0 + n4;
    f32x4 v[4][8];
#pragma unroll
    for (int b = 0; b < 4; ++b)
#pragma unroll
        for (int i = 0; i < 8; ++i) v[b][i] = __builtin_nontemporal_load((const f32x4*)(src + (size_t)(b * 8 + i) * ldn));
    asm volatile("" ::: "memory");
#pragma unroll
    for (int b = 0; b < 4; ++b) {
        if (LO) {
#pragma unroll
            for (int i = 0; i < 8; ++i) { v[b][i].x -= bf2f(f2bf(v[b][i].x)); v[b][i].y -= bf2f(f2bf(v[b][i].y)); v[b][i].z -= bf2f(f2bf(v[b][i].z)); v[b][i].w -= bf2f(f2bf(v[b][i].w)); }
        }
        const int kc = kh * 4 + b;
#pragma unroll
        for (int c = 0; c < 4; ++c) {
            const int n = n4 + c;
            const u32x4 w = {pk2(v[b][0][c], v[b][1][c]), pk2(v[b][2][c], v[b][3][c]), pk2(v[b][4][c], v[b][5][c]), pk2(v[b][6][c], v[b][7][c])};
            *(LAS u32x4*)(wl + n * 128 + ((kc ^ (n & 7)) << 4)) = w;
        }
        __builtin_amdgcn_sched_barrier(0);
    }
    asm volatile("s_waitcnt lgkmcnt(0)" ::: "memory");
    const int cch = lane & 7;
#pragma unroll
    for (int j = 0; j < 16; ++j) {
        const int n = (lane >> 3) + 8 * j;
        const u32x4 w = *(const LAS u32x4*)(wl + n * 128 + ((cch ^ (n & 7)) << 4));
        __builtin_nontemporal_store(w, (u32x4*)(Bt + (size_t)(drow0 + n) * K + kd0 + cch * 8));
    }
    asm volatile("s_waitcnt lgkmcnt(0)" ::: "memory");
}

struct Ctx { unsigned char* lds; XcdBarrier bar; int G, bid, NGW, lo, hi; long NGT; };
__device__ __forceinline__ unsigned char* ldptr(const unsigned char* lds, int i) {
    const LAS unsigned* p = (const LAS unsigned*)((LAS unsigned char*)lds + LDS_PTRS) + 2 * i;
    const unsigned lo = __builtin_amdgcn_readfirstlane(p[0]), hi = __builtin_amdgcn_readfirstlane(p[1]);
    return (unsigned char*)(GAS unsigned char*)(((unsigned long long)hi << 32) | lo);
}
#define PIN(i) ((const float*)ldptr(lds, (i)))
#ifndef PHMASK
#define PHMASK 0xFFFFFFFFu
#endif
#define IN(k) (((PHMASK >> (k)) & 1u) && lo <= (k) && (k) < hi)
#define SEAM(k) do { if (!MK_PER_PHASE_LAUNCH && IN((k) + 1)) xcd_barrier(bar); else __syncthreads(); } while (0)
#define CTX_LOCALS \
    unsigned char* lds = C.lds; const XcdBarrier bar = C.bar; const int G = C.G, bid = C.bid, NGW = C.NGW; \
    const long NGT = C.NGT; unsigned char* ws = ldptr(lds, 28); unsigned* ctl = (unsigned*)(ws + WS_CTL); float* smf = (float*)lds; const int lo = C.lo, hi = C.hi; \
    LAS unsigned char* ldsl = (LAS unsigned char*)lds; \
    (void)NGW; (void)NGT; (void)ctl; (void)smf; (void)bid; (void)G; (void)ldsl;
#define PH_LOCALS \
    int tid = threadIdx.x; asm volatile("" : "+v"(tid)); const int lane = tid & 63, wave = __builtin_amdgcn_readfirstlane(tid >> 6); const int gw = bid * NWAVES + wave; const long gt = (long)bid * NTHR + tid; \
    (void)lane; (void)wave; (void)gw; (void)gt;
#define WS_PTRS \
    float* modv = (float*)(ws + WS_MODV); float* ROPE = (float*)(ws + WS_ROPE); \
    bf16_t* HALL = (bf16_t*)(ws + WS_HALL); bf16_t* Qb = (bf16_t*)(ws + WS_Q); bf16_t* Kb = (bf16_t*)(ws + WS_K); bf16_t* Vb = (bf16_t*)(ws + WS_V); \
    float* OATT = (float*)(ws + WS_OATT); bf16_t* ATT = (bf16_t*)(ws + WS_ATT); \
    bf16_t* Y = (bf16_t*)(ws + WS_Y); float* X1 = (float*)(ws + WS_X1); float* X2 = (float*)ldptr(lds, 27); \
    bf16_t* HM = (bf16_t*)(ws + WS_HM); bf16_t* H1 = (bf16_t*)(ws + WS_H1); \
    float* LOG = (float*)(ws + WS_LOG); bf16_t* HO = (bf16_t*)(ws + WS_HO); bf16_t* HS = (bf16_t*)(ws + WS_HS); \
    int* IDX = (int*)(ws + WS_IDX); float* WGT = (float*)(ws + WS_WGT); int* POS = (int*)(ws + WS_POS); \
    int* SPAIR = (int*)(ws + WS_SPAIR); float* SW = (float*)(ws + WS_SW); \
    bf16_t* Ub = (bf16_t*)(ws + WS_U); bf16_t* VB = (bf16_t*)(ws + WS_VB); float* VN = (float*)(ws + WS_VN); bf16_t* GSP = (bf16_t*)(ws + WS_GSP); \
    bf16_t* WIN_T = (bf16_t*)(ws + WS_WIN_T); bf16_t* WOUT_T = (bf16_t*)(ws + WS_WOUT_T); bf16_t* SWIN_T = (bf16_t*)(ws + WS_SWIN_T); bf16_t* SWOUT_T = (bf16_t*)(ws + WS_SWOUT_T); \
    bf16_t* SHUP_T = (bf16_t*)(ws + WS_SHUP_T); bf16_t* SHDN_T = (bf16_t*)(ws + WS_SHDN_T); bf16_t* EUP_T = (bf16_t*)(ws + WS_EUP_T); bf16_t* EDN_T = (bf16_t*)(ws + WS_EDN_T); bf16_t* RW_T = (bf16_t*)(ws + WS_RW_T); (void)RW_T; bf16_t* WSB = (bf16_t*)(ws + WS_WSB); f32x2* VSTAT = (f32x2*)(ws + WS_VSTAT); (void)WSB; (void)VSTAT; \
    (void)modv; (void)ROPE; (void)HALL; (void)Qb; (void)Kb; (void)Vb; (void)OATT; (void)ATT; (void)Y; (void)X1; (void)X2; (void)HM; (void)H1; (void)LOG; (void)HO; (void)HS; (void)IDX; (void)WGT; (void)POS; \
    (void)SPAIR; (void)SW; (void)Ub; (void)VB; (void)VN; (void)GSP; (void)WIN_T; (void)WOUT_T; (void)SWIN_T; (void)SWOUT_T; (void)SHUP_T; (void)SHDN_T; (void)EUP_T; (void)EDN_T;

constexpr int NI_WIN = 16 * 24, NI_WOUT = 16 * 8, NI_SWIN = 16 * 32, NI_SWOUT = 32 * 8, NI_RW = 2 * 3 * 32, NI_SH = 2 * 96, NI_DENSE = NI_WIN + NI_WOUT + NI_SWIN + NI_SWOUT + NI_RW + NI_SH;
constexpr int NI_EXP = 2 * NE * 96;
constexpr int NI_EXP_CONV = NI_EXP / 100 * 70;
__device__ __forceinline__ void cvt_weights(unsigned char* lds, int w, int NW, int lane, LAS unsigned char* wl, int it0, int it1) {
    unsigned char* ws = ldptr(lds, 28);
    bf16_t* WIN_T = (bf16_t*)(ws + WS_WIN_T); bf16_t* WOUT_T = (bf16_t*)(ws + WS_WOUT_T); bf16_t* SWIN_T = (bf16_t*)(ws + WS_SWIN_T); bf16_t* SWOUT_T = (bf16_t*)(ws + WS_SWOUT_T);
    bf16_t* SHUP_T = (bf16_t*)(ws + WS_SHUP_T); bf16_t* SHDN_T = (bf16_t*)(ws + WS_SHDN_T); bf16_t* EUP_T = (bf16_t*)(ws + WS_EUP_T); bf16_t* EDN_T = (bf16_t*)(ws + WS_EDN_T); bf16_t* RW_T = (bf16_t*)(ws + WS_RW_T);
    for (int it = it0 + w; it < it1; it += NW) {
        int r = it;
        if (r < NI_WIN) { cvt_item(PIN(I_AWIN), 3 * D, D, (r / 24) * 64, (r % 24) * 128, WIN_T, (r % 24) * 128, wl, lane); continue; } r -= NI_WIN;
        if (r < NI_WOUT) { cvt_item(PIN(I_AWOUT), D, D, (r / 8) * 64, (r % 8) * 128, WOUT_T, (r % 8) * 128, wl, lane); continue; } r -= NI_WOUT;
        if (r < NI_SWIN) { cvt_item(PIN(I_SWIN), 2 * SGU_DFF, D, (r / 32) * 64, (r % 32) * 128, SWIN_T, (r % 32) * 128, wl, lane); continue; } r -= NI_SWIN;
        if (r < NI_SWOUT) { cvt_item(PIN(I_SWOUT), D, SGU_DFF, (r / 8) * 64, (r % 8) * 128, SWOUT_T, (r % 8) * 128, wl, lane); continue; } r -= NI_SWOUT;
        if (r < NI_RW) { const int l = r / 96, seg = (r % 96) / 32, sub = r % 32; const float* rw = PIN(I_RW) + (size_t)l * D * NE; bf16_t* dst = RW_T + (size_t)l * NE * 3072;
            if (seg < 2) cvt_item<false>(rw, NE, 3072, (sub / 2) * 64, (sub % 2) * 128, dst, (sub % 2) * 128, wl, lane, seg * 1024 + (sub / 2) * 64);
            else cvt_item<true>(rw, NE, 3072, (sub / 2) * 64, (sub % 2) * 128, dst, (sub % 2) * 128, wl, lane, 2048 + (sub / 2) * 64);
            continue; } r -= NI_RW;
        const float *wg, *wu, *wd; bf16_t *up_t, *dn_t;
        if (r < NI_SH) { const int l = r / 96; r %= 96; wg = PIN(I_SHG) + (size_t)l * D * EDFF; wu = PIN(I_SHU) + (size_t)l * D * EDFF; wd = PIN(I_SHD) + (size_t)l * EDFF * D;
            up_t = SHUP_T + (size_t)l * 512 * D; dn_t = SHDN_T + (size_t)l * D * EDFF; }
        else { r -= NI_SH; const int le = r / 96; r %= 96; wg = PIN(I_EWG) + (size_t)le * D * EDFF; wu = PIN(I_EWU) + (size_t)le * D * EDFF; wd = PIN(I_EWD) + (size_t)le * EDFF * D;
            up_t = EUP_T + (size_t)le * 512 * D; dn_t = EDN_T + (size_t)le * D * EDFF; }
        const int mat = r / 32, sub = r % 32;
        if (mat < 2) cvt_item(mat == 0 ? wg : wu, EDFF, D, (sub / 2) * 64, (sub % 2) * 128, up_t, (sub % 2) * 256 + mat * 128, wl, lane);
        else cvt_item(wd, D, EDFF, (sub / 8) * 64, (sub % 8) * 128, dn_t, (sub % 8) * 128, wl, lane);
    }
}

__device__ __forceinline__ void phases_front(const Ctx& C) {
    CTX_LOCALS
    WS_PTRS
    if (IN(0)) { PH_LOCALS
        float* sc = smf;
        float* red = smf + 5 * 1024;
        for (int i = tid; i < 5 * 1024; i += NTHR) { const int r = i >> 10, k = i & 1023; const float c = r < 4 ? PIN(I_C)[r * D + k] : PIN(I_CCTX)[k]; sc[i] = siluf(c); }
        __syncthreads();
        for (int it = bid; it < 2 * 96; it += G) {
            const int l = it / 96, j = (it % 96) * 64 + lane;
            const float* w = PIN(I_WMOD) + (size_t)l * D * 6144 + j;
            float a0 = 0, a1 = 0, a2 = 0, a3 = 0, a4 = 0;
            for (int k = wave * 128; k < wave * 128 + 128; ++k) { const float wv = w[(size_t)k * 6144]; a0 += sc[k] * wv; a1 += sc[1024 + k] * wv; a2 += sc[2048 + k] * wv; a3 += sc[3072 + k] * wv; a4 += sc[4096 + k] * wv; }
            red[(wave * 5 + 0) * 64 + lane] = a0; red[(wave * 5 + 1) * 64 + lane] = a1; red[(wave * 5 + 2) * 64 + lane] = a2; red[(wave * 5 + 3) * 64 + lane] = a3; red[(wave * 5 + 4) * 64 + lane] = a4;
            __syncthreads();
            if (tid < 320) { const int r = tid >> 6, jj = tid & 63; float s = 0.f;
#pragma unroll
                for (int w8 = 0; w8 < 8; ++w8) s += red[(w8 * 5 + r) * 64 + jj];
                const int col = (it % 96) * 64 + jj;
                modv[((size_t)l * 5 + r) * 6144 + col] = s + PIN(I_BMOD)[l * 6144 + col]; }
            __syncthreads();
        }
        if (gt < 128 * 16) { const int pos = (int)gt >> 4, jj = (int)gt & 15; const float ang = (float)pos * __powf(10000.f, -(float)jj / 16.f); ROPE[gt * 2] = __cosf(ang); ROPE[gt * 2 + 1] = __sinf(ang); }
        for (long i = gt; i < SGU_G * SGU_CH * SGU_CH / 2; i += NGT) { const f32x2 w = *(const f32x2*)(PIN(I_SWS) + i * 2); ((unsigned*)WSB)[i] = pk2(w.x, w.y); }
        cvt_weights(lds, bid * NWAVES + wave, G * NWAVES, lane, ldsl + wave * 16384, 0, NI_DENSE);
        cvt_weights(lds, bid * NWAVES + wave, G * NWAVES, lane, ldsl + wave * 16384, NI_DENSE + NI_EXP_CONV, NI_DENSE + NI_EXP);
        SEAM(0);
    }
    if (IN(1)) { PH_LOCALS
        for (long i = gt; i < (long)TA * (D / 4); i += NGT) {
            const int row = (int)(i >> 8), c = (int)(i & 255) * 4, b = row / SEQA, n = row % SEQA;
            const float* src = n < SEQ ? PIN(I_X) + ((size_t)b * SEQ + n) * D + c : PIN(I_CTX) + ((size_t)b * CTX + (n - SEQ)) * D + c;
            const float* mb = modv + (n < SEQ ? b : 4) * 6144;
            const f32x4 h = *(const f32x4*)src * (*(const f32x4*)(mb + 1024 + c) + 1.f) + *(const f32x4*)(mb + c);
            *(u32x2*)(HALL + (size_t)row * D + c) = (u32x2){pk2(h.x, h.y), pk2(h.z, h.w)};
        }
        SEAM(1);
    }
#if FAST_DENSE
    if (IN(2)) { PH_LOCALS
        pg8::DenseSched S; S.init(HALL, WIN_T, TA, 3 * D, D, G, bid);
        const pg8::EpiQKV E{Qb, (WS_K - WS_Q) / 2, ROPE, 0.125f * 1.4426950408889634f};
        pg8::gemm_phase<pg8::EpiQKV, pg8::DenseSched, true>(ldsl, D, S, E);
        SEAM(2);
    }
#else
    if (IN(2)) { PH_LOCALS
        const LoadBf16 la{HALL, D, nullptr};
        for (int it = bid; it < (TA / 128) * 24; it += G) {
            const int mt = it / 24, nt = it % 24;
            auto epi = [=](int r, int c, f32x4 va, f32x4 vb) { bf16_t* dst = Qb + (size_t)(c >> 10) * ((WS_K - WS_Q) / 2) + (size_t)r * D + (c & 1023);
                *(u32x4*)dst = (u32x4){pk2(va.x, va.y), pk2(va.z, va.w), pk2(vb.x, vb.y), pk2(vb.z, vb.w)}; };
            gemm_tile(la, PIN(I_AWIN), 3 * D, D, mt * 128, nt * 128, smf, epi);
        }
        SEAM(2);
    }
    if (IN(3)) { PH_LOCALS
        for (long i = gt; i < (long)T * 1024; i += NGT) {
            const int j = (int)(i & 15), ch = (int)(i >> 4) & 1, hm = (int)(i >> 5) & 15, wh = (int)(i >> 9) & 1; const long tok = i >> 10;
            const int b = (int)(tok / SEQ), n = (int)(tok % SEQ);
            const int pos = ch == 0 ? n / 64 : n % 64;
            const float cs = ROPE[(pos * 16 + j) * 2], sn = ROPE[(pos * 16 + j) * 2 + 1];
            bf16_t* p = (wh ? Kb : Qb) + ((size_t)b * SEQA + n) * D + hm * 64 + ch * 32 + j;
            const float x1 = bf2f(p[0]), x2 = bf2f(p[16]);
            p[0] = (bf16_t)f2bf(x1 * cs - x2 * sn); p[16] = (bf16_t)f2bf(x2 * cs + x1 * sn);
        }
        SEAM(3);
    }
#endif
    if (IN(4)) { PH_LOCALS
        const float* lp = PIN(I_ALAM);
        const float l1 = wave_sum(lp[lane] * lp[64 + lane]), l2 = wave_sum(lp[128 + lane] * lp[192 + lane]);
        const float lam = __expf(l1) - __expf(l2) + LAM_INIT;
        const int x = bid & 7, r = bid >> 3, W = G >> 3, NCV = (W > 16) ? 3 : 0, WA = W - NCV;
        if (r < WA) {
            for (int i = 0; ; ++i) {
                const int idx = i * WA + r; if (idx >= 4 * (SEQ / att::UNIT_ROWS)) break;
                const int pair = x * 4 + idx / (SEQ / att::UNIT_ROWS), qb = idx % (SEQ / att::UNIT_ROWS), b = pair >> 3, h = pair & 7;
                const size_t q0 = (size_t)b * SEQA * D + h * 128, kv0 = (size_t)(b * NH + h) * SEQA * 128;
                att::attn_unit(Qb + q0 + (size_t)qb * att::UNIT_ROWS * D, Kb + kv0, Vb + kv0, ATT + ((size_t)b * SEQ + (size_t)qb * att::UNIT_ROWS) * D + h * 128,
                               lam, PIN(I_ASUBG), SEQA, (char*)lds, (char*)lds + LDS_TAB);
            }
        }
        if (NCV == 0 || r >= WA) {
            const int cw = NCV ? ((r - WA) * 8 + x) * NWAVES + wave : bid * NWAVES + wave, cn = NCV ? NCV * 8 * NWAVES : G * NWAVES;
            cvt_weights(lds, cw, cn, lane, ldsl + wave * 16384, NI_DENSE, NI_DENSE + (NCV ? NI_EXP_CONV : NI_EXP));
        }
        SEAM(4);
    }
    if (IN(6)) { PH_LOCALS
#if FAST_DENSE
        pg8::DenseSched S; S.init(ATT, WOUT_T, T, D, D, G, bid);
        const pg8::EpiBf16<0> E{Y, D, nullptr, 0, 0};
        pg8::gemm_phase<pg8::EpiBf16<0>, pg8::DenseSched, true>(ldsl, D, S, E);
#else
        const LoadBf16 la{ATT, D, nullptr};
        for (int it = bid; it < (T / 128) * 8; it += G) {
            const int mt = it / 8, nt = it % 8;
            auto epi = [=](int r, int c, f32x4 va, f32x4 vb) { *(u32x4*)(Y + (size_t)r * D + c) = (u32x4){pk2(va.x, va.y), pk2(va.z, va.w), pk2(vb.x, vb.y), pk2(vb.z, vb.w)}; };
            gemm_tile(la, PIN(I_AWOUT), D, D, mt * 128, nt * 128, smf, epi);
        }
#endif
        SEAM(6);
    }
}
template <int L> __device__ __forceinline__ void layer_tail(const Ctx& C) {
    CTX_LOCALS
    WS_PTRS
    const float* xin = (L == 0) ? PIN(I_X) : X2;
    const float* modl = modv + (size_t)L * 5 * 6144;
    unsigned* cnt = ctl + CW_CNT + L * 256;
    LAS int* ps = (LAS int*)(ldsl + LDS_PS); LAS int* xps = ps + 264;
    const int xcd = bid & 7, xr = bid >> 3, XW = G >> 3;
    if (L == 1) {
        if (IN(14)) { PH_LOCALS
#if FAST_DENSE
            pg8::DenseSched S; S.init(H1, SWIN_T, T, 2 * SGU_DFF, D, G, bid);
            const pg8::EpiSguIn E{Ub, VB, PIN(I_SBIN), (float*)VSTAT};
            pg8::gemm_phase<pg8::EpiSguIn, pg8::DenseSched, true>(ldsl, D, S, E);
#else
            const LoadBf16 la{H1, D, nullptr};
            for (int it = bid; it < (T / 128) * 32; it += G) {
                const int mt = it / 32, nt = it % 32;
                auto epi = [=](int r, int c, f32x4 va, f32x4 vb) { const float v[8] = {va.x, va.y, va.z, va.w, vb.x, vb.y, vb.z, vb.w};
                    float z[8];
#pragma unroll
                    for (int j = 0; j < 8; ++j) z[j] = gelu_erf(v[j] + PIN(I_SBIN)[c + j]);
                    bf16_t* dst = (c < SGU_DFF) ? Ub + (size_t)r * SGU_DFF + c : VB + (size_t)r * SGU_DFF + (c - SGU_DFF);
                    *(u32x4*)dst = (u32x4){pk2(z[0], z[1]), pk2(z[2], z[3]), pk2(z[4], z[5]), pk2(z[6], z[7])}; };
                gemm_tile(la, PIN(I_SWIN), 2 * SGU_DFF, D, mt * 128, nt * 128, smf, epi);
            }
#endif
            SEAM(14);
        }
        if (IN(16)) { PH_LOCALS
            const int g = bid & 7, wp = wave & 3, r32 = lane & 31, hih = lane >> 5;
            att::bf16x8 pa[2][4];
#pragma unroll
            for (int kh = 0; kh < 2; ++kh)
#pragma unroll
                for (int ks = 0; ks < 4; ++ks) pa[kh][ks] = *reinterpret_cast<const att::bf16x8*>(WSB + ((size_t)g * SGU_CH + wp * 32 + r32) * SGU_CH + kh * 64 + ks * 16 + hih * 8);
            att::sgu_chunks(VB + g * SGU_GC, Ub + g * SGU_GC, GSP + g * SGU_GC, VSTAT, PIN(I_SNG) + g * SGU_GC, PIN(I_SNB) + g * SGU_GC, PIN(I_SBS) + g * SGU_CH, pa,
                            bid >> 3, G >> 3, T / SGU_CH, (char*)lds);
            SEAM(16);
        }
        if (IN(17)) { PH_LOCALS
#if FAST_DENSE
            pg8::DenseSched S; S.init(GSP, SWOUT_T, T, D, SGU_DFF, G, bid);
            const pg8::EpiBf16<0> E{Y, D, nullptr, 0, 0};
            pg8::gemm_phase<pg8::EpiBf16<0>, pg8::DenseSched, true>(ldsl, SGU_DFF, S, E);
#else
            const LoadBf16 la{GSP, SGU_DFF, nullptr};
            for (int it = bid; it < (T / 128) * 8; it += G) {
                const int mt = it / 8, nt = it % 8;
                auto epi = [=](int r, int c, f32x4 va, f32x4 vb) { *(u32x4*)(Y + (size_t)r * D + c) = (u32x4){pk2(va.x, va.y), pk2(va.z, va.w), pk2(vb.x, vb.y), pk2(vb.z, vb.w)}; };
                gemm_tile(la, PIN(I_SWOUT), D, SGU_DFF, mt * 128, nt * 128, smf, epi);
            }
#endif
            SEAM(17);
        }
    }
    constexpr int P_LN = (L == 0) ? 7 : 18;
    if (IN(P_LN)) { PH_LOCALS
        ln_rows<false>(xin, Y, X1, HM, PIN(I_LNG) + (L * 2 + 0) * D, PIN(I_LNB) + (L * 2 + 0) * D, modl, 2048, modl, 4096, HML, gw, NGW, lane);
        if (L == 0) for (long i = gt; i < T; i += NGT) VSTAT[i] = (f32x2){0.f, 0.f};
        SEAM(P_LN);
    }
    if (IN(P_LN + 1)) { PH_LOCALS
        const int GH = G >> 1;
        if (bid < GH) {
            pg8::DenseSched S; S.init(HM, RW_T + (size_t)L * NE * 3072, T, NE, 3072, GH, bid, HML);
            const pg8::EpiF32 E{LOG, NE};
            pg8::gemm_phase<pg8::EpiF32, pg8::DenseSched, true, 32>(ldsl, 3072, S, E);
        } else {
            pg8::DenseSched S; S.init(HM, SHUP_T + (size_t)L * 512 * D, T, 512, D, G - GH, bid - GH, HML);
            const pg8::EpiSharedUp E{HS};
            pg8::gemm_phase<pg8::EpiSharedUp, pg8::DenseSched, true>(ldsl, D, S, E);
        }
        SEAM(P_LN + 1);
    }
    if (IN(P_LN + 2)) { PH_LOCALS
        const float* rb = PIN(I_RB) + L * NE;
        const f32x4 bias = *(const f32x4*)(rb + lane * 4);
        for (int t = gw; t < T; t += NGW) {
            const f32x4 lg = *(const f32x4*)(LOG + (size_t)t * NE + lane * 4);
            float sc[4], ch[4];
#pragma unroll
            for (int i = 0; i < 4; ++i) { sc[i] = sigmoidf_(lg[i]); ch[i] = sc[i] + bias[i]; }
            float m1 = fmaxf(ch[0], ch[1]), m2 = fminf(ch[0], ch[1]);
#pragma unroll
            for (int i = 2; i < 4; ++i) { const float v = ch[i]; m2 = fmaxf(m2, fminf(m1, v)); m1 = fmaxf(m1, v); }
#pragma unroll
            for (int o = 1; o < 8; o <<= 1) { const float b1 = __shfl_xor(m1, o), b2 = __shfl_xor(m2, o); const float n1 = fmaxf(m1, b1), n2 = fmaxf(fminf(m1, b1), fmaxf(m2, b2)); m1 = n1; m2 = n2; }
            const float gs = m1 + m2; const int g = lane >> 3; int rank = 0;
#pragma unroll
            for (int gg = 0; gg < 8; ++gg) { const float o = __shfl(gs, gg * 8); rank += (o > gs || (o == gs && gg < g)) ? 1 : 0; }
            const bool sel = rank < 4;
            float cm[4];
#pragma unroll
            for (int i = 0; i < 4; ++i) cm[i] = sel ? ch[i] : -INFINITY;
            float wsum = 0.f, myw = 0.f; int myidx = 0;
#pragma unroll
            for (int k = 0; k < TOPK; ++k) {
                float bv = cm[0]; int bi = lane * 4;
#pragma unroll
                for (int i = 1; i < 4; ++i) if (cm[i] > bv) { bv = cm[i]; bi = lane * 4 + i; }
#pragma unroll
                for (int o = 1; o < 64; o <<= 1) { const float ov = __shfl_xor(bv, o); const int oi = __shfl_xor(bi, o); if (ov > bv || (ov == bv && oi < bi)) { bv = ov; bi = oi; } }
                const int sub = bi & 3; const float mysc = sub == 0 ? sc[0] : sub == 1 ? sc[1] : sub == 2 ? sc[2] : sc[3];
                const float wv = __shfl(mysc, bi >> 2);
                if ((bi >> 2) == lane) { if (sub == 0) cm[0] = -INFINITY; else if (sub == 1) cm[1] = -INFINITY; else if (sub == 2) cm[2] = -INFINITY; else cm[3] = -INFINITY; }
                wsum += wv; if (lane == k) { myw = wv; myidx = bi; }
            }
            if (lane < TOPK) {
                IDX[t * TOPK + lane] = myidx; WGT[t * TOPK + lane] = myw / wsum * ROUTED_SCALE;
                POS[t * TOPK + lane] = (int)atomicAdd(cnt + myidx, 1u);
            }
        }
        SEAM(P_LN + 2);
    }
    if (IN(P_LN + 3)) { PH_LOCALS
        expert_prefix(cnt, ps, xps, xcd, tid);
        for (long p = gt; p < TK; p += NGT) { const int e = IDX[p]; const int slot = ps[e] + POS[p]; SPAIR[slot] = (int)p; SW[slot] = WGT[p]; }
        for (int e = bid; e < NE; e += G) { const int c = (int)cnt[e], pe = ps[e + 1] - ps[e]; for (int s = c + tid; s < pe; s += NTHR) { SPAIR[ps[e] + s] = -1; SW[ps[e] + s] = 0.f; } }
        for (long t = gt; t < T; t += NGT) { SPAIR[PMAX + t] = TK + (int)t; SW[PMAX + t] = 1.f; }
        SEAM(P_LN + 3);
    }
    auto naive_up = [=](int row0, int e, int pn) {
        const float* wg = e < NE ? PIN(I_EWG) + ((size_t)L * NE + e) * D * EDFF : PIN(I_SHG) + (size_t)L * D * EDFF;
        const float* wu = e < NE ? PIN(I_EWU) + ((size_t)L * NE + e) * D * EDFF : PIN(I_SHU) + (size_t)L * D * EDFF;
        auto la = [=](int r, int k) -> f32x4 { const int p = SPAIR[r]; const int tok = p < 0 ? 0 : (p < TK ? (p >> 3) : (p - TK)); return ld_bf4(HM + (size_t)tok * HML + k); };
        for (int half = 0; half < 2; ++half) {
            f32x4 ga[4], gb[4];
            { int ri = 0; auto epi1 = [&](int r, int c, f32x4 va, f32x4 vb) { ga[ri] = va; gb[ri] = vb; ++ri; }; gemm_tile(la, wg, EDFF, D, row0 + half * 128, pn * 128, smf, epi1); }
            { int ri = 0; auto epi2 = [&](int r, int c, f32x4 va, f32x4 vb) { const float w = SW[r]; const f32x4 g0 = ga[ri], g1 = gb[ri]; ++ri;
                *(u32x4*)(HS + (size_t)r * EDFF + c) = (u32x4){pk2(w * siluf(g0.x) * va.x, w * siluf(g0.y) * va.y), pk2(w * siluf(g0.z) * va.z, w * siluf(g0.w) * va.w), pk2(w * siluf(g1.x) * vb.x, w * siluf(g1.y) * vb.y), pk2(w * siluf(g1.z) * vb.z, w * siluf(g1.w) * vb.w)}; };
              gemm_tile(la, wu, EDFF, D, row0 + half * 128, pn * 128, smf, epi2); }
        }
    };
    auto naive_dn = [=](int row0, int e, int pn) {
        const float* wd = e < NE ? PIN(I_EWD) + ((size_t)L * NE + e) * EDFF * D : PIN(I_SHD) + (size_t)L * EDFF * D;
        const LoadBf16 la{HS, EDFF, nullptr};
        auto epi = [=](int r, int c, f32x4 va, f32x4 vb) { const int p = SPAIR[r];
            if (p >= 0) *(u32x4*)(HO + (size_t)p * D + c) = (u32x4){pk2(va.x, va.y), pk2(va.z, va.w), pk2(vb.x, vb.y), pk2(vb.z, vb.w)}; };
        for (int q = 0; q < 4; ++q) gemm_tile(la, wd, D, EDFF, row0 + (q >> 1) * 128, pn * 256 + (q & 1) * 128, smf, epi);
    };
    if (IN(P_LN + 4)) { PH_LOCALS
        expert_prefix(cnt, ps, xps, xcd, tid);
        LAS int* ptab = (LAS int*)(ldsl + LDS_TAB); LAS float* wtab = (LAS float*)(ldsl + LDS_TAB + MAXU_UP * 1024);
        pg8::MoeSched<true, MAXU_UP> S{(const char*)HM, (const char*)(EUP_T + (size_t)L * NE * 512 * D), (const char*)(SHUP_T + (size_t)L * 512 * D), (size_t)512 * D * 2, D, HML, 2, xcd, xr, XW, 0, ps, xps, ptab};
        pg8::Unit u;
#if FAST_MOE
        for (int j = 0; S.next(j, u); ++j) if (tid < 256) { ptab[j * 256 + tid] = SPAIR[u.row0 + tid]; wtab[j * 256 + tid] = SW[u.row0 + tid]; }
        __syncthreads();
        const pg8::EpiMoeUp<MAXU_UP> E{HS, wtab};
        pg8::gemm_phase<pg8::EpiMoeUp<MAXU_UP>, pg8::MoeSched<true, MAXU_UP>, true>(ldsl, D, S, E);
        for (int j = MAXU_UP; S.next_any(j, u); ++j) naive_up(u.row0, u.e, u.pn);
#else
        for (int j = 0; S.next_any(j, u); ++j) naive_up(u.row0, u.e, u.pn);
#endif
        SEAM(P_LN + 4);
    }
    if (IN(P_LN + 5)) { PH_LOCALS
        expert_prefix(cnt, ps, xps, xcd, tid);
        LAS int* ptab = (LAS int*)(ldsl + LDS_TAB);
        pg8::MoeSched<false, MAXU_DN> S{(const char*)HS, (const char*)(EDN_T + (size_t)L * NE * D * EDFF), (const char*)(SHDN_T + (size_t)L * D * EDFF), (size_t)D * EDFF * 2, EDFF, EDFF, 4, xcd, xr, XW, 16, ps, xps, ptab};
        pg8::Unit u;
#if FAST_MOE
        for (int j = 0; S.next(j, u); ++j) if (tid < 256) ptab[j * 256 + tid] = SPAIR[u.row0 + tid];
        __syncthreads();
        const pg8::EpiMoeDown<MAXU_DN> E{HO, ptab};
        int kdn = EDFF; asm volatile("" : "+s"(kdn));
        pg8::gemm_phase<pg8::EpiMoeDown<MAXU_DN>, pg8::MoeSched<false, MAXU_DN>, true>(ldsl, kdn, S, E);
        for (int j = MAXU_DN; S.next_any(j, u); ++j) naive_dn(u.row0, u.e, u.pn);
#else
        for (int j = 0; S.next_any(j, u); ++j) naive_dn(u.row0, u.e, u.pn);
#endif
        SEAM(P_LN + 5);
    }
    if (IN(P_LN + 6)) { PH_LOCALS
        if (L == 0) ln_rows<true>(X1, HO, X2, H1, PIN(I_LNG) + (L * 2 + 1) * D, PIN(I_LNB) + (L * 2 + 1) * D, modl, 5120, modv + (size_t)5 * 6144, 1024, D, gw, NGW, lane);
        else ln_rows<true>(X1, HO, X2, nullptr, PIN(I_LNG) + (L * 2 + 1) * D, PIN(I_LNB) + (L * 2 + 1) * D, modl, 5120, nullptr, 0, D, gw, NGW, lane);
        SEAM(P_LN + 6);
    }
}

__global__ void __launch_bounds__(NTHR, 2) mega(Args args) {
    extern __shared__ __attribute__((aligned(16))) unsigned char lds[];
    const int tid = threadIdx.x;
    const int G = gridDim.x, bid = blockIdx.x;
    unsigned* ctl = (unsigned*)(args.ws + WS_CTL);
    for (int u = tid; u < 512; u += NTHR) ((unsigned*)(lds + LDS_MISC))[u] = 0u;
    __syncthreads();
    if (tid < 29) {
        const unsigned long long* kp = (const unsigned long long*)__builtin_amdgcn_kernarg_segment_ptr();
        ((unsigned long long*)(lds + LDS_PTRS))[tid] = kp[tid]; }
    __syncthreads();
    XcdBarrier bar; bar.bar = ctl + CW_BAR; bar.x = 0; bar.st = nullptr;
    if (!MK_PER_PHASE_LAUNCH) bar = xcd_barrier_post(ctl + CW_BAR, (volatile LAS unsigned*)(lds + LDS_MISC) + 8);
    Ctx C; C.lds = lds; C.bar = bar; C.G = G; C.bid = bid; C.NGW = G * NWAVES; C.NGT = (long)G * NTHR;
    C.lo = args.ph_lo; C.hi = args.ph_hi;
    phases_front(C);
    layer_tail<0>(C);
    layer_tail<1>(C);
#ifndef NO_PROBE_PASS
    if (args.ph_hi2 > args.ph_lo2) {
        xcd_barrier(bar);
        C.lo = args.ph_lo2; C.hi = args.ph_hi2;
        phases_front(C);
        layer_tail<0>(C);
        layer_tail<1>(C);
    }
#endif
}

extern "C" void kernel_launch(void* const* d_in, const int* in_sizes, int n_in, void* d_out, int out_size, void* d_ws, size_t ws_size, hipStream_t stream) {
    static int grid = 0;
    if (grid == 0) {
        if (n_in != 27 || out_size != T * D || ws_size < WS_END) { fprintf(stderr, "kernel_launch: unexpected shapes n_in %d out %d ws %zu (need %zu)\n", n_in, out_size, ws_size, (size_t)WS_END); grid = -1; return; }
        int dev = 0, cus = 0, per_cu = 0;
        if (hipGetDevice(&dev) != hipSuccess || hipDeviceGetAttribute(&cus, hipDeviceAttributeMultiprocessorCount, dev) != hipSuccess) { grid = -1; return; }
        if (hipFuncSetAttribute((const void*)mega, hipFuncAttributeMaxDynamicSharedMemorySize, LDS_BYTES) != hipSuccess) { fprintf(stderr, "kernel_launch: hipFuncSetAttribute failed\n"); grid = -1; return; }
        if (hipOccupancyMaxActiveBlocksPerMultiprocessor(&per_cu, (const void*)mega, NTHR, LDS_BYTES) != hipSuccess || per_cu < 1) fprintf(stderr, "kernel_launch: occupancy query reports %d\n", per_cu);
        (void)hipGetLastError();
        grid = cus;
    }
    if (grid < 0) return;
    if (hipMemsetAsync((char*)d_ws + WS_CTL, 0, CTL_ZERO_BYTES, stream) != hipSuccess) return;
    Args a{};
    for (int i = 0; i < 27; ++i) a.in[i] = (const float*)d_in[i];
    a.out = (float*)d_out; a.ws = (unsigned char*)d_ws;
#if MK_PER_PHASE_LAUNCH
    for (int p = 0; p < N_PHASES; ++p) { a.ph_lo = p; a.ph_hi = p + 1; hipLaunchKernelGGL(mega, dim3(grid), dim3(NTHR), LDS_BYTES, stream, a); }
#else
    a.ph_lo = 0; a.ph_hi = N_PHASES;
#ifdef PROBE_DUP
    a.ph_hi = PROBE_DUP_END; a.ph_lo2 = PROBE_DUP; a.ph_hi2 = N_PHASES;
#endif
    hipLaunchKernelGGL(mega, dim3(grid), dim3(NTHR), LDS_BYTES, stream, a);
#endif
    const hipError_t le = hipPeekAtLastError();
    if (le != hipSuccess) fprintf(stderr, "kernel_launch: launch failed: %s\n", hipGetErrorName(le));
}
```

```cpp
#include <hip/hip_runtime.h>
#include <cstdio>
#include <cstdint>
#include <cstddef>

#ifndef MK_PER_PHASE_LAUNCH
#define MK_PER_PHASE_LAUNCH 0
#endif

#define GAS __attribute__((address_space(1)))
#define LAS __attribute__((address_space(3)))
typedef unsigned short bf16_t;
typedef float f32x4 __attribute__((ext_vector_type(4)));
typedef float f32x2 __attribute__((ext_vector_type(2)));
typedef unsigned u32x4 __attribute__((ext_vector_type(4)));
typedef unsigned u32x2 __attribute__((ext_vector_type(2)));

constexpr int D = 1024, BATCH = 4, SEQ = 8192, CTX = 256, T = BATCH * SEQ, SEQA = SEQ + CTX, TA = BATCH * SEQA;
constexpr int NH = 8, HD = 64, DV = 128;
constexpr int SGU_DFF = 2048, SGU_CH = 128, SGU_G = 8, SGU_GC = 256;
constexpr int NE = 256, TOPK = 8, NGRP = 8, EDFF = 256;
constexpr int TK = T * TOPK;
constexpr int HML = 2048;
constexpr int PADM = 256;
constexpr int PMAX = TK + NE * PADM;
constexpr float LN_EPS = 1e-5f, ALPHA = 1.4142135623730951f, ROUTED_SCALE = 2.5f;
constexpr float LAM_INIT = 0.2f;
constexpr int NWAVES = 8, NTHR = 512;

constexpr size_t MiB = 1u << 20;
constexpr size_t WS_CTL = 0, CTL_ZERO_BYTES = 1 * MiB;
constexpr int CW_BAR = 4096;
constexpr int CW_CNT = 32768;
constexpr int CW_CVQ = 33792;
constexpr size_t WS_MODV = 1 * MiB;
constexpr size_t WS_ROPE = WS_MODV + 512 * 1024;
constexpr size_t WS_IDX = 2 * MiB, WS_WGT = 3 * MiB, WS_POS = 4 * MiB;
constexpr size_t WS_SPAIR = 5 * MiB, WS_SW = 7 * MiB;
constexpr size_t WS_WIN_T = 16 * MiB;
constexpr size_t WS_WOUT_T = 22 * MiB;
constexpr size_t WS_SWIN_T = 24 * MiB;
constexpr size_t WS_SWOUT_T = 32 * MiB;
constexpr size_t WS_SHUP_T = 36 * MiB;
constexpr size_t WS_SHDN_T = 38 * MiB;
constexpr size_t WS_RW_T = 40 * MiB;
constexpr size_t WS_WSB = 46 * MiB;
constexpr size_t WS_VSTAT = 47 * MiB;
constexpr size_t WS_EUP_T = 48 * MiB;
constexpr size_t WS_EDN_T = 560 * MiB;
constexpr size_t WS_R = 816 * MiB;
constexpr size_t WS_HALL = WS_R, WS_Q = WS_R + 66 * MiB, WS_K = WS_R + 132 * MiB, WS_V = WS_R + 198 * MiB, WS_OATT = WS_R + 264 * MiB, WS_ATT = WS_R + 520 * MiB;
constexpr size_t WS_U = WS_R, WS_VB = WS_R + 128 * MiB, WS_GSP = WS_R + 256 * MiB, WS_VN = WS_R + 384 * MiB;
constexpr size_t WS_HO = WS_R;
constexpr size_t WS_Y = WS_R + 640 * MiB;
constexpr size_t WS_X1 = WS_Y + 64 * MiB;
constexpr size_t WS_HM = WS_X1 + 128 * MiB;
constexpr size_t WS_H1 = WS_HM + 128 * MiB;
constexpr size_t WS_LOG = WS_H1 + 64 * MiB;
constexpr size_t WS_HS = WS_LOG + 32 * MiB;
constexpr size_t WS_END = WS_HS + 176 * MiB;
static_assert(WS_END <= (size_t)2048 * MiB, "workspace map exceeds 2 GiB");
static_assert((size_t)(PMAX + T) * EDFF * 2 <= 176 * MiB && (size_t)TA * D * 2 <= 66 * MiB && (size_t)(TK + T + 1) * D * 2 <= 640 * MiB, "ws sizes");
static_assert((size_t)(PMAX + T) * 4 <= 2 * MiB, "slot tables");

constexpr int LDS_BYTES = 163840;
constexpr int LDS_MISC = 131072;
constexpr int LDS_PS = LDS_MISC + 256;
constexpr int LDS_PTRS = LDS_MISC + 1536;
constexpr int LDS_TAB = LDS_MISC + 2048;
constexpr int MAXU_UP = 14, MAXU_DN = 28;
constexpr int LDS_R0 = LDS_TAB + 28 * 1024;
static_assert(LDS_R0 + 128 <= LDS_BYTES, "LDS map");

#define XB_TMO      128
#define XB_XCNT(j)  (256  + 64 * (j))
#define XB_XSUB(j)  (1280 + 64 * (j))
#define XB_XGEN(j)  (2304 + 64 * (j))
#define XB_TOP      3328
#define XB_TOPGEN   3392
#define XCD_BAR_WORDS 3456
#define XB_SPIN_CAP (1u << 22)

__device__ __forceinline__ unsigned xb_ld(unsigned* p)              { return __hip_atomic_load(p, __ATOMIC_RELAXED, __HIP_MEMORY_SCOPE_AGENT); }
__device__ __forceinline__ unsigned xb_add(unsigned* p, unsigned v) { return __hip_atomic_fetch_add(p, v, __ATOMIC_RELAXED, __HIP_MEMORY_SCOPE_AGENT); }
__device__ __forceinline__ unsigned xb_xcc_id() { return (unsigned)__builtin_amdgcn_s_getreg((3 << 11) | 20) & 0xFu; }
#define XB_SPIN(cond, bar) do { unsigned _sp = 0; while (cond) { __builtin_amdgcn_s_sleep(1); \
    if ((++_sp & 255u) == 0u) { if (xb_ld(&(bar)[XB_TMO])) break; if (_sp > XB_SPIN_CAP) { atomicAdd(&(bar)[XB_TMO], 1u); break; } } } } while (0)

struct XcdBarrier { unsigned* bar; unsigned x; volatile LAS unsigned* st; };

__device__ __forceinline__ XcdBarrier xcd_barrier_post(unsigned* bar, volatile LAS unsigned* st) {
    XcdBarrier b; b.bar = bar; b.x = xb_xcc_id(); b.st = st;
    if (threadIdx.x == 0) (void)xb_add(&bar[XB_XCNT(b.x)], 1u);
    return b;
}
__device__ __forceinline__ void xcd_barrier_complete(unsigned* bar, unsigned x, unsigned& nloc, unsigned& nx) {
    const unsigned G = gridDim.x * gridDim.y * gridDim.z;
    unsigned sum, cnt, mine, sp = 0u;
    for (;;) {
        sum = 0u; cnt = 0u; mine = 0u;
#pragma unroll
        for (unsigned j = 0; j < 16; ++j) { const unsigned c = xb_ld(&bar[XB_XCNT(j)]); sum += c; cnt += (c > 0u) ? 1u : 0u; mine = (j == x) ? c : mine; }
        if (sum == G) break;
        __builtin_amdgcn_s_sleep(1);
        if ((++sp & 255u) == 0u) { if (xb_ld(&bar[XB_TMO])) break; if (sp > XB_SPIN_CAP) { atomicAdd(&bar[XB_TMO], 1u); break; } }
    }
    nloc = mine > 0u ? mine : 1u; nx = cnt > 0u ? cnt : 1u;
}
__device__ __forceinline__ void xcd_barrier(const XcdBarrier& b) {
    asm volatile("s_waitcnt vmcnt(0)" ::: "memory");
    __syncthreads();
    if (threadIdx.x == 0) {
        unsigned* bar = b.bar;
        __builtin_amdgcn_s_waitcnt(0);
        unsigned nloc = b.st[0], nx = b.st[1];
        if (nloc == 0u) { xcd_barrier_complete(bar, b.x, nloc, nx); b.st[0] = nloc; b.st[1] = nx; }
        const unsigned old = xb_add(&bar[XB_XSUB(b.x)], 1u);
        const unsigned gen = old / nloc;
        if (old + 1u == (gen + 1u) * nloc) {
            __builtin_amdgcn_fence(__ATOMIC_RELEASE, "agent");
            asm volatile("s_waitcnt vmcnt(0)" ::: "memory");
            const unsigned og = xb_add(&bar[XB_TOP], 1u);
            const unsigned tg = og / nx;
            if (og + 1u == (tg + 1u) * nx) xb_add(&bar[XB_TOPGEN], 1u);
            else XB_SPIN(xb_ld(&bar[XB_TOPGEN]) == tg, bar);
            __builtin_amdgcn_fence(__ATOMIC_ACQUIRE, "agent");
            xb_add(&bar[XB_XGEN(b.x)], 1u);
            asm volatile("s_waitcnt vmcnt(0)" ::: "memory");
        } else {
            XB_SPIN(xb_ld(&bar[XB_XGEN(b.x)]) == gen, bar);
            __builtin_amdgcn_fence(__ATOMIC_ACQUIRE, "agent");
            asm volatile("s_waitcnt vmcnt(0)" ::: "memory");
        }
    }
    __syncthreads();
}

__device__ __forceinline__ unsigned f2bf(float f) { unsigned u = __builtin_bit_cast(unsigned, f); return (u + 0x7fffu + ((u >> 16) & 1u)) >> 16; }
__device__ __forceinline__ float bf2f(unsigned b) { return __builtin_bit_cast(float, b << 16); }
__device__ __forceinline__ unsigned pk2(float lo, float hi) { return f2bf(lo) | (f2bf(hi) << 16); }
__device__ __forceinline__ float wave_sum(float v) {
#pragma unroll
    for (int o = 1; o < 64; o <<= 1) v += __shfl_xor(v, o);
    return v;
}
__device__ __forceinline__ float siluf(float x) { return x / (1.f + __expf(-x)); }
__device__ __forceinline__ float sigmoidf_(float x) { return 1.f / (1.f + __expf(-x)); }
__device__ __forceinline__ float gelu_erf(float x) { return 0.5f * x * (1.f + erff(x * 0.70710678118654752f)); }

template <class LoadA, class Epi>
__device__ __forceinline__ void gemm_tile(const LoadA& la, const float* __restrict__ W, int ldw, int K, int m0, int n0, float* sm, const Epi& E) {
    const int tid = threadIdx.x, ty = tid >> 4, tx = tid & 15;
    float* As = sm; float* Bs = sm + 16 * 132;
    f32x4 acc[4][2];
#pragma unroll
    for (int i = 0; i < 4; ++i) { acc[i][0] = (f32x4){0.f, 0.f, 0.f, 0.f}; acc[i][1] = (f32x4){0.f, 0.f, 0.f, 0.f}; }
    const int ar = tid >> 2, k4 = (tid & 3) * 4;
    const int bk = tid >> 5, bn = (tid & 31) * 4;
    const float* bp = W + (size_t)bk * ldw + n0 + bn;
    for (int k0 = 0; k0 < K; k0 += 16) {
        const f32x4 a = la(m0 + ar, k0 + k4);
        const f32x4 b = *(const f32x4*)(bp + (size_t)k0 * ldw);
        __syncthreads();
        As[(k4 + 0) * 132 + ar] = a.x; As[(k4 + 1) * 132 + ar] = a.y; As[(k4 + 2) * 132 + ar] = a.z; As[(k4 + 3) * 132 + ar] = a.w;
        *(f32x4*)&Bs[bk * 128 + bn] = b;
        __syncthreads();
#pragma unroll 4
        for (int kk = 0; kk < 16; ++kk) {
            const f32x4 av = *(const f32x4*)&As[kk * 132 + ty * 4];
            const f32x4 b0 = *(const f32x4*)&Bs[kk * 128 + tx * 8], b1 = *(const f32x4*)&Bs[kk * 128 + tx * 8 + 4];
#pragma unroll
            for (int i = 0; i < 4; ++i) { acc[i][0] += b0 * av[i]; acc[i][1] += b1 * av[i]; }
        }
    }
#pragma unroll
    for (int i = 0; i < 4; ++i) E(m0 + ty * 4 + i, n0 + tx * 8, acc[i][0], acc[i][1]);
}
struct LoadBf16 {
    const bf16_t* A; int lda; const int* rowidx;
    __device__ __forceinline__ f32x4 operator()(int r, int k) const {
        const int rr = rowidx ? rowidx[r] : r;
        const u32x2 w = *(const u32x2*)(A + (size_t)rr * lda + k);
        return (f32x4){bf2f(w.x & 0xffffu), bf2f(w.x >> 16), bf2f(w.y & 0xffffu), bf2f(w.y >> 16)};
    }
};
struct LoadF32 {
    const float* A; int lda;
    __device__ __forceinline__ f32x4 operator()(int r, int k) const { return *(const f32x4*)(A + (size_t)r * lda + k); }
};

namespace pg8 {
typedef short bf16x8 __attribute__((ext_vector_type(8)));
constexpr int BM = 256, BK = 64, HALF = 128, HTB = HALF * BK * 2, STAGE_BYTES = 8 * HTB, NXCD = 8, WGM = 8;
__host__ __device__ __forceinline__ int lds_byte(int r, int c) { const int st = (r >> 4) * 2 + (c >> 5), rr = r & 15, cc = c & 31, ob = rr * 64 + cc * 2; return st * 1024 + (ob ^ (((ob >> 9) & 1) << 5)); }
__host__ __device__ __forceinline__ void stage_rc(int b, int& R, int& C) { const int st = b / 1024, sb = b % 1024, swz = sb ^ (((sb >> 9) & 1) << 5); R = (st >> 1) * 16 + swz / 64; C = (st & 1) * 32 + (swz % 64) / 2; }
__host__ __device__ __forceinline__ int perm32(int rho) { const int n = rho >> 4, i = rho & 15; return 8 * (i >> 2) + 4 * n + (i & 3); }

struct Unit { int pm, pn, row0, e, ord; };

__device__ __forceinline__ unsigned cvt_pk_bf16(float lo, float hi) { unsigned r; asm volatile("v_cvt_pk_bf16_f32 %0, %1, %2" : "=v"(r) : "v"(lo), "v"(hi)); return r; }
__device__ __forceinline__ f32x2 gelu_pk(f32x2 v) {
    const f32x2 av = __builtin_elementwise_abs(v), d = av * 0.2316418882f + 1.0f;
    f32x2 t; t.x = __builtin_amdgcn_rcpf(d.x); t.y = __builtin_amdgcn_rcpf(d.y);
    f32x2 q = t * 0.5307027145f + (-0.7265760135f); q = q * t + 0.7107068705f; q = q * t + (-0.142248368f); q = q * t + 0.127414796f; q = q * t;
    const f32x2 s = (v * v) * (-0.72134752044f);
    f32x2 e; e.x = __builtin_amdgcn_exp2f(s.x); e.y = __builtin_amdgcn_exp2f(s.y);
    const f32x2 m = v * (q * e), r = v - m;
    f32x2 o; o.x = v.x < 0.f ? m.x : r.x; o.y = v.y < 0.f ? m.y : r.y; return o;
}
template <int ACT> struct EpiBf16 {
    static constexpr bool PERM = true;
    bf16_t* O; int ldc; const float* bias; int split_cols; size_t split_stride;
    __device__ __forceinline__ void operator()(const f32x4 (&acc)[2][2][4][2], const Unit& u, int wr, int wc, int fr, int fq) const {
        const int row0 = u.pm * BM + wr * 64 + fr; int colt = u.pn * BM; bf16_t* base = O;
        if (split_cols) { const int t = colt / split_cols; base += (size_t)t * split_stride; colt -= t * split_cols; }
        const int col0 = colt + wc * 32 + 8 * fq, bcol0 = u.pn * BM + wc * 32 + 8 * fq;
        f32x4 bv[2][2];
#pragma unroll
        for (int bj = 0; bj < 2; ++bj)
#pragma unroll
            for (int n = 0; n < 2; ++n) bv[bj][n] = bias ? *(const f32x4*)(bias + bcol0 + bj * HALF + 4 * n) : (f32x4){0.f, 0.f, 0.f, 0.f};
#pragma unroll
        for (int ai = 0; ai < 2; ++ai)
#pragma unroll
            for (int m = 0; m < 4; ++m) { bf16_t* rowp = base + (size_t)(row0 + ai * HALF + m * 16) * ldc + col0;
#pragma unroll
                for (int bj = 0; bj < 2; ++bj) { f32x4 v0 = acc[ai][bj][m][0] + bv[bj][0], v1 = acc[ai][bj][m][1] + bv[bj][1];
                    if (ACT == 1) { f32x2 a = gelu_pk((f32x2){v0[0], v0[1]}), b = gelu_pk((f32x2){v0[2], v0[3]}), c = gelu_pk((f32x2){v1[0], v1[1]}), d = gelu_pk((f32x2){v1[2], v1[3]});
                        v0 = (f32x4){a.x, a.y, b.x, b.y}; v1 = (f32x4){c.x, c.y, d.x, d.y}; }
                    u32x4 w; w.x = cvt_pk_bf16(v0[0], v0[1]); w.y = cvt_pk_bf16(v0[2], v0[3]); w.z = cvt_pk_bf16(v1[0], v1[1]); w.w = cvt_pk_bf16(v1[2], v1[3]);
                    *(u32x4*)(rowp + bj * HALF) = w; } }
    }
};
struct EpiSguIn {
    static constexpr bool PERM = true;
    bf16_t* U; bf16_t* VB; const float* bias; float* vsum;
    __device__ __forceinline__ void operator()(const f32x4 (&acc)[2][2][4][2], const Unit& u, int wr, int wc, int fr, int fq) const {
        const int row0 = u.pm * BM + wr * 64 + fr, colt = u.pn * BM; const bool gate = colt >= SGU_DFF;
        bf16_t* base = gate ? VB : U; const int col0 = (gate ? colt - SGU_DFF : colt) + wc * 32 + 8 * fq, bcol0 = colt + wc * 32 + 8 * fq;
        f32x4 bv[2][2];
#pragma unroll
        for (int bj = 0; bj < 2; ++bj)
#pragma unroll
            for (int n = 0; n < 2; ++n) bv[bj][n] = *(const f32x4*)(bias + bcol0 + bj * HALF + 4 * n);
#pragma unroll
        for (int ai = 0; ai < 2; ++ai)
#pragma unroll
            for (int m = 0; m < 4; ++m) { const int r = row0 + ai * HALF + m * 16; bf16_t* rowp = base + (size_t)r * SGU_DFF + col0; float s1 = 0.f, s2 = 0.f;
#pragma unroll
                for (int bj = 0; bj < 2; ++bj) { f32x4 v0 = acc[ai][bj][m][0] + bv[bj][0], v1 = acc[ai][bj][m][1] + bv[bj][1];
                    const f32x2 a = gelu_pk((f32x2){v0[0], v0[1]}), b = gelu_pk((f32x2){v0[2], v0[3]}), c = gelu_pk((f32x2){v1[0], v1[1]}), d = gelu_pk((f32x2){v1[2], v1[3]});
                    u32x4 w; w.x = cvt_pk_bf16(a.x, a.y); w.y = cvt_pk_bf16(b.x, b.y); w.z = cvt_pk_bf16(c.x, c.y); w.w = cvt_pk_bf16(d.x, d.y);
                    *(u32x4*)(rowp + bj * HALF) = w;
                    if (gate) { s1 += (a.x + a.y) + (b.x + b.y) + (c.x + c.y) + (d.x + d.y); s2 += (a.x * a.x + a.y * a.y) + (b.x * b.x + b.y * b.y) + (c.x * c.x + c.y * c.y) + (d.x * d.x + d.y * d.y); } }
                if (gate) { s1 += __shfl_xor(s1, 16); s1 += __shfl_xor(s1, 32); s2 += __shfl_xor(s2, 16); s2 += __shfl_xor(s2, 32);
                    if (fq == 0) { atomicAdd(vsum + 2 * r, s1); atomicAdd(vsum + 2 * r + 1, s2); } } }
    }
};
struct EpiF32 {
    static constexpr bool PERM = false;
    float* C; int ldc;
    __device__ __forceinline__ void operator()(const f32x4 (&acc)[2][2][4][2], const Unit& u, int wr, int wc, int fr, int fq) const {
        const int row0 = u.pm * BM + wr * 64 + fr, col0 = u.pn * BM + wc * 32 + 4 * fq;
#pragma unroll
        for (int ai = 0; ai < 2; ++ai)
#pragma unroll
            for (int m = 0; m < 4; ++m) { float* rowp = C + (size_t)(row0 + ai * HALF + m * 16) * ldc + col0;
#pragma unroll
                for (int bj = 0; bj < 2; ++bj)
#pragma unroll
                    for (int n = 0; n < 2; ++n) *(f32x4*)(rowp + bj * HALF + n * 16) = acc[ai][bj][m][n]; }
    }
};
struct EpiQKV {
    static constexpr bool PERM = true;
    bf16_t* Q; size_t stride; const float* rope; float qscale;
    __device__ __forceinline__ void operator()(const f32x4 (&acc)[2][2][4][2], const Unit& u, int wr, int wc, int fr, int fq) const {
        const int row0 = u.pm * BM + wr * 64 + fr, colt = u.pn * BM, t = colt >> 10, cbase = colt & 1023;
        bf16_t* base = Q + (size_t)t * stride;
        const bool do_rope = (t < 2) && ((u.pm % 33) != 32);
        const float sc = (t == 0) ? qscale : 1.f;
        const float sgn = (fq < 2) ? -1.f : 1.f;
        const bool lowhalf = (fq < 2);
#pragma unroll
        for (int ai = 0; ai < 2; ++ai)
#pragma unroll
            for (int m = 0; m < 4; ++m) {
                const int r = row0 + ai * HALF + m * 16, nseq = r % SEQA;
                const int pos = (wc & 1) ? (nseq & 63) : (nseq >> 6);
                f32x4 cs[4];
                if (do_rope) { const f32x4* rp = (const f32x4*)(rope + (pos * 16 + 8 * (fq & 1)) * 2);
#pragma unroll
                    for (int q4 = 0; q4 < 4; ++q4) cs[q4] = rp[q4]; }
                const int bq = r / SEQA, hd0 = cbase >> 7;
                bf16_t* rowp = (t == 0) ? base + (size_t)r * D + cbase + wc * 32 + 8 * fq : base + ((size_t)(bq * NH + hd0) * SEQA + nseq) * 128 + wc * 32 + 8 * fq;
                const size_t bjstep = (t == 0) ? (size_t)HALF : (size_t)SEQA * 128;
#pragma unroll
                for (int bj = 0; bj < 2; ++bj) {
                    float v[8];
#pragma unroll
                    for (int n = 0; n < 2; ++n)
#pragma unroll
                        for (int j = 0; j < 4; ++j) v[n * 4 + j] = acc[ai][bj][m][n][j];
                    if (do_rope) {
#pragma unroll
                        for (int i = 0; i < 8; ++i) {
                            const unsigned xb = __builtin_bit_cast(unsigned, v[i]);
                            auto rr = __builtin_amdgcn_permlane32_swap(xb, xb, false, false);
                            const float partner = __builtin_bit_cast(float, lowhalf ? rr[1] : rr[0]);
                            const float c = cs[i >> 1][(i & 1) * 2], s = cs[i >> 1][(i & 1) * 2 + 1];
                            v[i] = v[i] * c + sgn * partner * s;
                        }
                    }
                    u32x4 w; w.x = cvt_pk_bf16(v[0] * sc, v[1] * sc); w.y = cvt_pk_bf16(v[2] * sc, v[3] * sc); w.z = cvt_pk_bf16(v[4] * sc, v[5] * sc); w.w = cvt_pk_bf16(v[6] * sc, v[7] * sc);
                    *(u32x4*)(rowp + bj * bjstep) = w;
                }
            }
    }
};
template <int MAXU> struct EpiMoeUp {
    static constexpr bool PERM = true;
    bf16_t* HS; const LAS float* wtab;
    __device__ __forceinline__ void operator()(const f32x4 (&acc)[2][2][4][2], const Unit& u, int wr, int wc, int fr, int fq) const {
#pragma unroll
        for (int ai = 0; ai < 2; ++ai)
#pragma unroll
            for (int m = 0; m < 4; ++m) {
                const int rr = ai * HALF + wr * 64 + m * 16 + fr;
                const float w = wtab[u.ord * 256 + rr];
                float h[8];
#pragma unroll
                for (int n = 0; n < 2; ++n)
#pragma unroll
                    for (int j = 0; j < 4; ++j) { const float g = acc[ai][0][m][n][j], up = acc[ai][1][m][n][j]; h[n * 4 + j] = w * up * g * __builtin_amdgcn_rcpf(1.f + __expf(-g)); }
                u32x4 o; o.x = cvt_pk_bf16(h[0], h[1]); o.y = cvt_pk_bf16(h[2], h[3]); o.z = cvt_pk_bf16(h[4], h[5]); o.w = cvt_pk_bf16(h[6], h[7]);
                *(u32x4*)(HS + (size_t)(u.row0 + rr) * EDFF + u.pn * 128 + wc * 32 + 8 * fq) = o;
            }
    }
};
struct EpiSharedUp {
    static constexpr bool PERM = true;
    bf16_t* HS;
    __device__ __forceinline__ void operator()(const f32x4 (&acc)[2][2][4][2], const Unit& u, int wr, int wc, int fr, int fq) const {
#pragma unroll
        for (int ai = 0; ai < 2; ++ai)
#pragma unroll
            for (int m = 0; m < 4; ++m) {
                const int rr = u.pm * BM + ai * HALF + wr * 64 + m * 16 + fr;
                float h[8];
#pragma unroll
                for (int n = 0; n < 2; ++n)
#pragma unroll
                    for (int j = 0; j < 4; ++j) { const float g = acc[ai][0][m][n][j], up = acc[ai][1][m][n][j]; h[n * 4 + j] = up * g * __builtin_amdgcn_rcpf(1.f + __expf(-g)); }
                u32x4 o; o.x = cvt_pk_bf16(h[0], h[1]); o.y = cvt_pk_bf16(h[2], h[3]); o.z = cvt_pk_bf16(h[4], h[5]); o.w = cvt_pk_bf16(h[6], h[7]);
                *(u32x4*)(HS + (size_t)(PMAX + rr) * EDFF + u.pn * 128 + wc * 32 + 8 * fq) = o;
            }
    }
};
template <int MAXU> struct EpiMoeDown {
    static constexpr bool PERM = true;
    bf16_t* HO; const LAS int* ptab;
    __device__ __forceinline__ void operator()(const f32x4 (&acc)[2][2][4][2], const Unit& u, int wr, int wc, int fr, int fq) const {
#pragma unroll
        for (int ai = 0; ai < 2; ++ai)
#pragma unroll
            for (int m = 0; m < 4; ++m) {
                const int rr = ai * HALF + wr * 64 + m * 16 + fr;
                int p = ptab[u.ord * 256 + rr]; p = p < 0 ? (TK + T) : p;
                bf16_t* rowp = HO + (size_t)p * D + u.pn * BM + wc * 32 + 8 * fq;
#pragma unroll
                for (int bj = 0; bj < 2; ++bj) { const f32x4 v0 = acc[ai][bj][m][0], v1 = acc[ai][bj][m][1];
                    u32x4 o; o.x = cvt_pk_bf16(v0[0], v0[1]); o.y = cvt_pk_bf16(v0[2], v0[3]); o.z = cvt_pk_bf16(v1[0], v1[1]); o.w = cvt_pk_bf16(v1[2], v1[3]);
                    *(u32x4*)(rowp + bj * HALF) = o; }
            }
    }
};

struct DenseSched {
    const char* A; const char* Bt; int K, lda, nM, nN, nwg, G, c;
    __device__ __forceinline__ void init(const void* A_, const void* Bt_, int M, int N, int K_, int G_, int c_, int lda_ = 0) { A = (const char*)A_; Bt = (const char*)Bt_; K = K_; lda = lda_ ? lda_ : K_; nM = M / BM; nN = N / BM; nwg = nM * nN; G = G_; c = c_; }
    __device__ __forceinline__ bool next(int i, Unit& u) const {
        const long L = (long)i * G + c; if (L >= nwg) return false;
        int wgid = (int)L; { const int q = nwg / NXCD, r = nwg % NXCD, xcd = wgid % NXCD, off = wgid / NXCD; wgid = (xcd < r ? xcd * (q + 1) : r * (q + 1) + (xcd - r) * q) + off; }
        const int nig = WGM * nN, gid = wgid / nig, fm = gid * WGM, gsz = (nM - fm) < WGM ? (nM - fm) : WGM;
        u.pm = fm + ((wgid % nig) % gsz); u.pn = (wgid % nig) / gsz; u.row0 = 0; u.e = 0; u.ord = i; return true;
    }
    __device__ __forceinline__ const char* a_base() const { return A; }
    __device__ __forceinline__ unsigned a_off(const Unit& u, int h, int R, int C) const { return (unsigned)(((u.pm * BM + h * HALF + R) * lda + C) * 2); }
    __device__ __forceinline__ const char* b_base(const Unit& u) const { return Bt + (size_t)u.pn * BM * K * 2; }
};
template <bool GATHER, int MAXU> struct MoeSched {
    const char* A; const char* Bexp; const char* Bsh; size_t b_estride; int K, lda, NPN, x, r, W, nsh;
    const LAS int* ps; const LAS int* xps; const LAS int* ptab;
    __device__ __forceinline__ bool next_any(int i, Unit& u) const {
        const int uu = i * W + r, nrt = __builtin_amdgcn_readfirstlane(xps[32]), tot = (nrt + nsh) * NPN; if (uu >= tot) return false;
        const int rtl = uu / NPN; u.pn = uu % NPN; u.pm = 0; u.ord = i;
        if (rtl < nrt) { int a = 0, b = 32; while (b - a > 1) { const int mid = (a + b) >> 1; if (__builtin_amdgcn_readfirstlane(xps[mid]) <= rtl) a = mid; else b = mid; }
            u.e = x + 8 * a; u.row0 = __builtin_amdgcn_readfirstlane(ps[u.e]) + (rtl - __builtin_amdgcn_readfirstlane(xps[a])) * BM; }
        else { u.e = NE; u.row0 = PMAX + (x * 16 + (rtl - nrt)) * BM; }
        return true;
    }
    __device__ __forceinline__ int row0_of(int i) const {
        const int uu = i * W + r, nrt = xps[32], tot = (nrt + nsh) * NPN; if (i >= MAXU || uu >= tot) return -1;
        const int rtl = uu / NPN;
        if (rtl < nrt) { int a = 0, b = 32; while (b - a > 1) { const int mid = (a + b) >> 1; if (xps[mid] <= rtl) a = mid; else b = mid; } return ps[x + 8 * a] + (rtl - xps[a]) * BM; }
        return PMAX + (x * 16 + (rtl - nrt)) * BM;
    }
    __device__ __forceinline__ bool next(int i, Unit& u) const { return i < MAXU && next_any(i, u); }
    __device__ __forceinline__ const char* a_base() const { return A; }
    __device__ __forceinline__ unsigned a_off(const Unit& u, int h, int R, int C) const {
        const int row = h * HALF + R;
        if (GATHER) { const int p = ptab[u.ord * 256 + row]; const int tok = p < 0 ? 0 : (p < TK ? (p >> 3) : (p - TK)); return (unsigned)((tok * lda + C) * 2); }
        else return (unsigned)(((u.row0 + row) * lda + C) * 2);
    }
    __device__ __forceinline__ const char* b_base(const Unit& u) const { return (u.e < NE ? Bexp + (size_t)u.e * b_estride : Bsh) + (size_t)u.pn * BM * K * 2; }
};

template <class Epi, class Sched, bool ALIGN_EPI, int AWRAP = 0>
__device__ __forceinline__ void gemm_phase(LAS unsigned char* lds, const int K, const Sched& S, const Epi& E) {
    const int tid = threadIdx.x, wid = __builtin_amdgcn_readfirstlane(tid >> 6), lane = tid & 63, wr = wid >> 2, wc = wid & 3, fr = lane & 15, fq = lane >> 4;
    const int nt = K / BK;
    int sR[2], sC[2]; unsigned voffB[2];
#pragma unroll
    for (int i = 0; i < 2; ++i) { int R, C; stage_rc(tid * 16 + i * 8192, R, C); sR[i] = R; sC[i] = C; const int Rb = Epi::PERM ? ((R & ~31) + perm32(R & 31)) : R; voffB[i] = (unsigned)(Rb * K + C) * 2u; }
    const size_t kstep = (size_t)(BK * 2);
    const size_t hstep = (size_t)HALF * K * 2;
    const unsigned ldsw = (unsigned)wid * 1024u;
    const int aoff = lds_byte(wr * 64 + fr, fq * 8), boff = lds_byte(wc * 32 + fr, fq * 8);
#define PG8_SA(b, h) (((b) * 2 + (h)) * HTB)
#define PG8_SB(b, h) ((4 + (b) * 2 + (h)) * HTB)
#define PG8_STAGE(bufoff, gbase, voff) do { _Pragma("unroll") for (int _i = 0; _i < 2; ++_i) \
        __builtin_amdgcn_global_load_lds((const unsigned*)((const char*)(gbase) + (voff)[_i]), (LAS unsigned*)(lds + (bufoff) + ldsw + _i * 8192), 16, 0, 0); } while (0)
#define PG8_LDA(dst, b, h) do { _Pragma("unroll") for (int m = 0; m < 4; ++m) _Pragma("unroll") for (int k = 0; k < 2; ++k) dst[m][k] = *(const LAS bf16x8*)(lds + PG8_SA(b, h) + aoff + m * 2048 + k * 1024); } while (0)
#define PG8_LDB(dst, b, h) do { _Pragma("unroll") for (int n = 0; n < 2; ++n) _Pragma("unroll") for (int k = 0; k < 2; ++k) dst[n][k] = *(const LAS bf16x8*)(lds + PG8_SB(b, h) + boff + n * 2048 + k * 1024); } while (0)
#define PG8_MMA(ai, bj, At, Bt) do { __builtin_amdgcn_s_setprio(1); _Pragma("unroll") for (int m = 0; m < 4; ++m) _Pragma("unroll") for (int n = 0; n < 2; ++n) _Pragma("unroll") for (int k = 0; k < 2; ++k) \
        acc[ai][bj][m][n] = __builtin_amdgcn_mfma_f32_16x16x32_bf16(Bt[n][k], At[m][k], acc[ai][bj][m][n], 0, 0, 0); __builtin_amdgcn_s_setprio(0); } while (0)
#define PG8_WAIT_V(n) asm volatile("s_waitcnt vmcnt(" #n ")" ::: "memory")
#define PG8_WAIT_L(n) asm volatile("s_waitcnt lgkmcnt(" #n ")" ::: "memory")
#define PG8_BAR __builtin_amdgcn_s_barrier()
#define PG8_SCHED __builtin_amdgcn_sched_barrier(0)
    Unit cur, nxt; int ui = 0;
    if (!S.next(0, cur)) return;
    f32x4 acc[2][2][4][2];
#pragma unroll
    for (int a = 0; a < 2; ++a)
#pragma unroll
        for (int b = 0; b < 2; ++b)
#pragma unroll
            for (int m = 0; m < 4; ++m)
#pragma unroll
                for (int n = 0; n < 2; ++n) acc[a][b][m][n] = (f32x4){0.f, 0.f, 0.f, 0.f};
    bf16x8 At[4][2], B0[2][2], B1[2][2];
    unsigned cao[2][2], nao[2][2];
#pragma unroll
    for (int h = 0; h < 2; ++h)
#pragma unroll
        for (int i = 0; i < 2; ++i) cao[h][i] = S.a_off(cur, h, sR[i], sC[i]);
    const char* const Ab = S.a_base();
    const char* cB = S.b_base(cur);
    PG8_STAGE(PG8_SB(0, 0), cB, voffB); PG8_STAGE(PG8_SB(0, 1), cB + hstep, voffB); PG8_STAGE(PG8_SA(0, 0), Ab, cao[0]); PG8_STAGE(PG8_SA(0, 1), Ab, cao[1]);
    if (wr == 1) PG8_BAR;
    PG8_WAIT_V(2); PG8_BAR;
    PG8_STAGE(PG8_SB(1, 0), cB + kstep, voffB); PG8_STAGE(PG8_SA(1, 0), Ab + kstep, cao[0]); PG8_STAGE(PG8_SB(1, 1), cB + hstep + kstep, voffB);
    PG8_WAIT_V(6); PG8_BAR;
    for (;;) {
        const bool has_next = S.next(ui + 1, nxt);
        const char* nB = has_next ? S.b_base(nxt) : cB;
#pragma unroll
        for (int h = 0; h < 2; ++h)
#pragma unroll
            for (int i = 0; i < 2; ++i) nao[h][i] = has_next ? S.a_off(nxt, h, sR[i], sC[i]) : cao[h][i];
#pragma nounroll
        for (int t = 0; t < nt; t += 2) {
            const bool last = (t == nt - 2);
            const int ta1 = AWRAP ? (t + 1) % AWRAP : (t + 1), ta2 = AWRAP ? (t + 2) % AWRAP : (t + 2);
            const char* a1 = Ab + (size_t)ta1 * kstep;
            const char* a2 = last ? Ab : Ab + (size_t)ta2 * kstep; const char* b2 = last ? nB : cB + (size_t)(t + 2) * kstep;
            const char* a3 = a2 + kstep; const char* b3 = b2 + kstep;
            unsigned o2[2][2];
#pragma unroll
            for (int h = 0; h < 2; ++h)
#pragma unroll
                for (int i = 0; i < 2; ++i) o2[h][i] = last ? nao[h][i] : cao[h][i];
            PG8_LDB(B0, 0, 0); PG8_LDB(B1, 0, 1); PG8_SCHED; PG8_LDA(At, 0, 0); PG8_STAGE(PG8_SA(1, 1), a1, cao[1]);
            PG8_WAIT_V(8); PG8_WAIT_L(0); PG8_BAR; PG8_MMA(0, 0, At, B0); PG8_MMA(0, 1, At, B1); PG8_BAR; PG8_SCHED;
            PG8_LDA(At, 0, 1); PG8_STAGE(PG8_SB(0, 0), b2, voffB); PG8_STAGE(PG8_SB(0, 1), b2 + hstep, voffB); PG8_STAGE(PG8_SA(0, 0), a2, o2[0]);
            PG8_WAIT_V(8); PG8_WAIT_L(0); PG8_BAR; PG8_MMA(1, 0, At, B0); PG8_MMA(1, 1, At, B1); PG8_BAR; PG8_SCHED;
            PG8_LDB(B0, 1, 0); PG8_LDB(B1, 1, 1); PG8_SCHED; PG8_LDA(At, 1, 0); PG8_STAGE(PG8_SA(0, 1), a2, o2[1]);
            PG8_WAIT_V(8); PG8_WAIT_L(0); PG8_BAR; PG8_MMA(0, 0, At, B0); PG8_MMA(0, 1, At, B1); PG8_BAR; PG8_SCHED;
            PG8_LDA(At, 1, 1); PG8_STAGE(PG8_SB(1, 0), b3, voffB); PG8_STAGE(PG8_SB(1, 1), b3 + hstep, voffB); PG8_STAGE(PG8_SA(1, 0), a3, o2[0]);
            PG8_WAIT_V(8); PG8_WAIT_L(0); PG8_BAR; PG8_MMA(1, 0, At, B0); PG8_MMA(1, 1, At, B1); PG8_BAR; PG8_SCHED;
        }
        if constexpr (ALIGN_EPI) { if (wr == 0) PG8_BAR; }
        E(acc, cur, wr, wc, fr, fq);
        if (!has_next) break;
#pragma unroll
        for (int a = 0; a < 2; ++a)
#pragma unroll
            for (int b = 0; b < 2; ++b)
#pragma unroll
                for (int m = 0; m < 4; ++m)
#pragma unroll
                    for (int n = 0; n < 2; ++n) acc[a][b][m][n] = (f32x4){0.f, 0.f, 0.f, 0.f};
        cur = nxt; cB = nB; ++ui;
#pragma unroll
        for (int h = 0; h < 2; ++h)
#pragma unroll
            for (int i = 0; i < 2; ++i) cao[h][i] = nao[h][i];
        if constexpr (ALIGN_EPI) { if (wr == 1) PG8_BAR; }
    }
    PG8_WAIT_V(0);
    if constexpr (!ALIGN_EPI) { if (wr == 0) PG8_BAR; }
    PG8_BAR;
#undef PG8_SA
#undef PG8_SB
#undef PG8_STAGE
#undef PG8_LDA
#undef PG8_LDB
#undef PG8_MMA
#undef PG8_WAIT_V
#undef PG8_WAIT_L
#undef PG8_BAR
#undef PG8_SCHED
}
}

namespace att {
using bf16x8 = __attribute__((ext_vector_type(8))) short;
using s16x4  = __attribute__((ext_vector_type(4))) short;
using f32x16 = __attribute__((ext_vector_type(16))) float;
constexpr int QBLK = 32, KVBLK = 64, UNIT_ROWS = 128, LDR = D, LDKV = 128;
constexpr float SCALE = 0.125f;
constexpr size_t SHM_V = KVBLK * 128 * 2, SHM_K = KVBLK * 128 * 2, SHM_ATTN = 2 * SHM_V + 2 * SHM_K + 8 * 64 * 4;
#define KSWZ(row, colB) ((row) * 256 + ((colB) ^ (((row) & 7) << 4)))
#define SBAR() __builtin_amdgcn_sched_barrier(0)
__device__ __forceinline__ int crow(int r, int hi) { return (r & 3) + 8 * (r >> 2) + 4 * hi; }
__device__ __forceinline__ unsigned cvtpk(float lo, float hi) { unsigned r; asm volatile("v_cvt_pk_bf16_f32 %0, %1, %2" : "=v"(r) : "v"(lo), "v"(hi)); return r; }

__device__ __forceinline__ void qkt(f32x16& p0, f32x16& p1, const bf16_t* Ks, const bf16x8* qr, int r32, int hi, int mp, const f32x16& negm) {
#pragma unroll
  for (int d0 = 0; d0 < 4; ++d0) { int cb = ((mp * 4 + d0) * 16 + hi * 8) * 2;
    bf16x8 b0 = *reinterpret_cast<const bf16x8*>((const char*)Ks + KSWZ(r32, cb));
    bf16x8 b1 = *reinterpret_cast<const bf16x8*>((const char*)Ks + KSWZ(32 + r32, cb));
    if (d0 == 0) { p0 = __builtin_amdgcn_mfma_f32_32x32x16_bf16(b0, qr[0], negm, 0, 0, 0); p1 = __builtin_amdgcn_mfma_f32_32x32x16_bf16(b1, qr[0], negm, 0, 0, 0); }
    else { p0 = __builtin_amdgcn_mfma_f32_32x32x16_bf16(b0, qr[d0], p0, 0, 0, 0); p1 = __builtin_amdgcn_mfma_f32_32x32x16_bf16(b1, qr[d0], p1, 0, 0, 0); } }
}
__device__ __forceinline__ int v_st(int k, int c) { const int kk = (k & ~0xC) | ((k & 4) << 1) | ((k & 8) >> 1); return ((kk >> 3) * 4 + (c >> 5)) * 512 + ((kk & 7) * 32 + (c & 31)) * 2; }
__device__ __forceinline__ int v_rd_base(int lane) { return ((lane & 3) << 3) | (((lane >> 2) & 3) << 6) | (((lane >> 4) & 1) << 5) | (((lane >> 5) & 1) << 8); }
constexpr int v_rd_off(int d0, int ks, int half) { return d0 * 512 + ks * 4096 + half * 2048; }
template <int OFF> __device__ __forceinline__ s16x4 tr_read(int vb) {
  s16x4 r; asm volatile("ds_read_b64_tr_b16 %0, %1 offset:%2" : "=&v"(r) : "v"(vb), "i"(OFF) : "memory"); return r;
}
template <int D0> __device__ __forceinline__ void pv_one(f32x16& od, int vb, bf16x8 pa0, bf16x8 pa1, bf16x8 pa2, bf16x8 pa3) {
  const s16x4 l0 = tr_read<v_rd_off(D0, 0, 0)>(vb), h0 = tr_read<v_rd_off(D0, 0, 1)>(vb), l1 = tr_read<v_rd_off(D0, 1, 0)>(vb), h1 = tr_read<v_rd_off(D0, 1, 1)>(vb);
  const s16x4 l2 = tr_read<v_rd_off(D0, 2, 0)>(vb), h2 = tr_read<v_rd_off(D0, 2, 1)>(vb), l3 = tr_read<v_rd_off(D0, 3, 0)>(vb), h3 = tr_read<v_rd_off(D0, 3, 1)>(vb);
  asm volatile("s_waitcnt lgkmcnt(0)" ::: "memory"); SBAR();
#define PK(L, H) (bf16x8){L[0], L[1], L[2], L[3], H[0], H[1], H[2], H[3]}
  od = __builtin_amdgcn_mfma_f32_32x32x16_bf16(pa0, PK(l0, h0), od, 0, 0, 0);
  od = __builtin_amdgcn_mfma_f32_32x32x16_bf16(pa1, PK(l1, h1), od, 0, 0, 0);
  od = __builtin_amdgcn_mfma_f32_32x32x16_bf16(pa2, PK(l2, h2), od, 0, 0, 0);
  od = __builtin_amdgcn_mfma_f32_32x32x16_bf16(pa3, PK(l3, h3), od, 0, 0, 0);
#undef PK
}
__device__ __forceinline__ void pv_d0(f32x16* o, int vb, bf16x8 pa0, bf16x8 pa1, bf16x8 pa2, bf16x8 pa3) {
  pv_one<0>(o[0], vb, pa0, pa1, pa2, pa3); pv_one<1>(o[1], vb, pa0, pa1, pa2, pa3); pv_one<2>(o[2], vb, pa0, pa1, pa2, pa3); pv_one<3>(o[3], vb, pa0, pa1, pa2, pa3);
}

constexpr float THRL = 8.f;
template <bool first>
__device__ __forceinline__ void softmax_tile(f32x16& p0, f32x16& p1, float& m_ref, float& l_reg, f32x16& negm, f32x16 (&o)[4], float* al_l, int r32, int hi,
                                             bf16x8& pa0, bf16x8& pa1, bf16x8& pa2, bf16x8& pa3) {
  float mx0 = fmaxf(p0[0], p0[1]), mx1 = fmaxf(p0[2], p0[3]), mx2 = fmaxf(p1[0], p1[1]), mx3 = fmaxf(p1[2], p1[3]);
#pragma unroll
  for (int r = 4; r < 16; r += 4) { mx0 = fmaxf(fmaxf(mx0, p0[r]), p0[r + 1]); mx1 = fmaxf(fmaxf(mx1, p0[r + 2]), p0[r + 3]); mx2 = fmaxf(fmaxf(mx2, p1[r]), p1[r + 1]); mx3 = fmaxf(fmaxf(mx3, p1[r + 2]), p1[r + 3]); }
  float rm = fmaxf(fmaxf(mx0, mx1), fmaxf(mx2, mx3));
  { auto rr = __builtin_amdgcn_permlane32_swap(__float_as_uint(rm), __float_as_uint(rm), false, false); rm = fmaxf(__uint_as_float(rr[0]), __uint_as_float(rr[1])); }
  if (first || __any(rm > THRL)) {
    const float dl = first ? rm : fmaxf(rm, 0.f);
    m_ref += dl;
#pragma unroll
    for (int r = 0; r < 16; ++r) { p0[r] -= dl; p1[r] -= dl; }
#pragma unroll
    for (int r = 0; r < 16; ++r) negm[r] = -m_ref;
    if (!first) {
      const float alpha = __builtin_amdgcn_exp2f(-dl); l_reg *= alpha;
      if (hi == 0) al_l[r32] = alpha; asm volatile("s_waitcnt lgkmcnt(0)" ::: "memory");
#pragma unroll
      for (int d = 0; d < 4; ++d)
#pragma unroll
        for (int r = 0; r < 16; ++r) o[d][r] *= al_l[crow(r, hi)];
    }
  }
#pragma unroll
  for (int r = 0; r < 16; ++r) { p0[r] = __builtin_amdgcn_exp2f(p0[r]); p1[r] = __builtin_amdgcn_exp2f(p1[r]); }
  float s0 = p0[0] + p0[1], s1 = p0[2] + p0[3], s2 = p1[0] + p1[1], s3 = p1[2] + p1[3];
#pragma unroll
  for (int r = 4; r < 16; r += 4) { s0 += p0[r]; s1 += p0[r + 2]; s2 += p1[r]; s3 += p1[r + 2]; s0 += p0[r + 1]; s1 += p0[r + 3]; s2 += p1[r + 1]; s3 += p1[r + 3]; }
  float ps = (s0 + s1) + (s2 + s3);
  { auto rr = __builtin_amdgcn_permlane32_swap(__float_as_uint(ps), __float_as_uint(ps), false, false); ps = __uint_as_float(rr[0]) + __uint_as_float(rr[1]); }
  l_reg += ps;
#define PK4(P, BASE, OUT) do { unsigned a0 = cvtpk(P[BASE + 0], P[BASE + 1]), a1 = cvtpk(P[BASE + 2], P[BASE + 3]);   \
    unsigned b0 = cvtpk(P[BASE + 4], P[BASE + 5]), b1 = cvtpk(P[BASE + 6], P[BASE + 7]);                              \
    auto r0 = __builtin_amdgcn_permlane32_swap(a0, b0, false, false); auto r1 = __builtin_amdgcn_permlane32_swap(a1, b1, false, false); \
    u32x4 w = {r0[0], r1[0], r0[1], r1[1]}; OUT = *reinterpret_cast<bf16x8*>(&w); } while (0)
  PK4(p0, 0, pa0); PK4(p0, 8, pa1); PK4(p1, 0, pa2); PK4(p1, 8, pa3);
#undef PK4
}
__device__ __forceinline__ void glds16(const void* gsrc, unsigned lds_dst) { unsigned keep;
  asm volatile("s_mov_b32 %0, m0\n\ts_mov_b32 m0, %2\n\ts_nop 0\n\tglobal_load_lds_dwordx4 %1, off\n\ts_mov_b32 m0, %0" : "=&s"(keep) : "v"(gsrc), "s"(lds_dst) : "memory"); }
constexpr int NSLOT = 4;
__device__ __forceinline__ void attn_unit(const bf16_t* __restrict__ Qb, const bf16_t* __restrict__ Kh, const bf16_t* __restrict__ Vh, bf16_t* __restrict__ Ob,
                                          float lam, const float* __restrict__ gsub, int seq, char* lds, char* wsl) {
  const int tid = threadIdx.x, wid = __builtin_amdgcn_readfirstlane(tid >> 6), lane = tid & 63, r32 = lane & 31, hi = lane >> 5, mp = wid >> 2, wq = wid & 3;
  bf16_t* V_lds = (bf16_t*)lds; bf16_t* K_lds = (bf16_t*)(lds + NSLOT * SHM_V);
  float* ws = (float*)wsl + wid * 64; float* li_l = ws; float* al_l = ws + 32;
  float m_reg = 0.f, l_reg = 0; f32x16 o[4] = {}; f32x16 negm = {}; bf16x8 qr[4];
  const bf16_t* Qw = Qb + (long)(wq * QBLK + r32) * LDR + mp * 64 + hi * 8;
#pragma unroll
  for (int d0 = 0; d0 < 4; ++d0) qr[d0] = *reinterpret_cast<const bf16x8*>(Qw + d0 * 16);
  const int vb0 = (int)(uintptr_t)V_lds + v_rd_base(lane);
  int koff[2], voff[2];
#pragma unroll
  for (int i = 0; i < 2; ++i) { const int p = (i * 8 + wid) * 1024 + lane * 16;
    { const int row = p >> 8, cp = (p & 255) >> 4, cc = cp ^ (row & 7); koff[i] = row * LDKV + cc * 8; }
    { const int st = p >> 9, q = p & 511, kk = (st >> 2) * 8 + (q >> 6), key = (kk & ~0xC) | ((kk & 4) << 1) | ((kk & 8) >> 1), col = (st & 3) * 32 + ((q & 63) >> 4) * 8; voff[i] = key * LDKV + col; } }
  const unsigned ldsV = (unsigned)(uintptr_t)V_lds + wid * 1024, ldsK = (unsigned)(uintptr_t)K_lds + wid * 1024;
#define DMA(t, slot) do { const bf16_t* kt_ = Kh + (long)(t) * KVBLK * LDKV; const bf16_t* vt_ = Vh + (long)(t) * KVBLK * LDKV; \
    glds16(kt_ + koff[0], (unsigned)__builtin_amdgcn_readfirstlane(ldsK + (slot) * SHM_K)); glds16(kt_ + koff[1], (unsigned)__builtin_amdgcn_readfirstlane(ldsK + (slot) * SHM_K + 8192)); \
    glds16(vt_ + voff[0], (unsigned)__builtin_amdgcn_readfirstlane(ldsV + (slot) * SHM_V)); glds16(vt_ + voff[1], (unsigned)__builtin_amdgcn_readfirstlane(ldsV + (slot) * SHM_V + 8192)); } while (0)
#define BAR_L() asm volatile("s_waitcnt lgkmcnt(0)\n\ts_barrier" ::: "memory")
#define BAR_V4() asm volatile("s_waitcnt vmcnt(4) lgkmcnt(0)\n\ts_barrier" ::: "memory")
#define BAR_V0() asm volatile("s_waitcnt vmcnt(0) lgkmcnt(0)\n\ts_barrier" ::: "memory")
  f32x16 p0, p1; bf16x8 pa0, pa1, pa2, pa3; const int NT = seq / KVBLK;
  asm volatile("s_waitcnt vmcnt(0)" ::: "memory");
  DMA(0, 0); DMA(1, 1); BAR_V4();
  int sK = 0, sV = NSLOT - 1, sD = 2;
#define STAGE(j) do { if ((j) + 2 < NT) DMA((j) + 2, sD); } while (0)
#define ENDBAR(j) do { if ((j) + 2 < NT) BAR_V4(); else BAR_V0(); } while (0)
#define ROT() do { sV = sK; sK = (sK == NSLOT - 1) ? 0 : sK + 1; sD = (sD == NSLOT - 1) ? 0 : sD + 1; } while (0)
#define MFMA_BLOCK(doPV, doQK, MP) do { if (doPV) pv_d0(o, vb0 + sV * (int)SHM_V, pa0, pa1, pa2, pa3); \
    if (doQK) qkt(p0, p1, (bf16_t*)((char*)K_lds + sK * SHM_K), qr, r32, hi, MP, negm); } while (0)
#define SMX(FIRST) softmax_tile<FIRST>(p0, p1, m_reg, l_reg, negm, o, al_l, r32, hi, pa0, pa1, pa2, pa3)
  if (mp == 0) {
    STAGE(0); MFMA_BLOCK(false, true, 0); BAR_L(); SMX(true); ENDBAR(0); ROT();
#pragma nounroll
    for (int j = 1; j < NT; ++j) { STAGE(j); MFMA_BLOCK(true, true, 0); BAR_L(); SMX(false); ENDBAR(j); ROT(); }
    MFMA_BLOCK(true, false, 0); BAR_L(); BAR_L();
  } else {
    STAGE(0); BAR_L(); MFMA_BLOCK(false, true, 1); ENDBAR(0); ROT();
    STAGE(1); SMX(true); BAR_L(); MFMA_BLOCK(true, true, 1); ENDBAR(1); ROT();
#pragma nounroll
    for (int j = 2; j < NT; ++j) { STAGE(j); SMX(false); BAR_L(); MFMA_BLOCK(true, true, 1); ENDBAR(j); ROT(); }
    SMX(false); BAR_L(); MFMA_BLOCK(true, false, 1); BAR_L();
  }
#undef DMA
#undef BAR_L
#undef BAR_V4
#undef BAR_V0
#undef STAGE
#undef ENDBAR
#undef ROT
#undef MFMA_BLOCK
#undef SMX
  int lane_e = lane; asm volatile("" : "+v"(lane_e));
  const int r32e = lane_e & 31, hie = lane_e >> 5;
  if (hie == 0) li_l[r32e] = l_reg; asm volatile("s_waitcnt lgkmcnt(0)" ::: "memory");
#pragma unroll
  for (int r = 0; r < 16; ++r) { const float rl = __builtin_amdgcn_rcpf(li_l[crow(r, hie)]);
#pragma unroll
    for (int d0 = 0; d0 < 4; ++d0) o[d0][r] *= rl; }
  __syncthreads();
  float* ex = (float*)lds + wq * 4096;
  if (mp == 1) {
#pragma unroll
    for (int d0 = 0; d0 < 4; ++d0)
#pragma unroll
      for (int r = 0; r < 16; ++r) ex[(d0 * 16 + r) * 64 + lane_e] = o[d0][r];
  }
  __syncthreads();
  if (mp == 0) {
    float gq[4];
#pragma unroll
    for (int d0 = 0; d0 < 4; ++d0) gq[d0] = gsub[d0 * 32 + r32e] * (1.f - LAM_INIT);
    bf16_t* Ow = Ob + (long)(wq * QBLK) * LDR;
#pragma unroll
    for (int r = 0; r < 16; ++r) {
      float ss = 0.f;
#pragma unroll
      for (int d0 = 0; d0 < 4; ++d0) { o[d0][r] -= lam * ex[(d0 * 16 + r) * 64 + lane_e]; ss += o[d0][r] * o[d0][r]; }
      ss += __shfl_xor(ss, 1); ss += __shfl_xor(ss, 2); ss += __shfl_xor(ss, 4); ss += __shfl_xor(ss, 8); ss += __shfl_xor(ss, 16);
      const float rn = 1.f / sqrtf(ss * (1.f / DV) + LN_EPS);
      const int orow = crow(r, hie);
#pragma unroll
      for (int d0 = 0; d0 < 4; ++d0) Ow[(long)orow * LDR + d0 * 32 + r32e] = (bf16_t)f2bf(o[d0][r] * rn * gq[d0]);
    }
  }
  asm volatile("s_waitcnt vmcnt(0)" ::: "memory");
  __syncthreads();
}

struct SguRaw { bf16x8 raw[2][2][2]; f32x2 st[2][2]; };
__device__ __forceinline__ void sgu_load(SguRaw& R, const bf16_t* __restrict__ Vr, const f32x2* __restrict__ vsum, int sr, int sc) {
#pragma unroll
  for (int kh = 0; kh < 2; ++kh)
#pragma unroll
    for (int rr = 0; rr < 2; ++rr) {
#pragma unroll
      for (int ch = 0; ch < 2; ++ch) R.raw[kh][rr][ch] = *reinterpret_cast<const bf16x8*>(Vr + (long)(kh * 64 + rr * 32 + sr) * SGU_DFF + ch * 128 + sc);
      R.st[kh][rr] = vsum[kh * 64 + rr * 32 + sr]; }
}
__device__ __forceinline__ void sgu_chunks(const bf16_t* __restrict__ VBg, const bf16_t* __restrict__ Ug, bf16_t* __restrict__ Gg, const f32x2* __restrict__ vsum,
                                           const float* __restrict__ ng, const float* __restrict__ nb, const float* __restrict__ bs, const bf16x8 (&pa)[2][4],
                                           int chunk0, int cstep, int nchunk, char* lds) {
  const int tid = threadIdx.x, wid = tid >> 6, lane = tid & 63, r32 = lane & 31, hi = lane >> 5, wp = wid & 3, wcol = wid >> 2;
  const int sr = tid >> 4, sc = (tid & 15) * 8;
  float gg[2][8], bb[2][8];
#pragma unroll
  for (int ch = 0; ch < 2; ++ch)
#pragma unroll
    for (int i = 0; i < 8; i += 4) { const f32x4 g4 = *(const f32x4*)(ng + ch * 128 + sc + i), b4 = *(const f32x4*)(nb + ch * 128 + sc + i);
      gg[ch][i] = g4.x; gg[ch][i + 1] = g4.y; gg[ch][i + 2] = g4.z; gg[ch][i + 3] = g4.w; bb[ch][i] = b4.x; bb[ch][i + 1] = b4.y; bb[ch][i + 2] = b4.z; bb[ch][i + 3] = b4.w; }
  float bsr[16];
#pragma unroll
  for (int r = 0; r < 16; ++r) bsr[r] = bs[wp * 32 + crow(r, hi)];
  bf16_t* stg = (bf16_t*)(lds + 65536 + wid * 8192);
  const int vb = (int)(uintptr_t)lds + v_rd_base(lane) + wcol * 16384;
  SguRaw R;
  if (chunk0 < nchunk) sgu_load(R, VBg + (size_t)chunk0 * SGU_CH * SGU_DFF, vsum + (size_t)chunk0 * SGU_CH, sr, sc);
  for (int chunk = chunk0; chunk < nchunk; chunk += cstep) {
#pragma unroll
    for (int kh = 0; kh < 2; ++kh)
#pragma unroll
      for (int rr = 0; rr < 2; ++rr) {
        const float mean = R.st[kh][rr].x * (1.f / SGU_DFF), var = R.st[kh][rr].y * (1.f / SGU_DFF) - mean * mean, rstd = 1.f / sqrtf(fmaxf(var, 0.f) + LN_EPS);
#pragma unroll
        for (int ch = 0; ch < 2; ++ch) { const bf16x8 x = R.raw[kh][rr][ch]; unsigned w[4];
#pragma unroll
          for (int i = 0; i < 8; i += 2) { const float v0 = (bf2f((unsigned short)x[i]) - mean) * rstd * gg[ch][i] + bb[ch][i], v1 = (bf2f((unsigned short)x[i + 1]) - mean) * rstd * gg[ch][i + 1] + bb[ch][i + 1]; w[i >> 1] = cvtpk(v0, v1); }
          *(u32x4*)(lds + (kh * 2 + ch) * 16384 + v_st(rr * 32 + sr, sc)) = (u32x4){w[0], w[1], w[2], w[3]}; }
      }
    __syncthreads();
    if (chunk + cstep < nchunk) sgu_load(R, VBg + (size_t)(chunk + cstep) * SGU_CH * SGU_DFF, vsum + (size_t)(chunk + cstep) * SGU_CH, sr, sc);
    f32x16 o[4] = {};
    pv_d0(o, vb, pa[0][0], pa[0][1], pa[0][2], pa[0][3]);
    pv_d0(o, vb + 2 * 16384, pa[1][0], pa[1][1], pa[1][2], pa[1][3]);
#pragma unroll
    for (int r = 0; r < 16; ++r)
#pragma unroll
      for (int d0 = 0; d0 < 4; ++d0) stg[crow(r, hi) * 128 + d0 * 32 + r32] = (bf16_t)f2bf(o[d0][r] + bsr[r]);
    asm volatile("s_waitcnt lgkmcnt(0)" ::: "memory");
    const size_t cbase = (size_t)chunk * SGU_CH * SGU_DFF;
#pragma unroll
    for (int it = 0; it < 8; ++it) {
      const int row = it * 4 + (lane >> 4), cc = (lane & 15) * 8;
      const u32x4 vm = *(const u32x4*)(stg + row * 128 + cc);
      const size_t off = cbase + (size_t)(wp * 32 + row) * SGU_DFF + wcol * 128 + cc;
      const u32x4 uw = *(const u32x4*)(Ug + off);
      float a[8], u8[8];
      a[0] = bf2f(vm.x & 0xffffu); a[1] = bf2f(vm.x >> 16); a[2] = bf2f(vm.y & 0xffffu); a[3] = bf2f(vm.y >> 16); a[4] = bf2f(vm.z & 0xffffu); a[5] = bf2f(vm.z >> 16); a[6] = bf2f(vm.w & 0xffffu); a[7] = bf2f(vm.w >> 16);
      u8[0] = bf2f(uw.x & 0xffffu); u8[1] = bf2f(uw.x >> 16); u8[2] = bf2f(uw.y & 0xffffu); u8[3] = bf2f(uw.y >> 16); u8[4] = bf2f(uw.z & 0xffffu); u8[5] = bf2f(uw.z >> 16); u8[6] = bf2f(uw.w & 0xffffu); u8[7] = bf2f(uw.w >> 16);
      *(u32x4*)(Gg + off) = (u32x4){cvtpk(a[0] * u8[0], a[1] * u8[1]), cvtpk(a[2] * u8[2], a[3] * u8[3]), cvtpk(a[4] * u8[4], a[5] * u8[5]), cvtpk(a[6] * u8[6], a[7] * u8[7])};
    }
    __syncthreads();
  }
}
#undef KSWZ
#undef SBAR
}

struct Args { const float* in[27]; float* out; unsigned char* ws; int ph_lo, ph_hi, ph_lo2, ph_hi2; };
static_assert(offsetof(Args, out) == 27 * 8 && offsetof(Args, ws) == 28 * 8, "Args starts with 29 consecutive pointers");
enum { I_X = 0, I_C, I_CTX, I_CCTX, I_WMOD, I_BMOD, I_LNG, I_LNB, I_AWIN, I_AWOUT, I_ALAM, I_ASUBG, I_SWIN, I_SBIN, I_SNG, I_SNB, I_SWS, I_SBS, I_SWOUT,
       I_RW, I_RB, I_EWG, I_EWU, I_EWD, I_SHG, I_SHU, I_SHD };
constexpr int N_PHASES = 25;

__device__ __forceinline__ f32x4 ld_bf4(const bf16_t* p) { const u32x2 w = *(const u32x2*)p; return (f32x4){bf2f(w.x & 0xffffu), bf2f(w.x >> 16), bf2f(w.y & 0xffffu), bf2f(w.y >> 16)}; }

__device__ __forceinline__ void bf8_to_f32(const u32x4 w, float (&f)[8]) {
    f[0] = bf2f(w.x & 0xffffu); f[1] = bf2f(w.x >> 16); f[2] = bf2f(w.y & 0xffffu); f[3] = bf2f(w.y >> 16); f[4] = bf2f(w.z & 0xffffu); f[5] = bf2f(w.z >> 16); f[6] = bf2f(w.w & 0xffffu); f[7] = bf2f(w.w >> 16);
}
template <bool MOE>
__device__ __forceinline__ void ln_rows(const float* __restrict__ xin, const bf16_t* __restrict__ Yb, float* __restrict__ xout, bf16_t* __restrict__ hb, const float* __restrict__ lng, const float* __restrict__ lnb,
                                        const float* __restrict__ modl, int g_off, const float* __restrict__ modh, int sc_off, int hstride  , int gw, int NGW, int lane) {
    constexpr int NY = MOE ? TOPK + 1 : 1;
    for (int row = gw; row < T; row += NGW) {
        const int b = row / SEQ; const float* mb = modl + b * 6144; const float* mh = modh ? modh + b * 6144 : nullptr;
        u32x4 yr[NY][2]; f32x4 xr[2][2], gr[2][2], lg[2][2], lb[2][2], scv[2][2], shv[2][2];
#pragma unroll
        for (int j = 0; j < 2; ++j) {
            const int c = j * 512 + lane * 8;
            if (!MOE) yr[0][j] = *(const u32x4*)(Yb + (size_t)row * D + c);
            else { yr[TOPK][j] = *(const u32x4*)(Yb + ((size_t)TK + row) * D + c);
#pragma unroll
                for (int k = 0; k < TOPK; ++k) yr[k][j] = *(const u32x4*)(Yb + ((size_t)row * TOPK + k) * D + c); }
#pragma unroll
            for (int q = 0; q < 2; ++q) { xr[j][q] = *(const f32x4*)(xin + (size_t)row * D + c + q * 4); gr[j][q] = *(const f32x4*)(mb + g_off + c + q * 4);
            }
        }
        asm volatile("" ::: "memory");
        float v[2][8]; float s = 0.f;
#pragma unroll
        for (int j = 0; j < 2; ++j) {
            float ya[8]; bf8_to_f32(yr[0][j], ya);
#pragma unroll
            for (int k = 1; k < NY; ++k) { float t8[8]; bf8_to_f32(yr[k][j], t8);
#pragma unroll
                for (int i = 0; i < 8; ++i) ya[i] += t8[i];
                __builtin_amdgcn_sched_barrier(0); }
#pragma unroll
            for (int i = 0; i < 8; ++i) { v[j][i] = xr[j][i >> 2][i & 3] * ALPHA + gr[j][i >> 2][i & 3] * ya[i]; s += v[j][i]; }
        }
#pragma unroll
        for (int j = 0; j < 2; ++j)
#pragma unroll
            for (int q = 0; q < 2; ++q) { const int c = j * 512 + lane * 8 + q * 4; lg[j][q] = *(const f32x4*)(lng + c); lb[j][q] = *(const f32x4*)(lnb + c);
                if (modh) { scv[j][q] = *(const f32x4*)(mh + sc_off + c); shv[j][q] = *(const f32x4*)(mh + sc_off - 1024 + c); } }
        asm volatile("" ::: "memory");
        const float mean = wave_sum(s) * (1.f / D); float s2 = 0.f;
#pragma unroll
        for (int j = 0; j < 2; ++j)
#pragma unroll
            for (int i = 0; i < 8; ++i) { v[j][i] -= mean; s2 += v[j][i] * v[j][i]; }
        const float rstd = 1.f / sqrtf(wave_sum(s2) * (1.f / D) + LN_EPS);
#pragma unroll
        for (int j = 0; j < 2; ++j) {
            const int c = j * 512 + lane * 8;
            float o[8];
#pragma unroll
            for (int i = 0; i < 8; ++i) o[i] = v[j][i] * rstd * lg[j][i >> 2][i & 3] + lb[j][i >> 2][i & 3];
            *(f32x4*)(xout + (size_t)row * D + c) = (f32x4){o[0], o[1], o[2], o[3]}; *(f32x4*)(xout + (size_t)row * D + c + 4) = (f32x4){o[4], o[5], o[6], o[7]};
            if (modh) {
                float h[8];
#pragma unroll
                for (int i = 0; i < 8; ++i) h[i] = o[i] * (scv[j][i >> 2][i & 3] + 1.f) + shv[j][i >> 2][i & 3];
                const u32x4 hw = (u32x4){pk2(h[0], h[1]), pk2(h[2], h[3]), pk2(h[4], h[5]), pk2(h[6], h[7])};
                *(u32x4*)(hb + (size_t)row * hstride + c) = hw;
                if (hstride == HML) { float hf[8]; bf8_to_f32(hw, hf);
                    *(u32x4*)(hb + (size_t)row * hstride + D + c) = (u32x4){pk2(h[0] - hf[0], h[1] - hf[1]), pk2(h[2] - hf[2], h[3] - hf[3]), pk2(h[4] - hf[4], h[5] - hf[5]), pk2(h[6] - hf[6], h[7] - hf[7])}; }
            }
        }
    }
}

__device__ __forceinline__ void expert_prefix(const unsigned* cnt, LAS int* ps, LAS int* xps, int x, int tid) {
    if (tid < 64) {
        int v[4], s = 0;
#pragma unroll
        for (int i = 0; i < 4; ++i) { const int c = (int)cnt[tid * 4 + i]; v[i] = (c + PADM - 1) / PADM * PADM; s += v[i]; }
        int inc = s;
#pragma unroll
        for (int o = 1; o < 64; o <<= 1) { const int t = __shfl_up(inc, o); if (tid >= o) inc += t; }
        int ex = inc - s;
#pragma unroll
        for (int i = 0; i < 4; ++i) { ps[tid * 4 + i] = ex; ex += v[i]; }
        if (tid == 63) ps[256] = ex;
        int tl = 0; if (tid < 32) tl = ((int)cnt[x + 8 * tid] + PADM - 1) / PADM;
        int inc2 = tl;
#pragma unroll
        for (int o = 1; o < 32; o <<= 1) { const int t = __shfl_up(inc2, o); if (tid >= o) inc2 += t; }
        if (tid < 32) { xps[tid] = inc2 - tl; if (tid == 31) xps[32] = inc2; }
    }
    __syncthreads();
}

template <bool LO = false>
__device__ __forceinline__ void cvt_item(const float* __restrict__ W, int ldn, int K, int k0, int n0, bf16_t* __restrict__ Bt, int drow0, LAS unsigned char* wl, int lane, int kd0 = -1) {
    if (kd0 < 0) kd0 = k0;
    const int n4 = (lane & 31) * 4, kh = lane >> 5;
    const float* src = W + (size_t)(k0 + kh * 32) * ldn + n0 + n4;
    f32x4 v[4][8];
#pragma unroll
    for (int b = 0; b < 4; ++b)
#pragma unroll
        for (int i = 0; i < 8; ++i) v[b][i] = __builtin_nontemporal_load((const f32x4*)(src + (size_t)(b * 8 + i) * ldn));
    asm volatile("" ::: "memory");
#pragma unroll
    for (int b = 0; b < 4; ++b) {
        if (LO) {
#pragma unroll
            for (int i = 0; i < 8; ++i) { v[b][i].x -= bf2f(f2bf(v[b][i].x)); v[b][i].y -= bf2f(f2bf(v[b][i].y)); v[b][i].z -= bf2f(f2bf(v[b][i].z)); v[b][i].w -= bf2f(f2bf(v[b][i].w)); }
        }
        const int kc = kh * 4 + b;
#pragma unroll
        for (int c = 0; c < 4; ++c) {
            const int n = n4 + c;
            const u32x4 w = {pk2(v[b][0][c], v[b][1][c]), pk2(v[b][2][c], v[b][3][c]), pk2(v[b][4][c], v[b][5][c]), pk2(v[b][6][c], v[b][7][c])};
            *(LAS u32x4*)(wl + n * 128 + ((kc ^ (n & 7)) << 4)) = w;
        }
        __builtin_amdgcn_sched_barrier(0);
    }
    asm volatile("s_waitcnt lgkmcnt(0)" ::: "memory");
    const int cch = lane & 7;
#pragma unroll
    for (int j = 0; j < 16; ++j) {
        const int n = (lane >> 3) + 8 * j;
        const u32x4 w = *(const LAS u32x4*)(wl + n * 128 + ((cch ^ (n & 7)) << 4));
        __builtin_nontemporal_store(w, (u32x4*)(Bt + (size_t)(drow0 + n) * K + kd0 + cch * 8));
    }
    asm volatile("s_waitcnt lgkmcnt(0)" ::: "memory");
}

struct Ctx { unsigned char* lds; XcdBarrier bar; int G, bid, NGW, lo, hi; long NGT; };
__device__ __forceinline__ unsigned char* ldptr(const unsigned char* lds, int i) {
    const LAS unsigned* p = (const LAS unsigned*)((LAS unsigned char*)lds + LDS_PTRS) + 2 * i;
    const unsigned lo = __builtin_amdgcn_readfirstlane(p[0]), hi = __builtin_amdgcn_readfirstlane(p[1]);
    return (unsigned char*)(GAS unsigned char*)(((unsigned long long)hi << 32) | lo);
}
#define PIN(i) ((const float*)ldptr(lds, (i)))
#ifndef PHMASK
#define PHMASK 0xFFFFFFFFu
#endif
#define IN(k) (((PHMASK >> (k)) & 1u) && lo <= (k) && (k) < hi)
#define SEAM(k) do { if (!MK_PER_PHASE_LAUNCH && IN((k) + 1)) xcd_barrier(bar); else __syncthreads(); } while (0)
#define CTX_LOCALS \
    unsigned char* lds = C.lds; const XcdBarrier bar = C.bar; const int G = C.G, bid = C.bid, NGW = C.NGW; \
    const long NGT = C.NGT; unsigned char* ws = ldptr(lds, 28); unsigned* ctl = (unsigned*)(ws + WS_CTL); float* smf = (float*)lds; const int lo = C.lo, hi = C.hi; \
    LAS unsigned char* ldsl = (LAS unsigned char*)lds; \
    (void)NGW; (void)NGT; (void)ctl; (void)smf; (void)bid; (void)G; (void)ldsl;
#define PH_LOCALS \
    int tid = threadIdx.x; asm volatile("" : "+v"(tid)); const int lane = tid & 63, wave = __builtin_amdgcn_readfirstlane(tid >> 6); const int gw = bid * NWAVES + wave; const long gt = (long)bid * NTHR + tid; \
    (void)lane; (void)wave; (void)gw; (void)gt;
#define WS_PTRS \
    float* modv = (float*)(ws + WS_MODV); float* ROPE = (float*)(ws + WS_ROPE); \
    bf16_t* HALL = (bf16_t*)(ws + WS_HALL); bf16_t* Qb = (bf16_t*)(ws + WS_Q); bf16_t* Kb = (bf16_t*)(ws + WS_K); bf16_t* Vb = (bf16_t*)(ws + WS_V); \
    float* OATT = (float*)(ws + WS_OATT); bf16_t* ATT = (bf16_t*)(ws + WS_ATT); \
    bf16_t* Y = (bf16_t*)(ws + WS_Y); float* X1 = (float*)(ws + WS_X1); float* X2 = (float*)ldptr(lds, 27); \
    bf16_t* HM = (bf16_t*)(ws + WS_HM); bf16_t* H1 = (bf16_t*)(ws + WS_H1); \
    float* LOG = (float*)(ws + WS_LOG); bf16_t* HO = (bf16_t*)(ws + WS_HO); bf16_t* HS = (bf16_t*)(ws + WS_HS); \
    int* IDX = (int*)(ws + WS_IDX); float* WGT = (float*)(ws + WS_WGT); int* POS = (int*)(ws + WS_POS); \
    int* SPAIR = (int*)(ws + WS_SPAIR); float* SW = (float*)(ws + WS_SW); \
    bf16_t* Ub = (bf16_t*)(ws + WS_U); bf16_t* VB = (bf16_t*)(ws + WS_VB); float* VN = (float*)(ws + WS_VN); bf16_t* GSP = (bf16_t*)(ws + WS_GSP); \
    bf16_t* WIN_T = (bf16_t*)(ws + WS_WIN_T); bf16_t* WOUT_T = (bf16_t*)(ws + WS_WOUT_T); bf16_t* SWIN_T = (bf16_t*)(ws + WS_SWIN_T); bf16_t* SWOUT_T = (bf16_t*)(ws + WS_SWOUT_T); \
    bf16_t* SHUP_T = (bf16_t*)(ws + WS_SHUP_T); bf16_t* SHDN_T = (bf16_t*)(ws + WS_SHDN_T); bf16_t* EUP_T = (bf16_t*)(ws + WS_EUP_T); bf16_t* EDN_T = (bf16_t*)(ws + WS_EDN_T); bf16_t* RW_T = (bf16_t*)(ws + WS_RW_T); (void)RW_T; bf16_t* WSB = (bf16_t*)(ws + WS_WSB); f32x2* VSTAT = (f32x2*)(ws + WS_VSTAT); (void)WSB; (void)VSTAT; \
    (void)modv; (void)ROPE; (void)HALL; (void)Qb; (void)Kb; (void)Vb; (void)OATT; (void)ATT; (void)Y; (void)X1; (void)X2; (void)HM; (void)H1; (void)LOG; (void)HO; (void)HS; (void)IDX; (void)WGT; (void)POS; \
    (void)SPAIR; (void)SW; (void)Ub; (void)VB; (void)VN; (void)GSP; (void)WIN_T; (void)WOUT_T; (void)SWIN_T; (void)SWOUT_T; (void)SHUP_T; (void)SHDN_T; (void)EUP_T; (void)EDN_T;

constexpr int NI_WIN = 16 * 24, NI_WOUT = 16 * 8, NI_SWIN = 16 * 32, NI_SWOUT = 32 * 8, NI_RW = 2 * 3 * 32, NI_SH = 2 * 96, NI_DENSE = NI_WIN + NI_WOUT + NI_SWIN + NI_SWOUT + NI_RW + NI_SH;
constexpr int NI_EXP = 2 * NE * 96;
__device__ __forceinline__ void cvt_weights(unsigned char* lds, int w, int NW, int lane, LAS unsigned char* wl, int it0, int it1, unsigned* queue = nullptr) {
    unsigned char* ws = ldptr(lds, 28);
    bf16_t* WIN_T = (bf16_t*)(ws + WS_WIN_T); bf16_t* WOUT_T = (bf16_t*)(ws + WS_WOUT_T); bf16_t* SWIN_T = (bf16_t*)(ws + WS_SWIN_T); bf16_t* SWOUT_T = (bf16_t*)(ws + WS_SWOUT_T);
    bf16_t* SHUP_T = (bf16_t*)(ws + WS_SHUP_T); bf16_t* SHDN_T = (bf16_t*)(ws + WS_SHDN_T); bf16_t* EUP_T = (bf16_t*)(ws + WS_EUP_T); bf16_t* EDN_T = (bf16_t*)(ws + WS_EDN_T); bf16_t* RW_T = (bf16_t*)(ws + WS_RW_T);
    for (int it = it0 + w; ; it += NW) {
        if (queue) { unsigned q = 0; if (lane == 0) q = __hip_atomic_fetch_add(queue, 1u, __ATOMIC_RELAXED, __HIP_MEMORY_SCOPE_AGENT); it = it0 + (int)__builtin_amdgcn_readfirstlane(q); }
        if (it >= it1) break;
        int r = it;
        if (r < NI_WIN) { cvt_item(PIN(I_AWIN), 3 * D, D, (r / 24) * 64, (r % 24) * 128, WIN_T, (r % 24) * 128, wl, lane); continue; } r -= NI_WIN;
        if (r < NI_WOUT) { cvt_item(PIN(I_AWOUT), D, D, (r / 8) * 64, (r % 8) * 128, WOUT_T, (r % 8) * 128, wl, lane); continue; } r -= NI_WOUT;
        if (r < NI_SWIN) { cvt_item(PIN(I_SWIN), 2 * SGU_DFF, D, (r / 32) * 64, (r % 32) * 128, SWIN_T, (r % 32) * 128, wl, lane); continue; } r -= NI_SWIN;
        if (r < NI_SWOUT) { cvt_item(PIN(I_SWOUT), D, SGU_DFF, (r / 8) * 64, (r % 8) * 128, SWOUT_T, (r % 8) * 128, wl, lane); continue; } r -= NI_SWOUT;
        if (r < NI_RW) { const int l = r / 96, seg = (r % 96) / 32, sub = r % 32; const float* rw = PIN(I_RW) + (size_t)l * D * NE; bf16_t* dst = RW_T + (size_t)l * NE * 3072;
            if (seg < 2) cvt_item<false>(rw, NE, 3072, (sub / 2) * 64, (sub % 2) * 128, dst, (sub % 2) * 128, wl, lane, seg * 1024 + (sub / 2) * 64);
            else cvt_item<true>(rw, NE, 3072, (sub / 2) * 64, (sub % 2) * 128, dst, (sub % 2) * 128, wl, lane, 2048 + (sub / 2) * 64);
            continue; } r -= NI_RW;
        const float *wg, *wu, *wd; bf16_t *up_t, *dn_t;
        if (r < NI_SH) { const int l = r / 96; r %= 96; wg = PIN(I_SHG) + (size_t)l * D * EDFF; wu = PIN(I_SHU) + (size_t)l * D * EDFF; wd = PIN(I_SHD) + (size_t)l * EDFF * D;
            up_t = SHUP_T + (size_t)l * 512 * D; dn_t = SHDN_T + (size_t)l * D * EDFF; }
        else { r -= NI_SH; const int le = r / 96; r %= 96; wg = PIN(I_EWG) + (size_t)le * D * EDFF; wu = PIN(I_EWU) + (size_t)le * D * EDFF; wd = PIN(I_EWD) + (size_t)le * EDFF * D;
            up_t = EUP_T + (size_t)le * 512 * D; dn_t = EDN_T + (size_t)le * D * EDFF; }
        const int mat = r / 32, sub = r % 32;
        if (mat < 2) cvt_item(mat == 0 ? wg : wu, EDFF, D, (sub / 2) * 64, (sub % 2) * 128, up_t, (sub % 2) * 256 + mat * 128, wl, lane);
        else cvt_item(wd, D, EDFF, (sub / 8) * 64, (sub % 8) * 128, dn_t, (sub % 8) * 128, wl, lane);
    }
}

__device__ __forceinline__ void phases_front(const Ctx& C) {
    CTX_LOCALS
    WS_PTRS
    if (IN(0)) { PH_LOCALS
        float* sc = smf;
        float* red = smf + 5 * 1024;
        for (int i = tid; i < 5 * 1024; i += NTHR) { const int r = i >> 10, k = i & 1023; const float c = r < 4 ? PIN(I_C)[r * D + k] : PIN(I_CCTX)[k]; sc[i] = siluf(c); }
        __syncthreads();
        for (int it = bid; it < 2 * 96; it += G) {
            const int l = it / 96, j = (it % 96) * 64 + lane;
            const float* w = PIN(I_WMOD) + (size_t)l * D * 6144 + j;
            float a0 = 0, a1 = 0, a2 = 0, a3 = 0, a4 = 0;
            for (int k = wave * 128; k < wave * 128 + 128; ++k) { const float wv = w[(size_t)k * 6144]; a0 += sc[k] * wv; a1 += sc[1024 + k] * wv; a2 += sc[2048 + k] * wv; a3 += sc[3072 + k] * wv; a4 += sc[4096 + k] * wv; }
            red[(wave * 5 + 0) * 64 + lane] = a0; red[(wave * 5 + 1) * 64 + lane] = a1; red[(wave * 5 + 2) * 64 + lane] = a2; red[(wave * 5 + 3) * 64 + lane] = a3; red[(wave * 5 + 4) * 64 + lane] = a4;
            __syncthreads();
            if (tid < 320) { const int r = tid >> 6, jj = tid & 63; float s = 0.f;
#pragma unroll
                for (int w8 = 0; w8 < 8; ++w8) s += red[(w8 * 5 + r) * 64 + jj];
                const int col = (it % 96) * 64 + jj;
                modv[((size_t)l * 5 + r) * 6144 + col] = s + PIN(I_BMOD)[l * 6144 + col]; }
            __syncthreads();
        }
        if (gt < 128 * 16) { const int pos = (int)gt >> 4, jj = (int)gt & 15; const float ang = (float)pos * __powf(10000.f, -(float)jj / 16.f); ROPE[gt * 2] = __cosf(ang); ROPE[gt * 2 + 1] = __sinf(ang); }
        for (long i = gt; i < SGU_G * SGU_CH * SGU_CH / 2; i += NGT) { const f32x2 w = *(const f32x2*)(PIN(I_SWS) + i * 2); ((unsigned*)WSB)[i] = pk2(w.x, w.y); }
        cvt_weights(lds, bid * NWAVES + wave, G * NWAVES, lane, ldsl + wave * 16384, 0, NI_DENSE);
        SEAM(0);
    }
    if (IN(1)) { PH_LOCALS
        for (long i = gt; i < (long)TA * (D / 4); i += NGT) {
            const int row = (int)(i >> 8), c = (int)(i & 255) * 4, b = row / SEQA, n = row % SEQA;
            const float* src = n < SEQ ? PIN(I_X) + ((size_t)b * SEQ + n) * D + c : PIN(I_CTX) + ((size_t)b * CTX + (n - SEQ)) * D + c;
            const float* mb = modv + (n < SEQ ? b : 4) * 6144;
            const f32x4 h = *(const f32x4*)src * (*(const f32x4*)(mb + 1024 + c) + 1.f) + *(const f32x4*)(mb + c);
            *(u32x2*)(HALL + (size_t)row * D + c) = (u32x2){pk2(h.x, h.y), pk2(h.z, h.w)};
        }
        SEAM(1);
    }
    if (IN(2)) { PH_LOCALS
        pg8::DenseSched S; S.init(HALL, WIN_T, TA, 3 * D, D, G, bid);
        const pg8::EpiQKV E{Qb, (WS_K - WS_Q) / 2, ROPE, 0.125f * 1.4426950408889634f};
        pg8::gemm_phase<pg8::EpiQKV, pg8::DenseSched, true>(ldsl, D, S, E);
        SEAM(2);
    }
    if (IN(4)) { PH_LOCALS
        const float* lp = PIN(I_ALAM);
        const float l1 = wave_sum(lp[lane] * lp[64 + lane]), l2 = wave_sum(lp[128 + lane] * lp[192 + lane]);
        const float lam = __expf(l1) - __expf(l2) + LAM_INIT;
        const int x = bid & 7, r = bid >> 3, W = G >> 3, NCV = (W > 16) ? 3 : 0, WA = W - NCV;
        if (r < WA) {
            for (int i = 0; ; ++i) {
                const int idx = i * WA + r; if (idx >= 4 * (SEQ / att::UNIT_ROWS)) break;
                const int pair = x * 4 + idx / (SEQ / att::UNIT_ROWS), qb = idx % (SEQ / att::UNIT_ROWS), b = pair >> 3, h = pair & 7;
                const size_t q0 = (size_t)b * SEQA * D + h * 128, kv0 = (size_t)(b * NH + h) * SEQA * 128;
                att::attn_unit(Qb + q0 + (size_t)qb * att::UNIT_ROWS * D, Kb + kv0, Vb + kv0, ATT + ((size_t)b * SEQ + (size_t)qb * att::UNIT_ROWS) * D + h * 128,
                               lam, PIN(I_ASUBG), SEQA, (char*)lds, (char*)lds + LDS_TAB);
            }
        }
        __syncthreads();
        cvt_weights(lds, 0, 0, lane, ldsl + wave * 16384, NI_DENSE, NI_DENSE + NI_EXP, ctl + CW_CVQ);
        SEAM(4);
    }
    if (IN(6)) { PH_LOCALS
        pg8::DenseSched S; S.init(ATT, WOUT_T, T, D, D, G, bid);
        const pg8::EpiBf16<0> E{Y, D, nullptr, 0, 0};
        pg8::gemm_phase<pg8::EpiBf16<0>, pg8::DenseSched, true>(ldsl, D, S, E);
        SEAM(6);
    }
}
template <int L> __device__ __forceinline__ void layer_tail(const Ctx& C) {
    CTX_LOCALS
    WS_PTRS
    const float* xin = (L == 0) ? PIN(I_X) : X2;
    const float* modl = modv + (size_t)L * 5 * 6144;
    unsigned* cnt = ctl + CW_CNT + L * 256;
    LAS int* ps = (LAS int*)(ldsl + LDS_PS); LAS int* xps = ps + 264;
    const int xcd = bid & 7, xr = bid >> 3, XW = G >> 3;
    if (L == 1) {
        if (IN(14)) { PH_LOCALS
            pg8::DenseSched S; S.init(H1, SWIN_T, T, 2 * SGU_DFF, D, G, bid);
            const pg8::EpiSguIn E{Ub, VB, PIN(I_SBIN), (float*)VSTAT};
            pg8::gemm_phase<pg8::EpiSguIn, pg8::DenseSched, true>(ldsl, D, S, E);
            SEAM(14);
        }
        if (IN(16)) { PH_LOCALS
            const int g = bid & 7, wp = wave & 3, r32 = lane & 31, hih = lane >> 5;
            att::bf16x8 pa[2][4];
#pragma unroll
            for (int kh = 0; kh < 2; ++kh)
#pragma unroll
                for (int ks = 0; ks < 4; ++ks) pa[kh][ks] = *reinterpret_cast<const att::bf16x8*>(WSB + ((size_t)g * SGU_CH + wp * 32 + r32) * SGU_CH + kh * 64 + ks * 16 + hih * 8);
            att::sgu_chunks(VB + g * SGU_GC, Ub + g * SGU_GC, GSP + g * SGU_GC, VSTAT, PIN(I_SNG) + g * SGU_GC, PIN(I_SNB) + g * SGU_GC, PIN(I_SBS) + g * SGU_CH, pa,
                            bid >> 3, G >> 3, T / SGU_CH, (char*)lds);
            SEAM(16);
        }
        if (IN(17)) { PH_LOCALS
            pg8::DenseSched S; S.init(GSP, SWOUT_T, T, D, SGU_DFF, G, bid);
            const pg8::EpiBf16<0> E{Y, D, nullptr, 0, 0};
            pg8::gemm_phase<pg8::EpiBf16<0>, pg8::DenseSched, true>(ldsl, SGU_DFF, S, E);
            SEAM(17);
        }
    }
    constexpr int P_LN = (L == 0) ? 7 : 18;
    if (IN(P_LN)) { PH_LOCALS
        ln_rows<false>(xin, Y, X1, HM, PIN(I_LNG) + (L * 2 + 0) * D, PIN(I_LNB) + (L * 2 + 0) * D, modl, 2048, modl, 4096, HML, gw, NGW, lane);
        if (L == 0) for (long i = gt; i < T; i += NGT) VSTAT[i] = (f32x2){0.f, 0.f};
        SEAM(P_LN);
    }
    if (IN(P_LN + 1)) { PH_LOCALS
        const int GH = G >> 1;
        if (bid < GH) {
            pg8::DenseSched S; S.init(HM, RW_T + (size_t)L * NE * 3072, T, NE, 3072, GH, bid, HML);
            const pg8::EpiF32 E{LOG, NE};
            pg8::gemm_phase<pg8::EpiF32, pg8::DenseSched, true, 32>(ldsl, 3072, S, E);
        } else {
            pg8::DenseSched S; S.init(HM, SHUP_T + (size_t)L * 512 * D, T, 512, D, G - GH, bid - GH, HML);
            const pg8::EpiSharedUp E{HS};
            pg8::gemm_phase<pg8::EpiSharedUp, pg8::DenseSched, true>(ldsl, D, S, E);
        }
        SEAM(P_LN + 1);
    }
    if (IN(P_LN + 2)) { PH_LOCALS
        const float* rb = PIN(I_RB) + L * NE;
        const f32x4 bias = *(const f32x4*)(rb + lane * 4);
        f32x4 lg_next = (gw < T) ? *(const f32x4*)(LOG + (size_t)gw * NE + lane * 4) : (f32x4){0.f, 0.f, 0.f, 0.f};
        int pend_t = -1, pend_pos = 0;
        for (int t = gw; t < T; t += NGW) {
            const f32x4 lg = lg_next; if (t + NGW < T) lg_next = *(const f32x4*)(LOG + (size_t)(t + NGW) * NE + lane * 4);
            float sc[4], ch[4];
#pragma unroll
            for (int i = 0; i < 4; ++i) { sc[i] = sigmoidf_(lg[i]); ch[i] = sc[i] + bias[i]; }
            float m1 = fmaxf(ch[0], ch[1]), m2 = fminf(ch[0], ch[1]);
#pragma unroll
            for (int i = 2; i < 4; ++i) { const float v = ch[i]; m2 = fmaxf(m2, fminf(m1, v)); m1 = fmaxf(m1, v); }
#pragma unroll
            for (int o = 1; o < 8; o <<= 1) { const float b1 = __shfl_xor(m1, o), b2 = __shfl_xor(m2, o); const float n1 = fmaxf(m1, b1), n2 = fmaxf(fminf(m1, b1), fmaxf(m2, b2)); m1 = n1; m2 = n2; }
            const float gs = m1 + m2; const int g = lane >> 3; int rank = 0;
#pragma unroll
            for (int gg = 0; gg < 8; ++gg) { const float o = __shfl(gs, gg * 8); rank += (o > gs || (o == gs && gg < g)) ? 1 : 0; }
            const bool sel = rank < 4;
            float cm[4];
#pragma unroll
            for (int i = 0; i < 4; ++i) cm[i] = sel ? ch[i] : -INFINITY;
            float wsum = 0.f, myw = 0.f; int myidx = 0;
#pragma unroll
            for (int k = 0; k < TOPK; ++k) {
                float bv = cm[0]; int bi = lane * 4;
#pragma unroll
                for (int i = 1; i < 4; ++i) if (cm[i] > bv) { bv = cm[i]; bi = lane * 4 + i; }
#pragma unroll
                for (int o = 1; o < 64; o <<= 1) { const float ov = __shfl_xor(bv, o); const int oi = __shfl_xor(bi, o); if (ov > bv || (ov == bv && oi < bi)) { bv = ov; bi = oi; } }
                const int sub = bi & 3; const float mysc = sub == 0 ? sc[0] : sub == 1 ? sc[1] : sub == 2 ? sc[2] : sc[3];
                const float wv = __shfl(mysc, bi >> 2);
                if ((bi >> 2) == lane) { if (sub == 0) cm[0] = -INFINITY; else if (sub == 1) cm[1] = -INFINITY; else if (sub == 2) cm[2] = -INFINITY; else cm[3] = -INFINITY; }
                wsum += wv; if (lane == k) { myw = wv; myidx = bi; }
            }
            if (lane < TOPK) {
                IDX[t * TOPK + lane] = myidx; WGT[t * TOPK + lane] = myw / wsum * ROUTED_SCALE;
                if (pend_t >= 0) POS[pend_t * TOPK + lane] = pend_pos;
                pend_pos = (int)atomicAdd(cnt + myidx, 1u);
            }
            pend_t = t;
        }
        if (pend_t >= 0 && lane < TOPK) POS[pend_t * TOPK + lane] = pend_pos;
        SEAM(P_LN + 2);
    }
    if (IN(P_LN + 3)) { PH_LOCALS
        expert_prefix(cnt, ps, xps, xcd, tid);
        for (long p = gt; p < TK; p += NGT) { const int e = IDX[p]; const int slot = ps[e] + POS[p]; SPAIR[slot] = (int)p; SW[slot] = WGT[p]; }
        for (int e = bid; e < NE; e += G) { const int c = (int)cnt[e], pe = ps[e + 1] - ps[e]; for (int s = c + tid; s < pe; s += NTHR) { SPAIR[ps[e] + s] = -1; SW[ps[e] + s] = 0.f; } }
        for (long t = gt; t < T; t += NGT) { SPAIR[PMAX + t] = TK + (int)t; SW[PMAX + t] = 1.f; }
        SEAM(P_LN + 3);
    }
    auto naive_up = [=](int row0, int e, int pn) {
        const float* wg = e < NE ? PIN(I_EWG) + ((size_t)L * NE + e) * D * EDFF : PIN(I_SHG) + (size_t)L * D * EDFF;
        const float* wu = e < NE ? PIN(I_EWU) + ((size_t)L * NE + e) * D * EDFF : PIN(I_SHU) + (size_t)L * D * EDFF;
        auto la = [=](int r, int k) -> f32x4 { const int p = SPAIR[r]; const int tok = p < 0 ? 0 : (p < TK ? (p >> 3) : (p - TK)); return ld_bf4(HM + (size_t)tok * HML + k); };
        for (int half = 0; half < 2; ++half) {
            f32x4 ga[4], gb[4];
            { int ri = 0; auto epi1 = [&](int r, int c, f32x4 va, f32x4 vb) { ga[ri] = va; gb[ri] = vb; ++ri; }; gemm_tile(la, wg, EDFF, D, row0 + half * 128, pn * 128, smf, epi1); }
            { int ri = 0; auto epi2 = [&](int r, int c, f32x4 va, f32x4 vb) { const float w = SW[r]; const f32x4 g0 = ga[ri], g1 = gb[ri]; ++ri;
                *(u32x4*)(HS + (size_t)r * EDFF + c) = (u32x4){pk2(w * siluf(g0.x) * va.x, w * siluf(g0.y) * va.y), pk2(w * siluf(g0.z) * va.z, w * siluf(g0.w) * va.w), pk2(w * siluf(g1.x) * vb.x, w * siluf(g1.y) * vb.y), pk2(w * siluf(g1.z) * vb.z, w * siluf(g1.w) * vb.w)}; };
              gemm_tile(la, wu, EDFF, D, row0 + half * 128, pn * 128, smf, epi2); }
        }
    };
    auto naive_dn = [=](int row0, int e, int pn) {
        const float* wd = e < NE ? PIN(I_EWD) + ((size_t)L * NE + e) * EDFF * D : PIN(I_SHD) + (size_t)L * EDFF * D;
        const LoadBf16 la{HS, EDFF, nullptr};
        auto epi = [=](int r, int c, f32x4 va, f32x4 vb) { const int p = SPAIR[r];
            if (p >= 0) *(u32x4*)(HO + (size_t)p * D + c) = (u32x4){pk2(va.x, va.y), pk2(va.z, va.w), pk2(vb.x, vb.y), pk2(vb.z, vb.w)}; };
        for (int q = 0; q < 4; ++q) gemm_tile(la, wd, D, EDFF, row0 + (q >> 1) * 128, pn * 256 + (q & 1) * 128, smf, epi);
    };
    if (IN(P_LN + 4)) { PH_LOCALS
        expert_prefix(cnt, ps, xps, xcd, tid);
        LAS int* ptab = (LAS int*)(ldsl + LDS_TAB); LAS float* wtab = (LAS float*)(ldsl + LDS_TAB + MAXU_UP * 1024);
        pg8::MoeSched<true, MAXU_UP> S{(const char*)HM, (const char*)(EUP_T + (size_t)L * NE * 512 * D), (const char*)(SHUP_T + (size_t)L * 512 * D), (size_t)512 * D * 2, D, HML, 2, xcd, xr, XW, 0, ps, xps, ptab};
        pg8::Unit u;
        LAS int* r0tab = (LAS int*)(ldsl + LDS_R0);
        if (tid < 32) r0tab[tid] = S.row0_of(tid);
        __syncthreads();
#pragma unroll
        for (int i = 0; i < MAXU_UP * 256 / NTHR; ++i) { const int idx = i * NTHR + tid, r0 = r0tab[idx >> 8]; if (r0 >= 0) { ptab[idx] = SPAIR[r0 + (idx & 255)]; wtab[idx] = SW[r0 + (idx & 255)]; } }
        __syncthreads();
        const pg8::EpiMoeUp<MAXU_UP> E{HS, wtab};
        pg8::gemm_phase<pg8::EpiMoeUp<MAXU_UP>, pg8::MoeSched<true, MAXU_UP>, true>(ldsl, D, S, E);
        for (int j = MAXU_UP; S.next_any(j, u); ++j) naive_up(u.row0, u.e, u.pn);
        SEAM(P_LN + 4);
    }
    if (IN(P_LN + 5)) { PH_LOCALS
        expert_prefix(cnt, ps, xps, xcd, tid);
        LAS int* ptab = (LAS int*)(ldsl + LDS_TAB);
        pg8::MoeSched<false, MAXU_DN> S{(const char*)HS, (const char*)(EDN_T + (size_t)L * NE * D * EDFF), (const char*)(SHDN_T + (size_t)L * D * EDFF), (size_t)D * EDFF * 2, EDFF, EDFF, 4, xcd, xr, XW, 16, ps, xps, ptab};
        pg8::Unit u;
        LAS int* r0tab = (LAS int*)(ldsl + LDS_R0);
        if (tid < 32) r0tab[tid] = S.row0_of(tid);
        __syncthreads();
#pragma unroll
        for (int i = 0; i < MAXU_DN * 256 / NTHR; ++i) { const int idx = i * NTHR + tid, r0 = r0tab[idx >> 8]; if (r0 >= 0) ptab[idx] = SPAIR[r0 + (idx & 255)]; }
        __syncthreads();
        const pg8::EpiMoeDown<MAXU_DN> E{HO, ptab};
        int kdn = EDFF; asm volatile("" : "+s"(kdn));
        pg8::gemm_phase<pg8::EpiMoeDown<MAXU_DN>, pg8::MoeSched<false, MAXU_DN>, true>(ldsl, kdn, S, E);
        for (int j = MAXU_DN; S.next_any(j, u); ++j) naive_dn(u.row0, u.e, u.pn);
        SEAM(P_LN + 5);
    }
    if (IN(P_LN + 6)) { PH_LOCALS
        if (L == 0) ln_rows<true>(X1, HO, X2, H1, PIN(I_LNG) + (L * 2 + 1) * D, PIN(I_LNB) + (L * 2 + 1) * D, modl, 5120, modv + (size_t)5 * 6144, 1024, D, gw, NGW, lane);
        else ln_rows<true>(X1, HO, X2, nullptr, PIN(I_LNG) + (L * 2 + 1) * D, PIN(I_LNB) + (L * 2 + 1) * D, modl, 5120, nullptr, 0, D, gw, NGW, lane);
        SEAM(P_LN + 6);
    }
}

__global__ void __launch_bounds__(NTHR, 2) mega(Args args) {
    extern __shared__ __attribute__((aligned(16))) unsigned char lds[];
    const int tid = threadIdx.x;
    const int G = gridDim.x, bid = blockIdx.x;
    unsigned* ctl = (unsigned*)(args.ws + WS_CTL);
    for (int u = tid; u < 512; u += NTHR) ((unsigned*)(lds + LDS_MISC))[u] = 0u;
    __syncthreads();
    if (tid < 29) {
        const unsigned long long* kp = (const unsigned long long*)__builtin_amdgcn_kernarg_segment_ptr();
        ((unsigned long long*)(lds + LDS_PTRS))[tid] = kp[tid]; }
    __syncthreads();
    XcdBarrier bar; bar.bar = ctl + CW_BAR; bar.x = 0; bar.st = nullptr;
    if (!MK_PER_PHASE_LAUNCH) bar = xcd_barrier_post(ctl + CW_BAR, (volatile LAS unsigned*)(lds + LDS_MISC) + 8);
    Ctx C; C.lds = lds; C.bar = bar; C.G = G; C.bid = bid; C.NGW = G * NWAVES; C.NGT = (long)G * NTHR;
    C.lo = args.ph_lo; C.hi = args.ph_hi;
    phases_front(C);
    layer_tail<0>(C);
    layer_tail<1>(C);
#ifndef NO_PROBE_PASS
    if (args.ph_hi2 > args.ph_lo2) {
        xcd_barrier(bar);
        C.lo = args.ph_lo2; C.hi = args.ph_hi2;
        phases_front(C);
        layer_tail<0>(C);
        layer_tail<1>(C);
    }
#endif
}

extern "C" void kernel_launch(void* const* d_in, const int* in_sizes, int n_in, void* d_out, int out_size, void* d_ws, size_t ws_size, hipStream_t stream) {
    static int grid = 0;
    if (grid == 0) {
        if (n_in != 27 || out_size != T * D || ws_size < WS_END) { fprintf(stderr, "kernel_launch: unexpected shapes n_in %d out %d ws %zu (need %zu)\n", n_in, out_size, ws_size, (size_t)WS_END); grid = -1; return; }
        int dev = 0, cus = 0, per_cu = 0;
        if (hipGetDevice(&dev) != hipSuccess || hipDeviceGetAttribute(&cus, hipDeviceAttributeMultiprocessorCount, dev) != hipSuccess) { grid = -1; return; }
        if (hipFuncSetAttribute((const void*)mega, hipFuncAttributeMaxDynamicSharedMemorySize, LDS_BYTES) != hipSuccess) { fprintf(stderr, "kernel_launch: hipFuncSetAttribute failed\n"); grid = -1; return; }
        if (hipOccupancyMaxActiveBlocksPerMultiprocessor(&per_cu, (const void*)mega, NTHR, LDS_BYTES) != hipSuccess || per_cu < 1) fprintf(stderr, "kernel_launch: occupancy query reports %d\n", per_cu);
        (void)hipGetLastError();
        grid = cus;
    }
    if (grid < 0) return;
    if (hipMemsetAsync((char*)d_ws + WS_CTL, 0, CTL_ZERO_BYTES, stream) != hipSuccess) return;
    Args a{};
    for (int i = 0; i < 27; ++i) a.in[i] = (const float*)d_in[i];
    a.out = (float*)d_out; a.ws = (unsigned char*)d_ws;
#if MK_PER_PHASE_LAUNCH
    for (int p = 0; p < N_PHASES; ++p) { a.ph_lo = p; a.ph_hi = p + 1; hipLaunchKernelGGL(mega, dim3(grid), dim3(NTHR), LDS_BYTES, stream, a); }
#else
    a.ph_lo = 0; a.ph_hi = N_PHASES;
#ifdef PROBE_DUP
    a.ph_hi = PROBE_DUP_END; a.ph_lo2 = PROBE_DUP; a.ph_hi2 = N_PHASES;
#endif
    hipLaunchKernelGGL(mega, dim3(grid), dim3(NTHR), LDS_BYTES, stream, a);
#endif
    const hipError_t le = hipPeekAtLastError();
    if (le != hipSuccess) fprintf(stderr, "kernel_launch: launch failed: %s\n", hipGetErrorName(le));
}
```
